# Optimizing an MI355X kernel written in HIP

```python
import jax, jax.numpy as jnp
from jax import lax
import numpy as np

D_MODEL = 1024
BATCH = 8
SEQ = 4096
DEPTH = 1

ATTN_HEADS = 8
HEAD_DIM = 64
ATTN_WIDTH = ATTN_HEADS * HEAD_DIM
CONV_GROUPS = 8
CONV_WIDTH = D_MODEL // 2
CONV_K = 3
Q_BLOCK = 128
EPS = 1e-6
IN_SIZES = (ATTN_WIDTH, ATTN_WIDTH, ATTN_WIDTH, ATTN_HEADS, ATTN_WIDTH,
            CONV_WIDTH, CONV_WIDTH, CONV_WIDTH, CONV_WIDTH,
            D_MODEL, D_MODEL)
IN_WIDTH = sum(IN_SIZES)

kernel_name = "fox_shortconv_gated_hybrid"


def _rmsnorm(x, g):
    xf = x.astype(jnp.float32)
    xf = xf * lax.rsqrt(jnp.mean(xf * xf, axis=-1, keepdims=True) + EPS)
    return xf.astype(x.dtype) * g


def _fox_attention(q, k, v, log_f):
    b, s, h, dh = q.shape
    nb = s // Q_BLOCK
    cum = jnp.cumsum(log_f, axis=1).transpose(0, 2, 1)
    q_blocks = q.reshape(b, nb, Q_BLOCK, h, dh).swapaxes(0, 1)
    cum_q_blocks = cum.reshape(b, h, nb, Q_BLOCK).transpose(2, 0, 1, 3)
    k_pos = jnp.arange(s)
    scale = dh ** -0.5

    def one_block(args):
        qb, cq, blk = args
        logits = jnp.einsum('bqhd,bkhd->bhqk', qb, k).astype(jnp.float32) * scale
        logits = logits + cq[..., None] - cum[:, :, None, :]
        q_pos = blk * Q_BLOCK + jnp.arange(Q_BLOCK)
        causal = k_pos[None, :] <= q_pos[:, None]
        logits = jnp.where(causal, logits, -jnp.inf)
        p = jax.nn.softmax(logits, axis=-1).astype(v.dtype)
        return jnp.einsum('bhqk,bkhd->bqhd', p, v)

    out = lax.map(one_block, (q_blocks, cum_q_blocks, jnp.arange(nb)))
    return out.swapaxes(0, 1).reshape(b, s, h * dh)


def _causal_dwconv(v, w):
    return lax.conv_general_dilated(
        v, w[:, None, :].astype(v.dtype), window_strides=(1,),
        padding=[(CONV_K - 1, 0)], dimension_numbers=('NWC', 'WIO', 'NWC'),
        feature_group_count=v.shape[-1])


def _layer(x, c, w_ada, b_ada, norm_g, w_in, b_f, q_norm_g, k_norm_g,
           conv_w, w_attn_out, w_conv_out, w_o):
    b, s, _ = x.shape
    ada = c @ w_ada + b_ada
    shift, scale, gate = jnp.split(ada, 3, axis=-1)
    h = _rmsnorm(x, norm_g) * (1 + scale[:, None, :]) + shift[:, None, :]
    proj = h @ w_in
    split_points = np.cumsum(IN_SIZES)[:-1].tolist()
    q, k, v, f_logit, z_a, gb, gc, u, z_b, g_a, g_b = jnp.split(proj, split_points, axis=-1)

    q = _rmsnorm(q.reshape(b, s, ATTN_HEADS, HEAD_DIM), q_norm_g)
    k = _rmsnorm(k.reshape(b, s, ATTN_HEADS, HEAD_DIM), k_norm_g)
    v = v.reshape(b, s, ATTN_HEADS, HEAD_DIM)
    log_f = jax.nn.log_sigmoid((f_logit + b_f).astype(jnp.float32))
    o_a = _fox_attention(q, k, v, log_f) * jax.nn.silu(z_a)

    o_b = gb * _causal_dwconv(gc * u, conv_w) * jax.nn.silu(z_b)

    merged = jax.nn.sigmoid(g_a) * (o_a @ w_attn_out) + jax.nn.sigmoid(g_b) * (o_b @ w_conv_out)
    return x + gate[:, None, :] * (merged @ w_o)


def setup_inputs(seed: int = 0) -> dict:
    key = jax.random.key(seed)
    ks = jax.random.split(key, 14)
    f32 = jnp.float32
    nrm = lambda k, shape, s: jax.random.normal(k, shape, f32) * s
    x = jax.random.normal(ks[0], (BATCH, SEQ, D_MODEL), f32)
    c = jax.random.normal(ks[1], (BATCH, D_MODEL), f32)
    w_ada = nrm(ks[2], (DEPTH, D_MODEL, 3 * D_MODEL), 0.5 * D_MODEL ** -0.5)
    b_ada = nrm(ks[3], (DEPTH, 3 * D_MODEL), 0.02)
    norm_g = 1.0 + nrm(ks[4], (DEPTH, D_MODEL), 0.02)
    w_in = nrm(ks[5], (DEPTH, D_MODEL, IN_WIDTH), D_MODEL ** -0.5)
    b_f = 3.0 + nrm(ks[6], (DEPTH, ATTN_HEADS), 0.5)
    q_norm_g = 1.0 + nrm(ks[7], (DEPTH, HEAD_DIM), 0.02)
    k_norm_g = 1.0 + nrm(ks[8], (DEPTH, HEAD_DIM), 0.02)
    conv_w = nrm(ks[9], (DEPTH, CONV_K, CONV_WIDTH), CONV_K ** -0.5)
    w_attn_out = nrm(ks[10], (DEPTH, ATTN_WIDTH, D_MODEL), ATTN_WIDTH ** -0.5)
    w_conv_out = nrm(ks[11], (DEPTH, CONV_WIDTH, D_MODEL), CONV_WIDTH ** -0.5)
    w_o = nrm(ks[12], (DEPTH, D_MODEL, D_MODEL), D_MODEL ** -0.5)
    return {"x": x, "c": c, "w_ada": w_ada, "b_ada": b_ada, "norm_g": norm_g,
            "w_in": w_in, "b_f": b_f, "q_norm_g": q_norm_g, "k_norm_g": k_norm_g,
            "conv_w": conv_w, "w_attn_out": w_attn_out, "w_conv_out": w_conv_out,
            "w_o": w_o}


def reference(x, c, w_ada, b_ada, norm_g, w_in, b_f, q_norm_g, k_norm_g,
              conv_w, w_attn_out, w_conv_out, w_o):
    for i in range(DEPTH):
        x = _layer(x, c, w_ada[i], b_ada[i], norm_g[i], w_in[i], b_f[i],
                   q_norm_g[i], k_norm_g[i], conv_w[i], w_attn_out[i],
                   w_conv_out[i], w_o[i])
    return x
```

```cpp
#include <hip/hip_runtime.h>
#include <cstdio>
#include <cstdint>
namespace pg8 {
#define PG8_LAS __attribute__((address_space(3)))
typedef unsigned short bf16_t;
typedef short bf16x8 __attribute__((ext_vector_type(8)));
typedef float f32x4 __attribute__((ext_vector_type(4)));
typedef unsigned u32x4 __attribute__((ext_vector_type(4)));
constexpr int BM = 256, BK = 64, HALF = 128, HTB = HALF * BK * 2  , STAGE_BYTES = 8 * HTB, NXCD = 8, WGM = 8;

__host__ __device__ __forceinline__ int lds_byte(int r, int c) { const int st = (r >> 4) * 2 + (c >> 5), rr = r & 15, cc = c & 31, ob = rr * 64 + cc * 2; return st * 1024 + (ob ^ (((ob >> 9) & 1) << 5)); }
__host__ __device__ __forceinline__ void stage_rc(int b, int& R, int& C) { const int st = b / 1024, sb = b % 1024, swz = sb ^ (((sb >> 9) & 1) << 5); R = (st >> 1) * 16 + swz / 64; C = (st & 1) * 32 + (swz % 64) / 2; }
__host__ __device__ __forceinline__ int perm32(int rho) { const int n = rho >> 4, i = rho & 15; return 8 * (i >> 2) + 4 * n + (i & 3); }

struct Unit { int pm, pn; };
struct Gemm { const bf16_t* A; const bf16_t* Bt; int M, N, K; };

struct StaticOrder {
    int nM, nN, nwg, G, c, wgm;
    __host__ __device__ void init(int M, int N, int G_, int c_, int wgm_ = WGM) { nM = M / BM; nN = N / BM; nwg = nM * nN; G = G_; c = c_; wgm = wgm_; }
    __host__ __device__ bool next(int i, Unit& u) const {
        const long L = (long)i * G + c; if (L >= nwg) return false;
        int wgid = (int)L; { const int q = nwg / NXCD, r = nwg % NXCD, xcd = wgid % NXCD, off = wgid / NXCD; wgid = (xcd < r ? xcd * (q + 1) : r * (q + 1) + (xcd - r) * q) + off; }
        const int nig = wgm * nN, gid = wgid / nig, fm = gid * wgm, gsz = (nM - fm) < wgm ? (nM - fm) : wgm;
        u.pm = fm + ((wgid % nig) % gsz); u.pn = (wgid % nig) / gsz; return true;
    }
    __device__ __forceinline__ void a_ready(const Unit&) const {}
    __device__ __forceinline__ void done(const Unit&) const {}
};

__device__ __forceinline__ unsigned cvt_pk_bf16(float lo, float hi) { unsigned r; asm volatile("v_cvt_pk_bf16_f32 %0, %1, %2" : "=v"(r) : "v"(lo), "v"(hi)); return r; }
typedef float f32x2 __attribute__((ext_vector_type(2)));
__device__ __forceinline__ float sigm(float x) { return __builtin_amdgcn_rcpf(1.0f + __builtin_amdgcn_exp2f(x * -1.4426950408889634f)); }
__device__ __forceinline__ float silu(float x) { return x * sigm(x); }
__device__ __forceinline__ float bflo(unsigned w) { return __builtin_bit_cast(float, w << 16); }
__device__ __forceinline__ float bfhi(unsigned w) { return __builtin_bit_cast(float, w & 0xffff0000u); }
typedef unsigned u32x2 __attribute__((ext_vector_type(2)));

constexpr size_t OFF_Q = 96u << 20, OFF_K = 128u << 20, OFF_V = 160u << 20, OFF_SZA = 192u << 20, OFF_CU = 224u << 20, OFF_GZ = 256u << 20, OFF_SGA = 320u << 20, OFF_SGB = 384u << 20;
struct EpiProj {
    static constexpr bool PERM = true, AFTER_DRAIN = false, MID = false;
    unsigned char* ws; const float *qg, *kg; float qscale, eps;
    __device__ __forceinline__ void operator()(const f32x4 (&acc)[2][2][4][2], const Unit& u, int wr, int wc, int fr, int fq) const {
        const int pn = u.pn; const size_t row0 = (size_t)u.pm * BM + wr * 64 + fr;
        if (pn < 4) {
            const bool isq = pn < 2; const float* g = isq ? qg : kg; bf16_t* dst = (bf16_t*)(ws + (isq ? OFF_Q : OFF_K)); const float sc = isq ? qscale : 1.0f;
            const int colb = (pn & 1) * 256 + 64 * wc + 8 * fq;
            f32x4 gv[2][2];
#pragma unroll
            for (int bj = 0; bj < 2; ++bj)
#pragma unroll
                for (int n = 0; n < 2; ++n) gv[bj][n] = *(const f32x4*)(g + 32 * bj + 8 * fq + 4 * n) * sc;
#pragma unroll
            for (int ai = 0; ai < 2; ++ai)
#pragma unroll
                for (int m = 0; m < 4; ++m) {
                    float ss = 0.f;
#pragma unroll
                    for (int bj = 0; bj < 2; ++bj)
#pragma unroll
                        for (int n = 0; n < 2; ++n) { const f32x4 x = acc[ai][bj][m][n]; ss += (x[0] * x[0] + x[1] * x[1]) + (x[2] * x[2] + x[3] * x[3]); }
                    ss += __shfl_xor(ss, 16); ss += __shfl_xor(ss, 32);
                    const float rstd = __builtin_amdgcn_rsqf(ss * (1.0f / 64.0f) + eps);
                    bf16_t* rowp = dst + (row0 + ai * HALF + m * 16) * 512 + colb;
#pragma unroll
                    for (int bj = 0; bj < 2; ++bj) { const f32x4 v0 = acc[ai][bj][m][0] * rstd * gv[bj][0], v1 = acc[ai][bj][m][1] * rstd * gv[bj][1];
                        u32x4 w; w.x = cvt_pk_bf16(v0[0], v0[1]); w.y = cvt_pk_bf16(v0[2], v0[3]); w.z = cvt_pk_bf16(v1[0], v1[1]); w.w = cvt_pk_bf16(v1[2], v1[3]);
                        *(u32x4*)(rowp + 32 * bj) = w; }
                }
        } else if (pn >= 8 && pn < 16) {
            const int col = 64 * (pn - 8) + 16 * wc + 4 * fq; bf16_t* CU = (bf16_t*)(ws + OFF_CU); bf16_t* GZ = (bf16_t*)(ws + OFF_GZ);
#pragma unroll
            for (int ai = 0; ai < 2; ++ai)
#pragma unroll
                for (int m = 0; m < 4; ++m) { const size_t off = (row0 + ai * HALF + m * 16) * 512 + col;
                    const f32x4 gb = acc[ai][0][m][0], gc = acc[ai][0][m][1], uu = acc[ai][1][m][0], zb = acc[ai][1][m][1];
                    const f32x4 cu = gc * uu; f32x4 gz; gz[0] = gb[0] * silu(zb[0]); gz[1] = gb[1] * silu(zb[1]); gz[2] = gb[2] * silu(zb[2]); gz[3] = gb[3] * silu(zb[3]);
                    u32x2 a, b; a.x = cvt_pk_bf16(cu[0], cu[1]); a.y = cvt_pk_bf16(cu[2], cu[3]); b.x = cvt_pk_bf16(gz[0], gz[1]); b.y = cvt_pk_bf16(gz[2], gz[3]);
                    *(u32x2*)(CU + off) = a; *(u32x2*)(GZ + off) = b; }
        } else if (pn >= 16) {
            const int col = 128 * (pn - 16) + 32 * wc + 8 * fq; bf16_t* RB = (bf16_t*)(ws + OFF_SGA); bf16_t* SB = (bf16_t*)(ws + OFF_SGB);
#pragma unroll
            for (int ai = 0; ai < 2; ++ai)
#pragma unroll
                for (int m = 0; m < 4; ++m) { const size_t off = (row0 + ai * HALF + m * 16) * 1024 + col;
                    float sb[8], rr[8];
#pragma unroll
                    for (int n = 0; n < 2; ++n)
#pragma unroll
                        for (int i = 0; i < 4; ++i) { const float ea = __builtin_amdgcn_exp2f(acc[ai][0][m][n][i] * -1.4426950408889634f), eb = __builtin_amdgcn_exp2f(acc[ai][1][m][n][i] * -1.4426950408889634f);
                            sb[4 * n + i] = __builtin_amdgcn_rcpf(1.0f + eb); rr[4 * n + i] = (1.0f + eb) * __builtin_amdgcn_rcpf(1.0f + ea); }
                    u32x4 w, v; w.x = cvt_pk_bf16(rr[0], rr[1]); w.y = cvt_pk_bf16(rr[2], rr[3]); w.z = cvt_pk_bf16(rr[4], rr[5]); w.w = cvt_pk_bf16(rr[6], rr[7]);
                    v.x = cvt_pk_bf16(sb[0], sb[1]); v.y = cvt_pk_bf16(sb[2], sb[3]); v.z = cvt_pk_bf16(sb[4], sb[5]); v.w = cvt_pk_bf16(sb[6], sb[7]);
                    *(u32x4*)(RB + off) = w; *(u32x4*)(SB + off) = v; }
        } else {
            size_t doff; int ld, tcol, act;
            if (pn < 6) { doff = OFF_V; ld = 512; tcol = (pn - 4) * 256; act = 0; }
            else { doff = OFF_SZA; ld = 512; tcol = (pn - 6) * 256; act = 1; }
            bf16_t* dst = (bf16_t*)(ws + doff);
            const int colb = tcol + 64 * wc + 8 * fq;
#pragma unroll
            for (int ai = 0; ai < 2; ++ai)
#pragma unroll
                for (int m = 0; m < 4; ++m) { bf16_t* rowp = dst + (row0 + ai * HALF + m * 16) * ld + colb;
#pragma unroll
                    for (int bj = 0; bj < 2; ++bj) { f32x4 v0 = acc[ai][bj][m][0], v1 = acc[ai][bj][m][1];
                        if (act == 1) { v0[0] = silu(v0[0]); v0[1] = silu(v0[1]); v0[2] = silu(v0[2]); v0[3] = silu(v0[3]); v1[0] = silu(v1[0]); v1[1] = silu(v1[1]); v1[2] = silu(v1[2]); v1[3] = silu(v1[3]); }
                        u32x4 w; w.x = cvt_pk_bf16(v0[0], v0[1]); w.y = cvt_pk_bf16(v0[2], v0[3]); w.z = cvt_pk_bf16(v1[0], v1[1]); w.w = cvt_pk_bf16(v1[2], v1[3]);
                        *(u32x4*)(rowp + 32 * bj) = w; } }
        }
    }
};
__host__ __device__ __forceinline__ int proj_src_col(int p) {
    const int pn = p >> 8, r = p & 255, bj = r >> 7, wc = (r >> 5) & 3, jj = r & 31;
    if (pn >= 8 && pn < 16) { const int fq = jj >> 3, n = (jj >> 2) & 1, i = jj & 3; const int sect = bj == 0 ? (n == 0 ? 2056 : 2568) : (n == 0 ? 3080 : 3592); return sect + 64 * (pn - 8) + 16 * wc + 4 * fq + i; }
    if (pn >= 16) return (bj == 0 ? 4104 : 5128) + 128 * (pn - 16) + 32 * wc + jj;
    const int nat = 64 * wc + 32 * bj + jj;
    if (pn < 6) return 256 * pn + nat;
    return 1544 + 256 * (pn - 6) + nat;
}

struct EpiMerge {
    static constexpr bool PERM = true, AFTER_DRAIN = false, MID = true;
    const bf16_t* R; const bf16_t* SB; bf16_t* MG;
    __device__ __forceinline__ void mid(f32x4 (&acc)[2][2][4][2], const Unit& u, int wr, int wc, int fr, int fq) const {
        const size_t row0 = (size_t)u.pm * BM + wr * 64 + fr; const int col0 = u.pn * BM + wc * 32 + 8 * fq;
#pragma unroll
        for (int ai = 0; ai < 2; ++ai)
#pragma unroll
            for (int m = 0; m < 4; ++m) { const size_t off = (row0 + ai * HALF + m * 16) * 1024 + col0;
#pragma unroll
                for (int bj = 0; bj < 2; ++bj) { const u32x4 g = *(const u32x4*)(R + off + bj * HALF);
                    acc[ai][bj][m][0] *= (f32x4){bflo(g.x), bfhi(g.x), bflo(g.y), bfhi(g.y)}; acc[ai][bj][m][1] *= (f32x4){bflo(g.z), bfhi(g.z), bflo(g.w), bfhi(g.w)}; }
                if (m == 3) asm volatile("" ::: "memory"); }
    }
    __device__ __forceinline__ void operator()(const f32x4 (&acc)[2][2][4][2], const Unit& u, int wr, int wc, int fr, int fq) const {
        const size_t row0 = (size_t)u.pm * BM + wr * 64 + fr; const int col0 = u.pn * BM + wc * 32 + 8 * fq;
#pragma unroll
        for (int ai = 0; ai < 2; ++ai)
#pragma unroll
            for (int m = 0; m < 4; ++m) { const size_t off = (row0 + ai * HALF + m * 16) * 1024 + col0;
#pragma unroll
                for (int bj = 0; bj < 2; ++bj) { const u32x4 g = *(const u32x4*)(SB + off + bj * HALF); const f32x4 v0 = acc[ai][bj][m][0], v1 = acc[ai][bj][m][1];
                    u32x4 w; w.x = cvt_pk_bf16(v0[0] * bflo(g.x), v0[1] * bfhi(g.x)); w.y = cvt_pk_bf16(v0[2] * bflo(g.y), v0[3] * bfhi(g.y));
                    w.z = cvt_pk_bf16(v1[0] * bflo(g.z), v1[1] * bfhi(g.z)); w.w = cvt_pk_bf16(v1[2] * bflo(g.w), v1[3] * bfhi(g.w));
                    *(u32x4*)(MG + off + bj * HALF) = w; } }
    }
};
struct EpiOut {
    static constexpr bool PERM = false, AFTER_DRAIN = false, MID = false;
    const float* x; const float* gate; float* out;
    __device__ __forceinline__ void operator()(const f32x4 (&acc)[2][2][4][2], const Unit& u, int wr, int wc, int fr, int fq) const {
        const size_t row0 = (size_t)u.pm * BM + wr * 64 + fr; const int col0 = u.pn * BM + wc * 32 + 4 * fq; const float* gp = gate + (size_t)(u.pm >> 4) * 3072 + col0;
        f32x4 gv[2][2];
#pragma unroll
        for (int bj = 0; bj < 2; ++bj)
#pragma unroll
            for (int n = 0; n < 2; ++n) gv[bj][n] = *(const f32x4*)(gp + bj * HALF + n * 16);
#pragma unroll
        for (int ai = 0; ai < 2; ++ai) {
            f32x4 xv[4][2][2];
#pragma unroll
            for (int m = 0; m < 4; ++m) { const size_t off = (row0 + ai * HALF + m * 16) * 1024 + col0;
#pragma unroll
                for (int bj = 0; bj < 2; ++bj)
#pragma unroll
                    for (int n = 0; n < 2; ++n) xv[m][bj][n] = *(const f32x4*)(x + off + bj * HALF + n * 16); }
            asm volatile("" ::: "memory");
#pragma unroll
            for (int m = 0; m < 4; ++m) { const size_t off = (row0 + ai * HALF + m * 16) * 1024 + col0;
#pragma unroll
                for (int bj = 0; bj < 2; ++bj)
#pragma unroll
                    for (int n = 0; n < 2; ++n) *(f32x4*)(out + off + bj * HALF + n * 16) = xv[m][bj][n] + gv[bj][n] * acc[ai][bj][m][n]; }
            asm volatile("" ::: "memory"); }
    }
};

template <class Epi, class Sched, bool ALIGN_EPI = false, bool SP2 = false>
__device__ __forceinline__ void gemm_phase(PG8_LAS unsigned char* lds, const Gemm g, const Sched& S, const Epi& E) {
    int tid_ = threadIdx.x; asm volatile("" : "+v"(tid_));
    const int tid = tid_, wid = __builtin_amdgcn_readfirstlane(tid >> 6), lane = tid & 63, wr = wid >> 2, wc = wid & 3, fr = lane & 15, fq = lane >> 4;
    const int K = g.K, nt = K / BK;
    unsigned voffA[2], voffB[2];
#pragma unroll
    for (int i = 0; i < 2; ++i) { int R, C; stage_rc(tid * 16 + i * 8192, R, C); const int Rb = Epi::PERM ? ((R & ~31) + perm32(R & 31)) : R;
        voffA[i] = (unsigned)(R * K + C) * 2u; voffB[i] = (unsigned)(Rb * K + C) * 2u; }
    const size_t kstep = (size_t)(BK * 2);
    const size_t hstep = (size_t)HALF * K * 2;
    const size_t tstep = 2 * hstep;
    const unsigned ldsw = (unsigned)wid * 1024u;
    const int aoff = lds_byte(wr * 64 + fr, fq * 8), boff = lds_byte(wc * 32 + fr, fq * 8);
#define PG8_SA(b, h) (((b) * 2 + (h)) * HTB)
#define PG8_SB(b, h) ((4 + (b) * 2 + (h)) * HTB)
#define PG8_STAGE(bufoff, gbase, voff) do { _Pragma("unroll") for (int _i = 0; _i < 2; ++_i) \
        __builtin_amdgcn_global_load_lds((const unsigned*)((const char*)(gbase) + (voff)[_i]), (PG8_LAS unsigned*)(lds + (bufoff) + ldsw + _i * 8192), 16, 0, 0); } while (0)
#define PG8_LDA(dst, b, h) do { _Pragma("unroll") for (int m = 0; m < 4; ++m) _Pragma("unroll") for (int k = 0; k < 2; ++k) dst[m][k] = *(const PG8_LAS bf16x8*)(lds + PG8_SA(b, h) + aoff + m * 2048 + k * 1024); } while (0)
#define PG8_LDB(dst, b, h) do { _Pragma("unroll") for (int n = 0; n < 2; ++n) _Pragma("unroll") for (int k = 0; k < 2; ++k) dst[n][k] = *(const PG8_LAS bf16x8*)(lds + PG8_SB(b, h) + boff + n * 2048 + k * 1024); } while (0)
#define PG8_MMA(ai, bj, At, Bt) do { __builtin_amdgcn_s_setprio(1); _Pragma("unroll") for (int m = 0; m < 4; ++m) _Pragma("unroll") for (int n = 0; n < 2; ++n) _Pragma("unroll") for (int k = 0; k < 2; ++k) \
        acc[ai][bj][m][n] = __builtin_amdgcn_mfma_f32_16x16x32_bf16(Bt[n][k], At[m][k], acc[ai][bj][m][n], 0, 0, 0); __builtin_amdgcn_s_setprio(0); } while (0)
#define PG8_WAIT_V(n) asm volatile("s_waitcnt vmcnt(" #n ")" ::: "memory")
#define PG8_WAIT_L(n) asm volatile("s_waitcnt lgkmcnt(" #n ")" ::: "memory")
#define PG8_BAR __builtin_amdgcn_s_barrier()
#define PG8_SCHED __builtin_amdgcn_sched_barrier(0)
    Unit cur, nxt; int ui = 0;
    if (!S.next(0, cur)) return;
    f32x4 acc[2][2][4][2];
#pragma unroll
    for (int a = 0; a < 2; ++a)
#pragma unroll
        for (int b = 0; b < 2; ++b)
#pragma unroll
            for (int m = 0; m < 4; ++m)
#pragma unroll
                for (int n = 0; n < 2; ++n) acc[a][b][m][n] = (f32x4){0.f, 0.f, 0.f, 0.f};
    bf16x8 At[4][2], B0[2][2], B1[2][2];
    const char* cA = (const char*)g.A + (size_t)cur.pm * tstep; const char* cB = (const char*)g.Bt + (size_t)cur.pn * tstep;
    S.a_ready(cur);
    if constexpr (SP2) {
        PG8_STAGE(PG8_SB(0, 0), cB, voffB); PG8_STAGE(PG8_SB(0, 1), cB + hstep, voffB); PG8_STAGE(PG8_SA(0, 0), cA, voffA); PG8_STAGE(PG8_SA(0, 1), cA + hstep, voffA);
        if (wr == 1) PG8_BAR;
        PG8_WAIT_V(2); PG8_BAR;
        PG8_STAGE(PG8_SB(1, 0), cB + kstep, voffB); PG8_STAGE(PG8_SA(1, 0), cA + kstep, voffA); PG8_STAGE(PG8_SB(1, 1), cB + hstep + kstep, voffB);
        PG8_WAIT_V(6); PG8_BAR;
    } else {
        PG8_STAGE(PG8_SB(0, 0), cB, voffB); PG8_STAGE(PG8_SA(0, 0), cA, voffA); PG8_STAGE(PG8_SB(0, 1), cB + hstep, voffB); PG8_STAGE(PG8_SA(0, 1), cA + hstep, voffA);
        if (wr == 1) PG8_BAR;
        PG8_WAIT_V(4); PG8_BAR;
        PG8_STAGE(PG8_SB(1, 0), cB + kstep, voffB); PG8_STAGE(PG8_SA(1, 0), cA + kstep, voffA); PG8_STAGE(PG8_SB(1, 1), cB + hstep + kstep, voffB);
        PG8_WAIT_V(6); PG8_BAR;
    }
    for (;;) {
        const bool has_next = S.next(ui + 1, nxt);
        const char* nA = has_next ? (const char*)g.A + (size_t)nxt.pm * tstep : cA; const char* nB = has_next ? (const char*)g.Bt + (size_t)nxt.pn * tstep : cB;
        for (int t = 0; t < nt; t += 2) {
            if constexpr (Epi::MID) { if (t == nt / 2) E.mid(acc, cur, wr, wc, fr, fq); }
            const bool last = (t == nt - 2);
            const char* a1 = cA + (size_t)(t + 1) * kstep;
            const char* a2 = last ? nA : cA + (size_t)(t + 2) * kstep; const char* b2 = last ? nB : cB + (size_t)(t + 2) * kstep;
            const char* a3 = a2 + kstep; const char* b3 = b2 + kstep;
            if (last && has_next) S.a_ready(nxt);
            if constexpr (SP2) {
            PG8_LDB(B0, 0, 0); PG8_LDB(B1, 0, 1); PG8_SCHED; PG8_LDA(At, 0, 0); PG8_STAGE(PG8_SA(1, 1), a1 + hstep, voffA);
            PG8_WAIT_V(8); PG8_WAIT_L(0); PG8_BAR; PG8_MMA(0, 0, At, B0); PG8_MMA(0, 1, At, B1); PG8_BAR; PG8_SCHED;
            PG8_LDA(At, 0, 1); PG8_STAGE(PG8_SB(0, 0), b2, voffB); PG8_STAGE(PG8_SB(0, 1), b2 + hstep, voffB); PG8_STAGE(PG8_SA(0, 0), a2, voffA);
            PG8_WAIT_V(8); PG8_WAIT_L(0); PG8_BAR; PG8_MMA(1, 0, At, B0); PG8_MMA(1, 1, At, B1); PG8_BAR; PG8_SCHED;
            PG8_LDB(B0, 1, 0); PG8_LDB(B1, 1, 1); PG8_SCHED; PG8_LDA(At, 1, 0); PG8_STAGE(PG8_SA(0, 1), a2 + hstep, voffA);
            PG8_WAIT_V(8); PG8_WAIT_L(0); PG8_BAR; PG8_MMA(0, 0, At, B0); PG8_MMA(0, 1, At, B1); PG8_BAR; PG8_SCHED;
            PG8_LDA(At, 1, 1); PG8_STAGE(PG8_SB(1, 0), b3, voffB); PG8_STAGE(PG8_SB(1, 1), b3 + hstep, voffB); PG8_STAGE(PG8_SA(1, 0), a3, voffA);
            PG8_WAIT_V(8); PG8_WAIT_L(0); PG8_BAR; PG8_MMA(1, 0, At, B0); PG8_MMA(1, 1, At, B1); PG8_BAR; PG8_SCHED;
            } else {
            PG8_LDB(B0, 0, 0); PG8_SCHED; PG8_LDA(At, 0, 0); PG8_STAGE(PG8_SA(1, 1), a1 + hstep, voffA);
            PG8_WAIT_L(8); PG8_BAR; PG8_WAIT_L(0); PG8_MMA(0, 0, At, B0); PG8_BAR; PG8_SCHED;
            PG8_LDB(B1, 0, 1); PG8_STAGE(PG8_SB(0, 0), b2, voffB);
            PG8_BAR; PG8_WAIT_L(0); PG8_MMA(0, 1, At, B1); PG8_BAR;
            PG8_LDA(At, 0, 1); PG8_STAGE(PG8_SA(0, 0), a2, voffA);
            PG8_BAR; PG8_WAIT_L(0); PG8_MMA(1, 0, At, B0); PG8_BAR; PG8_SCHED;
            PG8_STAGE(PG8_SB(0, 1), b2 + hstep, voffB);
            PG8_WAIT_V(6); PG8_BAR; PG8_MMA(1, 1, At, B1); PG8_BAR;
            PG8_LDB(B0, 1, 0); PG8_SCHED; PG8_LDA(At, 1, 0); PG8_STAGE(PG8_SA(0, 1), a2 + hstep, voffA);
            PG8_WAIT_L(8); PG8_BAR; PG8_WAIT_L(0); PG8_MMA(0, 0, At, B0); PG8_BAR; PG8_SCHED;
            PG8_LDB(B1, 1, 1); PG8_STAGE(PG8_SB(1, 0), b3, voffB);
            PG8_BAR; PG8_WAIT_L(0); PG8_MMA(0, 1, At, B1); PG8_BAR;
            PG8_LDA(At, 1, 1); PG8_STAGE(PG8_SA(1, 0), a3, voffA);
            PG8_BAR; PG8_WAIT_L(0); PG8_MMA(1, 0, At, B0); PG8_BAR; PG8_SCHED;
            PG8_STAGE(PG8_SB(1, 1), b3 + hstep, voffB);
            PG8_WAIT_V(6); PG8_BAR; PG8_MMA(1, 1, At, B1); PG8_BAR;
            }
        }
        if constexpr (ALIGN_EPI) { if (wr == 0) PG8_BAR; }
        if constexpr (!Epi::AFTER_DRAIN) { E(acc, cur, wr, wc, fr, fq); S.done(cur); }
        if (!has_next) break;
#pragma unroll
        for (int a = 0; a < 2; ++a)
#pragma unroll
            for (int b = 0; b < 2; ++b)
#pragma unroll
                for (int m = 0; m < 4; ++m)
#pragma unroll
                    for (int n = 0; n < 2; ++n) acc[a][b][m][n] = (f32x4){0.f, 0.f, 0.f, 0.f};
        cur = nxt; cA = nA; cB = nB; ++ui;
        if constexpr (ALIGN_EPI) { if (wr == 1) PG8_BAR; }
    }
    PG8_WAIT_V(0);
    if constexpr (!ALIGN_EPI) { if (wr == 0) PG8_BAR; }
    PG8_BAR;
    if constexpr (Epi::AFTER_DRAIN) { E.fused(acc, cur, wr, wc, fr, fq, lds, wid, lane); S.done(cur); }
#undef PG8_SA
#undef PG8_SB
#undef PG8_STAGE
#undef PG8_LDA
#undef PG8_LDB
#undef PG8_MMA
#undef PG8_WAIT_V
#undef PG8_WAIT_L
#undef PG8_BAR
#undef PG8_SCHED
}
}

#ifndef PG8_SP2
#define PG8_SP2 true
#endif
#ifndef PG8_ALIGN
#define PG8_ALIGN true
#endif
#include <hip/hip_bf16.h>
#include <cmath>
namespace attn_body {
using bf16=__hip_bfloat16;
using bf16x8=__attribute__((ext_vector_type(8)))short;
using s16x4=__attribute__((ext_vector_type(4)))short;
using f32x16=__attribute__((ext_vector_type(16)))float;
using u32x4=__attribute__((ext_vector_type(4)))unsigned;
using f32x4v=__attribute__((ext_vector_type(4)))float;
constexpr int BATCH=8,NHEAD=8,SEQ=4096,D=64,DM=NHEAD*D;
constexpr int NW=8,QBLK=32,QB=QBLK*NW,KVBLK=64,NQB=SEQ/QB;
constexpr int ATTN_PITCH=DM, ATTN_UNIT_ROWS=QB, OPITCH=1024;
__device__ __forceinline__ int crow(int r,int hi){return (r&3)+8*(r>>2)+4*hi;}
#define SBAR() __builtin_amdgcn_sched_barrier(0)
__device__ __forceinline__ void cmask(f32x16&p0,f32x16&p1,int jb,int qrel,int hi){
  const float NEG=-INFINITY; int kb=64*jb+4*hi;
  #pragma unroll
  for(int r=0;r<16;++r){int kv=kb+(r&3)+8*(r>>2); if(kv>qrel)p0[r]=NEG; if(kv+32>qrel)p1[r]=NEG;}
}

constexpr int NSLOT=3, SLOTB=8192;
constexpr int LDS_K=0, LDS_V=NSLOT*SLOTB, LDS_WS=2*NSLOT*SLOTB, LDS_OST=LDS_WS+NW*64*4, LDS_BIAS=LDS_OST+NW*4096, LDS_BYTES=LDS_BIAS+SEQ*4;
constexpr float C2=0.125f*1.4426950408889634f;
__device__ __forceinline__ void glds16(const void*gsrc,unsigned lds_dst){unsigned keep;
  asm volatile("s_mov_b32 %0, m0\n\ts_mov_b32 m0, %2\n\ts_nop 0\n\tglobal_load_lds_dwordx4 %1, off\n\ts_mov_b32 m0, %0":"=&s"(keep):"v"(gsrc),"s"(lds_dst):"memory");}
__device__ __forceinline__ float max3f(float a,float b,float c){float r;asm("v_max3_f32 %0, %1, %2, %3":"=v"(r):"v"(a),"v"(b),"v"(c));return r;}
__device__ __forceinline__ float max2f(float a,float b){float r;asm("v_max_f32_e32 %0, %1, %2":"=v"(r):"v"(a),"v"(b));return r;}
__device__ __forceinline__ float fadd_s(float a,float b){float r;asm("v_add_f32_e32 %0, %1, %2":"=v"(r):"v"(a),"v"(b));return r;}
__device__ __forceinline__ float fsub_s(float a,float b){float r;asm("v_sub_f32_e32 %0, %1, %2":"=v"(r):"v"(a),"v"(b));return r;}
typedef float f32x2_t __attribute__((ext_vector_type(2))); typedef __bf16 bf16x2_t __attribute__((ext_vector_type(2)));
__device__ __forceinline__ unsigned cvtpk_s(float lo,float hi){f32x2_t v={lo,hi};bf16x2_t b=__builtin_convertvector(v,bf16x2_t);return __builtin_bit_cast(unsigned,b);}
#define WAIT_BAR(N) asm volatile("s_waitcnt vmcnt(" #N ") lgkmcnt(0)\n\ts_barrier":::"memory")

__device__ __forceinline__ void qkt(f32x16&p0,f32x16&p1,const char*Kslot,const bf16x8*qr,int r32,int hi){
  const char*kb=Kslot+hi*1024+r32*16;
  #pragma unroll
  for(int d0=0;d0<4;++d0){
    const bf16x8 b0=*reinterpret_cast<const bf16x8*>(kb+d0*2048);
    const bf16x8 b1=*reinterpret_cast<const bf16x8*>(kb+d0*2048+512);
    p0=__builtin_amdgcn_mfma_f32_32x32x16_bf16(b0,qr[d0],p0,0,0,0);p1=__builtin_amdgcn_mfma_f32_32x32x16_bf16(b1,qr[d0],p1,0,0,0);}
}
typedef __attribute__((address_space(3))) const char* lds_cptr;
typedef short v4i16_t __attribute__((ext_vector_type(4)));
__device__ __forceinline__ void kload8(bf16x8*kf,lds_cptr kp){
  kf[0]=*(const __attribute__((address_space(3))) bf16x8*)(kp);      kf[1]=*(const __attribute__((address_space(3))) bf16x8*)(kp+512);
  kf[2]=*(const __attribute__((address_space(3))) bf16x8*)(kp+2048); kf[3]=*(const __attribute__((address_space(3))) bf16x8*)(kp+2560);
  kf[4]=*(const __attribute__((address_space(3))) bf16x8*)(kp+4096); kf[5]=*(const __attribute__((address_space(3))) bf16x8*)(kp+4608);
  kf[6]=*(const __attribute__((address_space(3))) bf16x8*)(kp+6144); kf[7]=*(const __attribute__((address_space(3))) bf16x8*)(kp+6656);
}
__device__ __forceinline__ void kload2(bf16x8*kf,lds_cptr kp,int j){ kf[2*j]=*(const __attribute__((address_space(3))) bf16x8*)(kp+j*2048); kf[2*j+1]=*(const __attribute__((address_space(3))) bf16x8*)(kp+j*2048+512); }
__device__ __forceinline__ s16x4 vtr(lds_cptr p){ return __builtin_bit_cast(s16x4,__builtin_amdgcn_ds_read_tr16_b64_v4i16((__attribute__((address_space(3))) v4i16_t*)p)); }
__device__ __forceinline__ float rowmax(const f32x16&p0,const f32x16&p1){
  float a=max3f(p0[0],p0[1],p1[0]),b=max3f(p0[2],p0[3],p1[1]);a=max3f(a,p1[2],p1[3]);
  #pragma unroll
  for(int r=4;r<16;r+=4){a=max3f(a,p0[r],p0[r+1]);b=max3f(b,p0[r+2],p0[r+3]);a=max3f(a,p1[r],p1[r+1]);b=max3f(b,p1[r+2],p1[r+3]);}
  const float m=max2f(a,b);
  auto rr=__builtin_amdgcn_permlane32_swap(__float_as_uint(m),__float_as_uint(m),false,false);
  return max2f(__uint_as_float(rr[0]),__uint_as_float(rr[1]));
}
__device__ __forceinline__ void pv(f32x16*o,int vb,bf16x8 pa0,bf16x8 pa1,bf16x8 pa2,bf16x8 pa3){
  #pragma unroll
  for(int d0=0;d0<2;++d0){s16x4 lo[4],hi[4];
    #pragma unroll
    for(int ks=0;ks<4;++ks){
      asm volatile("ds_read_b64_tr_b16 %0,%1 offset:%c2":"=&v"(lo[ks]):"v"(vb),"i"(d0*4096+ks*1024):"memory");
      asm volatile("ds_read_b64_tr_b16 %0,%1 offset:%c2":"=&v"(hi[ks]):"v"(vb),"i"(d0*4096+ks*1024+512):"memory");}
    asm volatile("s_waitcnt lgkmcnt(0)":::"memory");SBAR();
    #define PK(k) (bf16x8){lo[k][0],lo[k][1],lo[k][2],lo[k][3],hi[k][0],hi[k][1],hi[k][2],hi[k][3]}
    o[d0]=__builtin_amdgcn_mfma_f32_32x32x16_bf16(pa0,PK(0),o[d0],0,0,0);
    o[d0]=__builtin_amdgcn_mfma_f32_32x32x16_bf16(pa1,PK(1),o[d0],0,0,0);
    o[d0]=__builtin_amdgcn_mfma_f32_32x32x16_bf16(pa2,PK(2),o[d0],0,0,0);
    o[d0]=__builtin_amdgcn_mfma_f32_32x32x16_bf16(pa3,PK(3),o[d0],0,0,0);
    #undef PK
  }
}

#ifndef ATTN_STORE16
#define ATTN_STORE16(p,v) (*(u32x4*)(p)=(v))
#endif
struct AttnTensors { unsigned char* ws; size_t oq,ok,ov,oz,olf,oo,obias,oj0; float gap,hdr; };
template<int THRL> __device__ __forceinline__ void attn_unit(int b,int h,int qb,int j0,f32x4v brow0,f32x4v brow1,unsigned*ctr,unsigned&nxt,int snext,const AttnTensors&T_,char*shm){
  const bf16*Q=(const bf16*)(T_.ws+T_.oq); const bf16*__restrict__ K=(const bf16*)(T_.ws+T_.ok); const bf16*__restrict__ V=(const bf16*)(T_.ws+T_.ov);
  const int tid=threadIdx.x,lane=tid&63,r32=lane&31,hi=lane>>5; const int wid=__builtin_amdgcn_readfirstlane(tid>>6);
  const long rowbase=(long)b*SEQ; const int q0=qb*QB;
  const bf16*Qw=Q+(rowbase+q0+wid*QBLK)*DM+h*D;
  const bf16*Kh=K+(rowbase+(long)j0*KVBLK)*DM+h*D,*Vh=V+(rowbase+(long)j0*KVBLK)*DM+h*D;
  const unsigned lds0=(unsigned)(uintptr_t)shm;
  float*wsf=(float*)(shm+LDS_WS)+wid*64;
  const bf16*ksrc=Kh+(long)lane*DM+wid*8;
  const bf16*vsrc=Vh+(long)(16*(wid&3)+(lane>>2))*DM+(wid>>2)*32+(lane&3)*8;
  const unsigned kdst=lds0+LDS_K+wid*1024, vdst=lds0+LDS_V+wid*1024;
  #define DMA_K(t,slot) glds16(ksrc+(long)(t)*KVBLK*DM,(unsigned)__builtin_amdgcn_readfirstlane(kdst+(slot)))
  #define DMA_V(t,slot) glds16(vsrc+(long)(t)*KVBLK*DM,(unsigned)__builtin_amdgcn_readfirstlane(vdst+(slot)))
  const int vb0=(int)(lds0+LDS_V)+((lane>>4)&1)*32+(lane&3)*8+(4*hi+((lane&15)>>2))*64;
  const char*Kbase=shm+LDS_K; bf16x8 kf[8];
  const lds_cptr shm3=(lds_cptr)shm; const lds_cptr kp0=shm3+LDS_K+hi*1024+r32*16; const lds_cptr vp0=shm3+LDS_V+((lane>>4)&1)*32+(lane&3)*8+(4*hi+((lane&15)>>2))*64;
  const int NT=(q0+QB)/KVBLK-j0;
  DMA_K(0,0);DMA_V(0,0);DMA_K(1,SLOTB);
  bf16x8 qr[4];
  #pragma unroll
  for(int d0=0;d0<4;++d0)qr[d0]=*reinterpret_cast<const bf16x8*>(&Qw[(long)r32*DM+d0*16+hi*8]);
  float mhat=0.f,l_reg=0.f;f32x16 o[2];o[0]=f32x16{};o[1]=f32x16{};
  const lds_cptr bp0=shm3+LDS_BIAS+hi*16+j0*256;
  #define BL(P,t,g,off) do{ const f32x4v a_=*(const __attribute__((address_space(3))) f32x4v*)(bp0+(t)*256+(off)+(g)*32); P[4*(g)]=a_[0];P[4*(g)+1]=a_[1];P[4*(g)+2]=a_[2];P[4*(g)+3]=a_[3]; }while(0)
  #define BS(P,g) do{ P[4*(g)]-=mhat;P[4*(g)+1]-=mhat;P[4*(g)+2]-=mhat;P[4*(g)+3]-=mhat; }while(0)
  #define BINIT(P0,P1,t) do{ _Pragma("unroll") for(int g_=0;g_<4;++g_){BL(P0,t,g_,0);BL(P1,t,g_,128);} _Pragma("unroll") for(int g_=0;g_<4;++g_){BS(P0,g_);BS(P1,g_);} }while(0)
  const int qrel=wid*QBLK+r32;
  #define CMASK(P0,P1,t) do{int jb_=(t)-(NT-4); if(jb_>=0)cmask(P0,P1,jb_,qrel,hi);}while(0)
  bool resc=false;
  #define START(P0,P1) do{ resc=false; \
    if(THRL>=0){ const float rm=rowmax(P0,P1); if(__builtin_expect(__any(rm>(float)THRL),0)){ const float dl=__builtin_fmaxf(rm,0.f); mhat=fadd_s(mhat,dl); \
      _Pragma("unroll") for(int r=0;r<16;++r){P0[r]=fsub_s(P0[r],dl);P1[r]=fsub_s(P1[r],dl);} } } \
    _Pragma("unroll") for(int r=0;r<16;++r)P0[r]=__builtin_amdgcn_exp2f(P0[r]); }while(0)
  #define RESC() do{ if(resc){ asm volatile("s_waitcnt lgkmcnt(0)":::"memory"); \
      _Pragma("unroll") for(int d_=0;d_<2;++d_) _Pragma("unroll") for(int r=0;r<16;++r)o[d_][r]*=wsf[crow(r,hi)]; } }while(0)
  f32x16 pA0,pA1,pB0,pB1;
  int sl_prev=0,sl_cur=0,sl_next=SLOTB;
  #define ROT() do{sl_prev=sl_cur;sl_cur=sl_next;sl_next=(sl_next==(NSLOT-1)*SLOTB)?0:sl_next+SLOTB;}while(0)
  DMA_K(2,2*SLOTB);
  { __attribute__((address_space(3))) f32x4v*bd=(__attribute__((address_space(3))) f32x4v*)((__attribute__((address_space(3))) char*)shm+LDS_BIAS)+tid*2; bd[0]=brow0; bd[1]=brow1; }
  if(tid==0){ if(snext>=0)nxt=(unsigned)snext; else nxt=2u*gridDim.x+__hip_atomic_fetch_add(ctr,1u,__ATOMIC_RELAXED,__HIP_MEMORY_SCOPE_AGENT); }
  WAIT_BAR(3);
  mhat=((const __attribute__((address_space(3))) float*)(shm3+LDS_BIAS))[q0+qrel]+T_.hdr;
  BINIT(pA0,pA1,0);
  qkt(pA0,pA1,Kbase,qr,r32,hi);asm volatile("s_nop 15\n\ts_nop 7":"+v"(pA0),"+v"(pA1));CMASK(pA0,pA1,0);
  START(pA0,pA1);
  BINIT(pB0,pB1,1);
  _Pragma("unroll") for(int r=0;r<16;++r)pA1[r]=__builtin_amdgcn_exp2f(pA1[r]);
  WAIT_BAR(0);
  DMA_K(3,0);DMA_V(1,SLOTB);
  ROT();
  kload8(kf,kp0+sl_cur);
  WAIT_BAR(2);
  s16x4 vlo[8],vhi[8]; u32x4 pw0,pw1,pw2,pw3;
  #define PKW(P,B) cvtpk_s(P[B],P[B+1])
  #define PAF(k) __builtin_bit_cast(bf16x8,pw##k)
  #define VFR(i) (bf16x8){vlo[i][0],vlo[i][1],vlo[i][2],vlo[i][3],vhi[i][0],vhi[i][1],vhi[i][2],vhi[i][3]}
  #define PIN(x) asm volatile("":"+v"(x))
  #define MX3(a,b,c) __builtin_fmaxf(__builtin_fmaxf((a),(b)),(c))
  #define GAPA(MF,A0,A1,A2,A3,W0,W1,PW) do{ MF; sacc+=A0; sacc+=A1; sacc+=A2; sacc+=A3; PIN(sacc); W0; W1; PIN(PW); SBAR(); }while(0)
  #define EX(v) __builtin_amdgcn_exp2f(v)
  #define GAPB(MF,X,B,E0,E1) do{ MF; X[B]=EX(X[B]); X[B+1]=EX(X[B+1]); X[B+2]=EX(X[B+2]); X[B+3]=EX(X[B+3]); PIN(X); E0; E1; SBAR(); }while(0)
  #define BLG(G,P,t,g,off) do{ if(G){ BL(P,t,g,off); } }while(0)
  #define BSG(G,P,g) do{ if(G){ BS(P,g); } }while(0)
  #define VRD(i) do{ vlo[i]=vtr(vp_+(((i)>>2)*4096+((i)&3)*1024)); vhi[i]=vtr(vp_+(((i)>>2)*4096+((i)&3)*1024+512)); }while(0)
  #define KRD(G,j) do{ if(G){ kload2(kf,kp0+sl_next,j); SBAR(); } }while(0)
  #define STEP(C0,C1,P0,P1,t,GK,GV,GL) do{ SBAR(); \
    const lds_cptr vp_=vp0+sl_prev; \
    VRD(0); SBAR(); float sacc=(P0[0]+P0[1]); \
    GAPA(C0=__builtin_amdgcn_mfma_f32_32x32x16_bf16(kf[0],qr[0],C0,0,0,0), P0[2],P0[3],P0[4],P0[5],     pw0[0]=PKW(P0,0), pw0[1]=PKW(P0,2), pw0); \
    VRD(4); SBAR(); GAPA(C1=__builtin_amdgcn_mfma_f32_32x32x16_bf16(kf[1],qr[0],C1,0,0,0), P0[6],P0[7],P0[8],P0[9],     pw0[2]=PKW(P0,4), pw0[3]=PKW(P0,6), pw0); \
    VRD(1); SBAR(); GAPA(C0=__builtin_amdgcn_mfma_f32_32x32x16_bf16(kf[2],qr[1],C0,0,0,0),   P0[10],P0[11],P0[12],P0[13], pw1[0]=PKW(P0,8), pw1[1]=PKW(P0,10), pw1); \
    VRD(5); SBAR(); GAPA(C1=__builtin_amdgcn_mfma_f32_32x32x16_bf16(kf[3],qr[1],C1,0,0,0),   P0[14],P0[15],P1[0],P1[1],   pw1[2]=PKW(P0,12),pw1[3]=PKW(P0,14), pw1); \
    VRD(2); SBAR(); GAPA(C0=__builtin_amdgcn_mfma_f32_32x32x16_bf16(kf[4],qr[2],C0,0,0,0),   P1[2],P1[3],P1[4],P1[5],     pw2[0]=PKW(P1,0), pw2[1]=PKW(P1,2), pw2); \
    VRD(6); SBAR(); GAPA(C1=__builtin_amdgcn_mfma_f32_32x32x16_bf16(kf[5],qr[2],C1,0,0,0),   P1[6],P1[7],P1[8],P1[9],     pw2[2]=PKW(P1,4), pw2[3]=PKW(P1,6), pw2); \
    VRD(3); SBAR(); GAPA(C0=__builtin_amdgcn_mfma_f32_32x32x16_bf16(kf[6],qr[3],C0,0,0,0),   P1[10],P1[11],P1[12],P1[13], pw3[0]=PKW(P1,8), pw3[1]=PKW(P1,10), pw3); \
    VRD(7); SBAR(); GAPA(C1=__builtin_amdgcn_mfma_f32_32x32x16_bf16(kf[7],qr[3],C1,0,0,0),   P1[14],P1[15],0.f,0.f,       pw3[2]=PKW(P1,12),pw3[3]=PKW(P1,14), pw3); \
    l_reg+=sacc; \
    if(GK){DMA_K((t)+3,sl_cur);} if(GV){DMA_V((t)+1,sl_next);} \
    CMASK(C0,C1,t); \
    if(THRL>=0){ float a=MX3(C0[0],C0[1],C1[0]),b=MX3(C0[2],C0[3],C1[1]); a=MX3(a,C1[2],C1[3]); \
      _Pragma("unroll") for(int r=4;r<16;r+=4){a=MX3(a,C0[r],C0[r+1]);b=MX3(b,C0[r+2],C0[r+3]);a=MX3(a,C1[r],C1[r+1]);b=MX3(b,C1[r+2],C1[r+3]);} \
      float rm=__builtin_fmaxf(a,b); { auto rr=__builtin_amdgcn_permlane32_swap(__float_as_uint(rm),__float_as_uint(rm),false,false); rm=__builtin_fmaxf(__uint_as_float(rr[0]),__uint_as_float(rr[1])); } \
      resc=false; \
      if(__builtin_expect(__any(rm>(float)THRL),0)){ const float dl=__builtin_fmaxf(rm,0.f); mhat+=dl; \
        _Pragma("unroll") for(int r=0;r<16;++r){C0[r]-=dl;C1[r]-=dl;} \
        const float f=__builtin_amdgcn_exp2f(-dl); l_reg*=f; if(hi==0)wsf[r32]=f; resc=true; } } \
    SBAR(); \
    GAPB(o[0]=__builtin_amdgcn_mfma_f32_32x32x16_bf16(PAF(0),VFR(0),o[0],0,0,0), C0,0,  BLG(GL,P0,(t)+1,0,0),  BLG(GL,P0,(t)+1,1,0)); \
    GAPB(o[1]=__builtin_amdgcn_mfma_f32_32x32x16_bf16(PAF(0),VFR(4),o[1],0,0,0), C0,4,  BLG(GL,P0,(t)+1,2,0),  BLG(GL,P0,(t)+1,3,0)); \
    KRD(GL,0); GAPB(o[0]=__builtin_amdgcn_mfma_f32_32x32x16_bf16(PAF(1),VFR(1),o[0],0,0,0), C0,8,  BLG(GL,P1,(t)+1,0,128), BLG(GL,P1,(t)+1,1,128)); \
    KRD(GL,1); GAPB(o[1]=__builtin_amdgcn_mfma_f32_32x32x16_bf16(PAF(1),VFR(5),o[1],0,0,0), C0,12, BLG(GL,P1,(t)+1,2,128), BLG(GL,P1,(t)+1,3,128)); \
    KRD(GL,2); GAPB(o[0]=__builtin_amdgcn_mfma_f32_32x32x16_bf16(PAF(2),VFR(2),o[0],0,0,0), C1,0,  BSG(GL,P0,0), BSG(GL,P0,1)); \
    KRD(GL,3); GAPB(o[1]=__builtin_amdgcn_mfma_f32_32x32x16_bf16(PAF(2),VFR(6),o[1],0,0,0), C1,4,  BSG(GL,P0,2), BSG(GL,P0,3)); \
    GAPB(o[0]=__builtin_amdgcn_mfma_f32_32x32x16_bf16(PAF(3),VFR(3),o[0],0,0,0), C1,8,  BSG(GL,P1,0), BSG(GL,P1,1)); \
    GAPB(o[1]=__builtin_amdgcn_mfma_f32_32x32x16_bf16(PAF(3),VFR(7),o[1],0,0,0), C1,12, BSG(GL,P1,2), BSG(GL,P1,3)); \
    }while(0)
  int t=1;
  #undef CMASK
  #define CMASK(P0,P1,t) do{}while(0)
  for(;t+5<NT;t+=2){
    STEP(pB0,pB1,pA0,pA1,t,true,true,true);     WAIT_BAR(2); RESC(); ROT();
    STEP(pA0,pA1,pB0,pB1,t+1,true,true,true);   WAIT_BAR(2); RESC(); ROT();
  }
  #undef CMASK
  #define CMASK(P0,P1,t) do{int jb_=(t)-(NT-4); if(jb_>=0)cmask(P0,P1,jb_,qrel,hi);}while(0)
  #define ENDW(tt) do{ if((tt)+3<NT){WAIT_BAR(2);} else if((tt)+2<NT){WAIT_BAR(1);} else {WAIT_BAR(0);} }while(0)
  for(;t+1<NT;t+=2){
    STEP(pB0,pB1,pA0,pA1,t,(t+3<NT),(t+1<NT),(t+1<NT));       ENDW(t);   RESC(); ROT();
    STEP(pA0,pA1,pB0,pB1,t+1,(t+4<NT),(t+2<NT),(t+2<NT));     ENDW(t+1); RESC(); ROT();
  }
  STEP(pB0,pB1,pA0,pA1,NT-1,false,false,false); RESC();
  const bf16*Zw=(const bf16*)(T_.ws+T_.oz)+(rowbase+q0+wid*QBLK)*DM+h*D;
  u32x4 zv[4];
  #pragma unroll
  for(int i=0;i<4;++i)zv[i]=*(const u32x4*)(Zw+(long)(i*8+(lane>>3))*DM+(lane&7)*8);
  { float sacc=pB0[0]+pB0[1]; _Pragma("unroll") for(int r=2;r<16;++r)sacc+=pB0[r]; _Pragma("unroll") for(int r=0;r<16;++r)sacc+=pB1[r]; l_reg+=sacc;
    pw0=(u32x4){PKW(pB0,0),PKW(pB0,2),PKW(pB0,4),PKW(pB0,6)};pw1=(u32x4){PKW(pB0,8),PKW(pB0,10),PKW(pB0,12),PKW(pB0,14)};pw2=(u32x4){PKW(pB1,0),PKW(pB1,2),PKW(pB1,4),PKW(pB1,6)};pw3=(u32x4){PKW(pB1,8),PKW(pB1,10),PKW(pB1,12),PKW(pB1,14)};
    SBAR(); pv(o,vb0+sl_cur,PAF(0),PAF(1),PAF(2),PAF(3)); }
  #undef PKW
  #undef PAF
  #undef VFR
  #undef PIN
  #undef MX3
  #undef GAPA
  #undef GAPB
  #undef EX
  #undef VRD
  #undef KRD
  #undef STEP
  #undef ENDW
  {auto rr=__builtin_amdgcn_permlane32_swap(__float_as_uint(l_reg),__float_as_uint(l_reg),false,false);l_reg=__uint_as_float(rr[0])+__uint_as_float(rr[1]);}
  if(hi==0)wsf[32+r32]=l_reg;asm volatile("s_waitcnt lgkmcnt(0)":::"memory");
  float rli[16];
  #pragma unroll
  for(int r=0;r<16;++r)rli[r]=__builtin_amdgcn_rcpf(wsf[32+crow(r,hi)]);
  bf16*Ow=(bf16*)(T_.ws+T_.oo)+(rowbase+q0+wid*QBLK)*OPITCH+h*D;
  { bf16*stg=(bf16*)(shm+LDS_OST)+wid*2048;
    #pragma unroll
    for(int r=0;r<16;++r){const int orow=crow(r,hi);
      #pragma unroll
      for(int d0=0;d0<2;++d0)stg[orow*64+d0*32+r32]=__float2bfloat16(o[d0][r]*rli[r]);}
    asm volatile("s_waitcnt lgkmcnt(0)":::"memory");
    #pragma unroll
    for(int i=0;i<4;++i){const int row=i*8+(lane>>3),ch=lane&7; u32x4 v=*(const u32x4*)(stg+row*64+ch*8);
      #pragma unroll
      for(int e=0;e<4;++e){ const float a0=__uint_as_float(v[e]<<16)*__uint_as_float(zv[i][e]<<16), a1=__uint_as_float(v[e]&0xffff0000u)*__uint_as_float(zv[i][e]&0xffff0000u); v[e]=cvtpk_s(a0,a1); }
      ATTN_STORE16(Ow+(long)row*OPITCH+ch*8,v);} }
  asm volatile("s_waitcnt lgkmcnt(0)\n\ts_barrier":::"memory");
  #undef DMA_K
  #undef DMA_V
  #undef CMASK
  #undef START
  #undef RESC
  #undef ROT
  #undef BL
  #undef BS
  #undef BINIT
  #undef BLG
  #undef BSG
}
constexpr int ATTN_LDS_BYTES=LDS_BYTES;
struct AttnUnit { int bh; int qb; };
__device__ __forceinline__ void bias_scan(char*shm,const float*__restrict__ lf,float*gdst=nullptr){
  const int tid=threadIdx.x,lane=tid&63,wid=tid>>6;
  float*bias=(float*)(shm+LDS_BIAS); float*wtot=(float*)(shm+LDS_WS);
  const f32x4v a=*(const f32x4v*)(lf+tid*8),b=*(const f32x4v*)(lf+tid*8+4);
  const float s0=a[0],s1=s0+a[1],s2=s1+a[2],s3=s2+a[3],s4=s3+b[0],s5=s4+b[1],s6=s5+b[2],s7=s6+b[3];
  float inc=s7;
  #pragma unroll
  for(int o=1;o<64;o<<=1){const float t=__shfl_up(inc,o); if(lane>=o)inc+=t;}
  if(lane==63)wtot[wid]=inc;
  asm volatile("s_waitcnt lgkmcnt(0)\n\ts_barrier":::"memory");
  float base=0.f;
  #pragma unroll
  for(int w=0;w<NW;++w){const float x=wtot[w]; if(w<wid)base+=x;}
  const float off=base+inc-s7; const float NL=-1.4426950408889634f;
  *(f32x4v*)(bias+tid*8)=(f32x4v){(off+s0)*NL,(off+s1)*NL,(off+s2)*NL,(off+s3)*NL};
  *(f32x4v*)(bias+tid*8+4)=(f32x4v){(off+s4)*NL,(off+s5)*NL,(off+s6)*NL,(off+s7)*NL};
  if(gdst){ *(f32x4v*)(gdst+tid*8)=(f32x4v){(off+s0)*NL,(off+s1)*NL,(off+s2)*NL,(off+s3)*NL}; *(f32x4v*)(gdst+tid*8+4)=(f32x4v){(off+s4)*NL,(off+s5)*NL,(off+s6)*NL,(off+s7)*NL}; }
  asm volatile("s_waitcnt lgkmcnt(0)\n\ts_barrier":::"memory");
}
__device__ __forceinline__ void j0_table(const char*shm,float gap,int*dst,int wave,int lane){
  const __attribute__((address_space(3))) float*bl=(const __attribute__((address_space(3))) float*)((const __attribute__((address_space(3))) char*)shm+LDS_BIAS);
  const float v=bl[64*lane+63];
  #pragma unroll
  for(int q=0;q<2;++q){ const int qb=2*wave+q; const float thr=bl[QB*qb]-gap; const unsigned long long mk=__ballot(v>=thr);
    int j0=mk?(int)__builtin_ctzll(mk):0; j0&=~1; const int jmax=4*qb; j0=j0<jmax?j0:jmax; if(lane==0)dst[qb]=j0; }
}
constexpr int LDS_J0=LDS_BIAS+SEQ*4;
static_assert(LDS_J0+4096<=131072,"attention LDS");
template<int THRL,class Extra> __device__ __forceinline__ void attn_phase_dyn(char*lds,const AttnTensors&T,unsigned*ctr,const Extra&X,int nextra){
  const int tid=threadIdx.x;
  volatile __attribute__((address_space(3))) unsigned* uw=(volatile __attribute__((address_space(3))) unsigned*)((__attribute__((address_space(3))) char*)lds+LDS_WS);
  volatile __attribute__((address_space(3))) int* jt=(volatile __attribute__((address_space(3))) int*)((__attribute__((address_space(3))) char*)lds+LDS_J0);
  for(int i=tid;i<BATCH*NHEAD*NQB;i+=NW*64)jt[i]=((const int*)(T.ws+T.oj0))[i];
  const unsigned G_=gridDim.x; unsigned nxt=blockIdx.x; int nstat=1;
  for(;;){
    if(tid==0){uw[0]=nxt;}
    asm volatile("s_waitcnt lgkmcnt(0)\n\ts_barrier":::"memory");
    const unsigned u=(unsigned)__builtin_amdgcn_readfirstlane((int)uw[0]);
    if(u>=(unsigned)(BATCH*NHEAD*NQB+nextra))break;
    if(u>=(unsigned)(BATCH*NHEAD*NQB)){ if(tid==0)nxt=2u*G_+__hip_atomic_fetch_add(ctr,1u,__ATOMIC_RELAXED,__HIP_MEMORY_SCOPE_AGENT);
      X((int)u-BATCH*NHEAD*NQB); asm volatile("s_waitcnt lgkmcnt(0)\n\ts_barrier":::"memory"); continue; }
    const int qb=NQB-1-(int)(u/(BATCH*NHEAD)), bh=(int)(u%(BATCH*NHEAD));
    const int j0=__builtin_amdgcn_readfirstlane((int)jt[bh*NQB+qb]);
    const f32x4v*src=(const f32x4v*)((const float*)(T.ws+T.obias)+(long)bh*SEQ)+tid*2; const f32x4v ba=src[0],bb=src[1];
    attn_unit<THRL>(bh/NHEAD,bh%NHEAD,qb,j0,ba,bb,ctr,nxt,nstat>0?(int)(G_+(blockIdx.x^4u)):-1,T,lds); nstat=0;
  }
}
#undef SBAR
#undef WAIT_BAR
}
constexpr int NWAVES = 8;
#ifndef MK_N_LAUNCHES
#define MK_N_LAUNCHES 1
#endif
constexpr int N_LAUNCHES = MK_N_LAUNCHES;
constexpr int PER_PHASE = 6;

constexpr int BATCH = 8, T = 4096, D = 1024, H = 8, HD = 64, AW = 512, CW = 512, INW = 6152, NPROJ = 6144;
constexpr int M = BATCH * T;
constexpr float EPS = 1e-6f;
constexpr int SRC_F = 1536;

constexpr size_t MiB = 1u << 20;
constexpr size_t WS_ADA = 0;
constexpr size_t WS_WF = 128 * 1024;
constexpr size_t WS_CTL = 256 * 1024;
constexpr int CW_ATTNQ = 3456 + 128;
constexpr size_t WS_LF = 1 * MiB;
constexpr size_t WS_W1 = 2 * MiB;
constexpr size_t WS_WAB = 14 * MiB, WS_WO = 16 * MiB;
constexpr size_t WS_HB = 32 * MiB;
constexpr size_t WS_OAB = WS_HB;
constexpr size_t WS_Q = pg8::OFF_Q;
constexpr size_t WS_K = pg8::OFF_K, WS_V = pg8::OFF_V;
constexpr size_t WS_MG = WS_K;
constexpr size_t WS_SZA = pg8::OFF_SZA, WS_CU = pg8::OFF_CU, WS_GZ = pg8::OFF_GZ;
constexpr size_t WS_R = pg8::OFF_SGA, WS_SGB = pg8::OFF_SGB;
constexpr size_t WS_BIAS = 448 * MiB;
constexpr size_t WS_J0 = 449 * MiB;
constexpr size_t WS_END = 450 * MiB;

constexpr int RING_OFF = 0, RING_BYTES = 131072;
constexpr int MISC_OFF = RING_BYTES + 320;
constexpr int LDS_BYTES = 147456;
static_assert(attn_body::ATTN_LDS_BYTES <= RING_BYTES, "attention LDS");

#define GAS __attribute__((address_space(1)))
#define LAS __attribute__((address_space(3)))
typedef unsigned short bf16;
typedef unsigned v4u __attribute__((ext_vector_type(4)));
typedef float f32x4 __attribute__((ext_vector_type(4)));
#define LDS_WAIT() asm volatile("s_waitcnt lgkmcnt(0)" ::: "memory")
__device__ __forceinline__ unsigned pk2(float lo, float hi) { return pg8::cvt_pk_bf16(lo, hi); }
__device__ __forceinline__ float wave_sum(float v) {
#pragma unroll
    for (int o = 1; o < 64; o <<= 1) v += __shfl_xor(v, o);
    return v;
}

template <bool MAP> __device__ __forceinline__ void p0_transpose_item(const float* W, int K, int NS, bf16* WT, LAS float* scr, int item, int nkb, int lane) {
    const int pb = item / nkb, kb = item % nkb, k0 = 64 * kb, p0 = 32 * pb;
    const int sc = MAP ? pg8::proj_src_col(p0 + (lane & 31)) : p0 + (lane & 31);
#pragma unroll 8
    for (int i = 0; i < 32; ++i) { const int kk = 2 * i + (lane >> 5); scr[kk * 33 + (lane & 31)] = W[(size_t)(k0 + kk) * NS + sc]; }
    LDS_WAIT(); asm volatile("" ::: "memory");
    const int c = lane & 7;
#pragma unroll
    for (int j = 0; j < 4; ++j) { const int n = (lane >> 3) + 8 * j; const LAS float* s = scr + (8 * c) * 33 + n;
        v4u o; o.x = pk2(s[0 * 33], s[1 * 33]); o.y = pk2(s[2 * 33], s[3 * 33]); o.z = pk2(s[4 * 33], s[5 * 33]); o.w = pk2(s[6 * 33], s[7 * 33]);
        *(GAS v4u*)(WT + (size_t)(p0 + n) * K + k0 + 8 * c) = o; }
    LDS_WAIT(); asm volatile("" ::: "memory");
}

#define XB_TMO      128
#define XB_XCNT(j)  (256  + 64 * (j))
#define XB_XSUB(j)  (1280 + 64 * (j))
#define XB_XGEN(j)  (2304 + 64 * (j))
#define XB_TOP      3328
#define XB_TOPGEN   3392
#define XCD_BAR_WORDS 3456
#define XB_SPIN_CAP (1u << 18)

__device__ __forceinline__ unsigned xb_ld(unsigned* p)              { return __hip_atomic_load(p, __ATOMIC_RELAXED, __HIP_MEMORY_SCOPE_AGENT); }
__device__ __forceinline__ unsigned xb_add(unsigned* p, unsigned v) { return __hip_atomic_fetch_add(p, v, __ATOMIC_RELAXED, __HIP_MEMORY_SCOPE_AGENT); }
__device__ __forceinline__ unsigned xb_xcc_id() { return (unsigned)__builtin_amdgcn_s_getreg((3 << 11) | 20) & 0xFu; }
#define XB_SPIN(cond, bar) do { unsigned _sp = 0; while (cond) { __builtin_amdgcn_s_sleep(1); \
    if ((++_sp & 255u) == 0u) { if (xb_ld(&(bar)[XB_TMO])) break; if (_sp > XB_SPIN_CAP) { atomicAdd(&(bar)[XB_TMO], 1u); break; } } } } while (0)

struct XcdBarrier {
    unsigned* bar; unsigned x;
    volatile LAS unsigned* st;
};

__device__ __forceinline__ XcdBarrier xcd_barrier_post(unsigned* bar, volatile LAS unsigned* st) {
    XcdBarrier b; b.bar = bar; b.x = xb_xcc_id(); b.st = st;
    if (threadIdx.x == 0) (void)xb_add(&bar[XB_XCNT(b.x)], 1u);
    return b;
}
__device__ __forceinline__ void xcd_barrier_complete(unsigned* bar, unsigned x, unsigned& nloc, unsigned& nx) {
    const unsigned G = gridDim.x * gridDim.y * gridDim.z;
    unsigned sum, cnt, mine, sp = 0u;
    for (;;) {
        sum = 0u; cnt = 0u; mine = 0u;
#pragma unroll
        for (unsigned j = 0; j < 16; ++j) { const unsigned c = xb_ld(&bar[XB_XCNT(j)]); sum += c; cnt += (c > 0u) ? 1u : 0u; mine = (j == x) ? c : mine; }
        if (sum == G) break;
        __builtin_amdgcn_s_sleep(1);
        if ((++sp & 255u) == 0u) { if (xb_ld(&bar[XB_TMO])) break; if (sp > XB_SPIN_CAP) { atomicAdd(&bar[XB_TMO], 1u); break; } }
    }
    nloc = mine > 0u ? mine : 1u; nx = cnt > 0u ? cnt : 1u;
}

__device__ __forceinline__ void xcd_barrier(const XcdBarrier& b) {
    asm volatile("s_waitcnt vmcnt(0)" ::: "memory");
    __syncthreads();
    if (threadIdx.x == 0) {
        unsigned* bar = b.bar;
        __builtin_amdgcn_s_waitcnt(0);
        unsigned nloc = b.st[0], nx = b.st[1];
        if (nloc == 0u) { xcd_barrier_complete(bar, b.x, nloc, nx); b.st[0] = nloc; b.st[1] = nx; }
        const unsigned old = xb_add(&bar[XB_XSUB(b.x)], 1u);
        const unsigned gen = old / nloc;
        if (old + 1u == (gen + 1u) * nloc) {
            __builtin_amdgcn_fence(__ATOMIC_RELEASE, "agent");
            asm volatile("s_waitcnt vmcnt(0)" ::: "memory");
            const unsigned og = xb_add(&bar[XB_TOP], 1u);
            const unsigned tg = og / nx;
            if (og + 1u == (tg + 1u) * nx) xb_add(&bar[XB_TOPGEN], 1u);
            else XB_SPIN(xb_ld(&bar[XB_TOPGEN]) == tg, bar);
            __builtin_amdgcn_fence(__ATOMIC_ACQUIRE, "agent");
            xb_add(&bar[XB_XGEN(b.x)], 1u);
            asm volatile("s_waitcnt vmcnt(0)" ::: "memory");
        } else {
            XB_SPIN(xb_ld(&bar[XB_XGEN(b.x)]) == gen, bar);
            __builtin_amdgcn_fence(__ATOMIC_ACQUIRE, "agent");
            asm volatile("s_waitcnt vmcnt(0)" ::: "memory");
        }
    }
    __syncthreads();
}


__device__ __forceinline__ float qk_bound(const float* q_g, const float* k_g, int lane) {
    float gq = fabsf(q_g[lane]), gk = fabsf(k_g[lane]);
#pragma unroll
    for (int o = 1; o < 64; o <<= 1) { gq = fmaxf(gq, __shfl_xor(gq, o)); gk = fmaxf(gk, __shfl_xor(gk, o)); }
    return attn_body::C2 * 64.0f * 1.02f * gq * gk;
}
#ifndef GEMM1_WGM
#define GEMM1_WGM 16
#endif
constexpr float GAP_EXTRA = 38.0f;
struct Args { const float* in[13]; float* out; unsigned char* ws; };
struct ConvItems {
    LAS unsigned char* L;
    __device__ __forceinline__ void operator()(int item) const {
        const __attribute__((address_space(4))) Args* ap_ = (const __attribute__((address_space(4))) Args*)__builtin_amdgcn_kernarg_segment_ptr(); asm volatile("" : "+s"(ap_));
        unsigned char* ws = ap_->ws; const float* conv_w = ap_->in[9]; const float* w_a = ap_->in[10]; const float* w_b = ap_->in[11]; const float* w_o = ap_->in[12];
        const bf16* CUB = (const bf16*)(ws + WS_CU); const bf16* GZB = (const bf16*)(ws + WS_GZ); bf16* OAB = (bf16*)(ws + WS_OAB); bf16* WABT = (bf16*)(ws + WS_WAB); bf16* WOT = (bf16*)(ws + WS_WO);
        const int lane = threadIdx.x & 63, wave = __builtin_amdgcn_readfirstlane((int)threadIdx.x >> 6);
        if (item >= M / 128) {
            LAS float* scr = (LAS float*)(L + wave * 8704); int r = (item - M / 128) * 8 + wave;
            constexpr int I_A = (D / 32) * (AW / 64), I_B = (D / 32) * (CW / 64);
            if (r < I_A) p0_transpose_item<false>(w_a, D, D, WABT, scr, r, AW / 64, lane);
            else if (r < I_A + I_B) p0_transpose_item<false>(w_b, D, D, WABT + 512, scr, r - I_A, CW / 64, lane);
            else p0_transpose_item<false>(w_o, D, D, WOT, scr, r - I_A - I_B, D / 64, lane);
            return; }
        const int m0 = item * 128 + wave * 16; const int ch = 8 * lane;
        float w0[8], w1[8], w2[8];
#pragma unroll
        for (int e = 0; e < 8; ++e) { w0[e] = conv_w[ch + e]; w1[e] = conv_w[CW + ch + e]; w2[e] = conv_w[2 * CW + ch + e]; }
        float p1[8], p2[8];
        const bool first = (m0 % T) == 0;
        { v4u a = {0u, 0u, 0u, 0u}, bq = {0u, 0u, 0u, 0u};
          if (!first) { a = *(const v4u*)(CUB + (size_t)(m0 - 2) * CW + ch); bq = *(const v4u*)(CUB + (size_t)(m0 - 1) * CW + ch); }
#pragma unroll
          for (int e = 0; e < 4; ++e) { p2[2 * e] = pg8::bflo(a[e]); p2[2 * e + 1] = pg8::bfhi(a[e]); p1[2 * e] = pg8::bflo(bq[e]); p1[2 * e + 1] = pg8::bfhi(bq[e]); } }
#pragma unroll 4
        for (int r = 0; r < 16; ++r) { const int m = m0 + r;
            const v4u cv = *(const v4u*)(CUB + (size_t)m * CW + ch), gv = *(const v4u*)(GZB + (size_t)m * CW + ch);
            float cur[8], o[8];
#pragma unroll
            for (int e = 0; e < 4; ++e) { cur[2 * e] = pg8::bflo(cv[e]); cur[2 * e + 1] = pg8::bfhi(cv[e]); }
#pragma unroll
            for (int e = 0; e < 4; ++e) { o[2 * e] = pg8::bflo(gv[e]) * (w0[2 * e] * p2[2 * e] + w1[2 * e] * p1[2 * e] + w2[2 * e] * cur[2 * e]);
                o[2 * e + 1] = pg8::bfhi(gv[e]) * (w0[2 * e + 1] * p2[2 * e + 1] + w1[2 * e + 1] * p1[2 * e + 1] + w2[2 * e + 1] * cur[2 * e + 1]); }
            v4u ov; ov.x = pk2(o[0], o[1]); ov.y = pk2(o[2], o[3]); ov.z = pk2(o[4], o[5]); ov.w = pk2(o[6], o[7]);
            *(v4u*)(OAB + (size_t)m * 1024 + 512 + ch) = ov;
#pragma unroll
            for (int e = 0; e < 8; ++e) { p2[e] = p1[e]; p1[e] = cur[e]; }
        }
    }
};
constexpr int N_CONV_ITEMS = M / 128 + ((D / 32) * (AW / 64) + (D / 32) * (CW / 64) + (D / 32) * (D / 64)) / 8;

template <int LO, int HI> __global__ void __launch_bounds__(NWAVES * 64, 2) fox_fwd(Args args) {
    extern __shared__ __attribute__((aligned(16))) unsigned char lds[];
    LAS unsigned char* L = (LAS unsigned char*)lds;
    if (threadIdx.x < 2) ((volatile LAS unsigned*)(L + MISC_OFF))[threadIdx.x] = 0u;
    if (HI - LO > 1 && threadIdx.x == 0) (void)xb_add(&((unsigned*)(args.ws + WS_CTL))[XB_XCNT(xb_xcc_id())], 1u);
    __syncthreads();
#define PHASE_IDS() int tid = threadIdx.x; asm volatile("" : "+v"(tid)); int bx = blockIdx.x; asm volatile("" : "+s"(bx)); int G = gridDim.x; asm volatile("" : "+s"(G)); \
    const int lane = tid & 63, wave = __builtin_amdgcn_readfirstlane(tid >> 6); const int vcu = (G % 8 == 0) ? (bx % 8) * (G / 8) + bx / 8 : bx; const int gw = vcu * NWAVES + wave, NGW = G * NWAVES; (void)lane; (void)gw; (void)NGW
#define PHASE_PTRS() const __attribute__((address_space(4))) Args* ap_ = (const __attribute__((address_space(4))) Args*)__builtin_amdgcn_kernarg_segment_ptr(); asm volatile("" : "+s"(ap_)); unsigned char* ws = ap_->ws; const float* x = ap_->in[0]; const float* c = ap_->in[1]; const float* w_ada = ap_->in[2]; const float* b_ada = ap_->in[3]; const float* norm_g = ap_->in[4]; const float* w_in = ap_->in[5]; const float* b_f = ap_->in[6]; const float* q_g = ap_->in[7]; const float* k_g = ap_->in[8]; const float* conv_w = ap_->in[9]; const float* w_a = ap_->in[10]; const float* w_b = ap_->in[11]; const float* w_o = ap_->in[12]; float* ADA = (float*)(ws + WS_ADA); float* WF = (float*)(ws + WS_WF); float* LF = (float*)(ws + WS_LF); bf16* W1T = (bf16*)(ws + WS_W1); bf16* WABT = (bf16*)(ws + WS_WAB); bf16* WOT = (bf16*)(ws + WS_WO); bf16* HB = (bf16*)(ws + WS_HB); bf16* OAB = (bf16*)(ws + WS_OAB); bf16* QB = (bf16*)(ws + WS_Q); bf16* KB = (bf16*)(ws + WS_K); bf16* VB = (bf16*)(ws + WS_V); bf16* MG = (bf16*)(ws + WS_MG); bf16* SZA = (bf16*)(ws + WS_SZA); bf16* CUB = (bf16*)(ws + WS_CU); bf16* GZB = (bf16*)(ws + WS_GZ); bf16* RB = (bf16*)(ws + WS_R); bf16* SGB = (bf16*)(ws + WS_SGB);
#ifndef REPEAT_PHASE
#define REPEAT_PHASE -1
#endif
#define REPS(k) (REPEAT_PHASE == (k) ? 2 : 1)
#ifndef PHMASK
#define PHMASK 63
#endif
#define IN(k) ((((PHMASK) >> (k)) & 1) && LO <= (k) && (k) < HI)
#define BOTH(k) (IN(k) && IN((k) + 1))
#ifndef BAR_REPS
#define BAR_REPS 1
#endif
#define XBAR() for (int br_ = 0; br_ < BAR_REPS; ++br_) do { const __attribute__((address_space(4))) Args* bp_ = (const __attribute__((address_space(4))) Args*)__builtin_amdgcn_kernarg_segment_ptr(); asm volatile("" : "+s"(bp_)); XcdBarrier b_; b_.bar = (unsigned*)(bp_->ws + WS_CTL); b_.x = xb_xcc_id(); b_.st = (volatile LAS unsigned*)(L + MISC_OFF); xcd_barrier(b_); } while (0)

    for (int rep_ = 0; rep_ < REPS(0); ++rep_) if (IN(0)) {
        PHASE_PTRS(); PHASE_IDS();
        if (bx < 192) {
            LAS float* ct = (LAS float*)L;
            LAS float* red = (LAS float*)(L + 32768);
            for (int i = tid; i < 8192; i += NWAVES * 64) { const int b = i >> 10, k = i & 1023; ct[k * 8 + b] = c[i]; }
            __syncthreads();
            const int col = bx * 16 + (lane & 15), kpar = lane >> 4;
            float acc[8];
#pragma unroll
            for (int b = 0; b < 8; ++b) acc[b] = 0.f;
#pragma unroll 8
            for (int kk = 0; kk < 32; ++kk) { const int k = wave * 128 + 4 * kk + kpar; const float wv = w_ada[(size_t)k * 3072 + col];
                const f32x4 c0 = *(const LAS f32x4*)(ct + k * 8), c1 = *(const LAS f32x4*)(ct + k * 8 + 4);
                acc[0] += c0[0] * wv; acc[1] += c0[1] * wv; acc[2] += c0[2] * wv; acc[3] += c0[3] * wv; acc[4] += c1[0] * wv; acc[5] += c1[1] * wv; acc[6] += c1[2] * wv; acc[7] += c1[3] * wv; }
#pragma unroll
            for (int b = 0; b < 8; ++b) { acc[b] += __shfl_xor(acc[b], 16); acc[b] += __shfl_xor(acc[b], 32); if (lane < 16) red[(wave * 8 + b) * 16 + lane] = acc[b]; }
            __syncthreads();
            if (tid < 128) { const int b = tid >> 4, cl = tid & 15; float s = b_ada[bx * 16 + cl];
#pragma unroll
                for (int w = 0; w < 8; ++w) s += red[(w * 8 + b) * 16 + cl];
                ADA[b * 3072 + bx * 16 + cl] = s; }
            __syncthreads();
        }
        {
            const int i = bx * NWAVES * 64 + tid; if (i < 8192) { const int j = i >> 10, k = i & 1023; WF[i] = w_in[(size_t)k * INW + SRC_F + j]; }
        }
        if (bx >= 192) {
            LAS float* scr = (LAS float*)(L + wave * 8704); const int w2 = (bx - 192) * NWAVES + wave;
            p0_transpose_item<true>(w_in, D, INW, W1T, scr, 2048 + w2, D / 64, lane);
            p0_transpose_item<true>(w_in, D, INW, W1T, scr, 2048 + 512 + w2, D / 64, lane);
        }
        if (BOTH(0)) XBAR();
    }

    for (int rep_ = 0; rep_ < REPS(1); ++rep_) if (IN(1)) {
        PHASE_PTRS(); PHASE_IDS();
        LAS float* wf = (LAS float*)L;
        for (int i = tid; i < 2048; i += NWAVES * 64) ((LAS f32x4*)wf)[i] = ((const f32x4*)WF)[i];
        __syncthreads();
        const int m0 = gw * 16, b = m0 / T;
        f32x4 gm[4], sh[4];
#pragma unroll
        for (int j = 0; j < 4; ++j) { const int col = 4 * lane + 256 * j; const f32x4 g = *(const f32x4*)(norm_g + col), scl = *(const f32x4*)(ADA + b * 3072 + 1024 + col);
            gm[j] = g * (scl + 1.0f); sh[j] = *(const f32x4*)(ADA + b * 3072 + col); }
        for (int r = 0; r < 16; ++r) { const int m = m0 + r; if (m >= M) break;
            const GAS f32x4* xr = (const GAS f32x4*)(x + (size_t)m * D) + lane;
            f32x4 v[4]; float s2 = 0.f;
#pragma unroll
            for (int j = 0; j < 4; ++j) { v[j] = xr[64 * j]; s2 += (v[j][0] * v[j][0] + v[j][1] * v[j][1]) + (v[j][2] * v[j][2] + v[j][3] * v[j][3]); }
            const float rstd = 1.0f / sqrtf(wave_sum(s2) * (1.0f / D) + EPS);
#pragma unroll
            for (int j = 0; j < 4; ++j) v[j] = v[j] * rstd * gm[j] + sh[j];
            GAS unsigned long long* o8 = (GAS unsigned long long*)(HB + (size_t)m * D) + lane;
#pragma unroll
            for (int j = 0; j < 4; ++j) o8[64 * j] = (unsigned long long)pk2(v[j][0], v[j][1]) | ((unsigned long long)pk2(v[j][2], v[j][3]) << 32);
            float fl[8];
#pragma unroll
            for (int q = 0; q < 8; ++q) { float a = 0.f;
#pragma unroll
                for (int j = 0; j < 4; ++j) { const f32x4 w = *(const LAS f32x4*)(wf + q * 1024 + 4 * lane + 256 * j); a += (v[j][0] * w[0] + v[j][1] * w[1]) + (v[j][2] * w[2] + v[j][3] * w[3]); }
                fl[q] = wave_sum(a); }
            float mine = fl[0];
#pragma unroll
            for (int q = 1; q < 8; ++q) mine = (lane == q) ? fl[q] : mine;
            if (lane < 8) { const float z = mine + b_f[lane]; const float ls = fminf(z, 0.f) - log1pf(__expf(-fabsf(z)));
                LF[(size_t)(b * 8 + lane) * T + (m - b * T)] = ls; }
        }
        {
            LAS float* scr = (LAS float*)(L + 32768 + wave * 8704);
            constexpr int I_1 = (NPROJ / 32) * (D / 64), I_A = (D / 32) * (AW / 64), I_B = (D / 32) * (CW / 64), I_O = (D / 32) * (D / 64);
            (void)I_A; (void)I_B; (void)I_O;
            static_assert(I_1 == 3072, "P0 converts items [2048, 3072) on its 64 GEMV-free workgroups");
            for (int it = gw; it < 2048; it += NGW) p0_transpose_item<true>(w_in, D, INW, W1T, scr, it, D / 64, lane);
        }
        __syncthreads();
        if (BOTH(1)) XBAR();
    }

    for (int rep_ = 0; rep_ < REPS(2); ++rep_) if (IN(2)) {
        PHASE_PTRS(); PHASE_IDS();
        if (bx < BATCH * H) {
            attn_body::bias_scan((char*)lds, LF + (size_t)bx * T, (float*)(ws + WS_BIAS) + (size_t)bx * T);
            attn_body::j0_table((const char*)lds, 2.0f * qk_bound(q_g, k_g, lane) + GAP_EXTRA, (int*)(ws + WS_J0) + bx * 16, wave, lane);
            __syncthreads(); }
        pg8::Gemm g{HB, W1T, M, NPROJ, D}; pg8::StaticOrder S; S.init(M, NPROJ, G, bx, GEMM1_WGM);
        pg8::EpiProj E{ws, q_g, k_g, attn_body::C2, EPS};
        pg8::gemm_phase<pg8::EpiProj, pg8::StaticOrder, PG8_ALIGN, PG8_SP2>(L + RING_OFF, g, S, E);
        if (BOTH(2)) XBAR();
    }

    for (int rep_ = 0; rep_ < REPS(3); ++rep_) if (IN(3)) {
        PHASE_PTRS(); PHASE_IDS();
        const float qkb = qk_bound(q_g, k_g, lane);
        const attn_body::AttnTensors AT{ws, WS_Q, WS_K, WS_V, WS_SZA, WS_LF, WS_OAB, WS_BIAS, WS_J0, 2.0f * qkb + GAP_EXTRA, qkb};
        const ConvItems CI{L};
        attn_body::attn_phase_dyn<-1, ConvItems>((char*)lds + RING_OFF, AT, (unsigned*)(ws + WS_CTL) + CW_ATTNQ, CI, N_CONV_ITEMS);
        if (BOTH(3)) XBAR();
    }

    for (int rep_ = 0; rep_ < REPS(4); ++rep_) if (IN(4)) {
        PHASE_PTRS(); PHASE_IDS();
        pg8::Gemm g{OAB, WABT, M, D, D}; pg8::StaticOrder S; S.init(M, D, G, bx);
        pg8::EpiMerge E{RB, SGB, MG};
        pg8::gemm_phase<pg8::EpiMerge, pg8::StaticOrder, PG8_ALIGN, PG8_SP2>(L + RING_OFF, g, S, E);
        if (BOTH(4)) XBAR();
    }

    for (int rep_ = 0; rep_ < REPS(5); ++rep_) if (IN(5)) {
        PHASE_PTRS(); PHASE_IDS();
        pg8::Gemm g{MG, WOT, M, D, D}; pg8::StaticOrder S; S.init(M, D, G, bx);
        pg8::EpiOut E{x, ADA + 2048, ap_->out};
        pg8::gemm_phase<pg8::EpiOut, pg8::StaticOrder, PG8_ALIGN, PG8_SP2>(L + RING_OFF, g, S, E);
    }
#undef IN
#undef BOTH
}

extern "C" void kernel_launch(void* const* d_in, const int* in_sizes, int n_in, void* d_out, int out_size, void* d_ws, size_t ws_size, hipStream_t stream) {
    static int grid = 0;
    if (grid == 0) {
        if (n_in != 13 || in_sizes[0] != M * D || out_size != M * D || ws_size < WS_END) { fprintf(stderr, "kernel_launch: shape/workspace mismatch (n_in %d, in0 %d, out %d, ws %zu); nothing launched\n", n_in, n_in > 0 ? in_sizes[0] : -1, out_size, ws_size); grid = -1; return; }
        int dev = 0, cus = 0, per_cu = 0;
        if (hipGetDevice(&dev) != hipSuccess || hipDeviceGetAttribute(&cus, hipDeviceAttributeMultiprocessorCount, dev) != hipSuccess) { fprintf(stderr, "kernel_launch: device query failed\n"); grid = -1; return; }
        bool ok = true;
#if MK_N_LAUNCHES == 1
        const void* kfull = (const void*)fox_fwd<0, PER_PHASE>;
        ok = hipFuncSetAttribute(kfull, hipFuncAttributeMaxDynamicSharedMemorySize, LDS_BYTES) == hipSuccess;
#else
        const void* kph[PER_PHASE] = {(const void*)fox_fwd<0, 1>, (const void*)fox_fwd<1, 2>, (const void*)fox_fwd<2, 3>, (const void*)fox_fwd<3, 4>, (const void*)fox_fwd<4, 5>, (const void*)fox_fwd<5, 6>};
        const void* kfull = kph[3];
        for (int i = 0; i < PER_PHASE; ++i) ok = ok && hipFuncSetAttribute(kph[i], hipFuncAttributeMaxDynamicSharedMemorySize, LDS_BYTES) == hipSuccess;
#endif
        if (!ok) { fprintf(stderr, "kernel_launch: hipFuncSetAttribute failed\n"); grid = -1; return; }
        if (hipOccupancyMaxActiveBlocksPerMultiprocessor(&per_cu, kfull, NWAVES * 64, LDS_BYTES) != hipSuccess || per_cu < 1) { fprintf(stderr, "kernel_launch: occupancy query reports %d workgroups per CU\n", per_cu); (void)hipGetLastError(); grid = -1; return; }
        grid = cus;
        if (grid != 256) { fprintf(stderr, "kernel_launch: built for a 256-CU device (got %d CUs); nothing launched\n", cus); grid = -1; return; }
    }
    if (grid < 0) return;
    if (hipMemsetAsync((char*)d_ws + WS_CTL, 0, (XCD_BAR_WORDS + 256) * 4, stream) != hipSuccess) { fprintf(stderr, "kernel_launch: hipMemsetAsync failed\n"); return; }
    Args a{};
    for (int i = 0; i < 13; ++i) a.in[i] = (const float*)d_in[i];
    a.out = (float*)d_out; a.ws = (unsigned char*)d_ws;
#if MK_N_LAUNCHES == 1
    {
        void* kargs[] = {&a};
        const hipError_t e = hipLaunchCooperativeKernel((const void*)fox_fwd<0, PER_PHASE>, dim3(grid), dim3(NWAVES * 64), kargs, LDS_BYTES, stream);
        if (e != hipSuccess) fprintf(stderr, "kernel_launch: cooperative launch failed: %s (grid %d)\n", hipGetErrorString(e), grid);
    }
#else
    {
        hipLaunchKernelGGL((fox_fwd<0, 1>), dim3(grid), dim3(NWAVES * 64), LDS_BYTES, stream, a);
        hipLaunchKernelGGL((fox_fwd<1, 2>), dim3(grid), dim3(NWAVES * 64), LDS_BYTES, stream, a);
        hipLaunchKernelGGL((fox_fwd<2, 3>), dim3(grid), dim3(NWAVES * 64), LDS_BYTES, stream, a);
        hipLaunchKernelGGL((fox_fwd<3, 4>), dim3(grid), dim3(NWAVES * 64), LDS_BYTES, stream, a);
        hipLaunchKernelGGL((fox_fwd<4, 5>), dim3(grid), dim3(NWAVES * 64), LDS_BYTES, stream, a);
        hipLaunchKernelGGL((fox_fwd<5, 6>), dim3(grid), dim3(NWAVES * 64), LDS_BYTES, stream, a);
        const hipError_t le = hipPeekAtLastError();
        if (le != hipSuccess) fprintf(stderr, "kernel_launch: a phase launch failed: %s\n", hipGetErrorName(le));
    }
#endif
}
```

```cpp
#include <hip/hip_runtime.h>
#include <cstdio>
#include <cstdint>
namespace pg8 {
#define PG8_LAS __attribute__((address_space(3)))
typedef unsigned short bf16_t;
typedef short bf16x8 __attribute__((ext_vector_type(8)));
typedef float f32x4 __attribute__((ext_vector_type(4)));
typedef unsigned u32x4 __attribute__((ext_vector_type(4)));
constexpr int BM = 256, BK = 64, HALF = 128, HTB = HALF * BK * 2  , STAGE_BYTES = 8 * HTB, NXCD = 8, WGM = 8;

__host__ __device__ __forceinline__ int lds_byte(int r, int c) { const int st = (r >> 4) * 2 + (c >> 5), rr = r & 15, cc = c & 31, ob = rr * 64 + cc * 2; return st * 1024 + (ob ^ (((ob >> 9) & 1) << 5)); }
__host__ __device__ __forceinline__ void stage_rc(int b, int& R, int& C) { const int st = b / 1024, sb = b % 1024, swz = sb ^ (((sb >> 9) & 1) << 5); R = (st >> 1) * 16 + swz / 64; C = (st & 1) * 32 + (swz % 64) / 2; }
__host__ __device__ __forceinline__ int perm32(int rho) { const int n = rho >> 4, i = rho & 15; return 8 * (i >> 2) + 4 * n + (i & 3); }

struct Unit { int pm, pn; };
struct Gemm { const bf16_t* A; const bf16_t* Bt; int M, N, K; };

struct StaticOrder {
    int nM, nN, nwg, G, c, wgm;
    __host__ __device__ void init(int M, int N, int G_, int c_, int wgm_ = WGM) { nM = M / BM; nN = N / BM; nwg = nM * nN; G = G_; c = c_; wgm = wgm_; }
    __host__ __device__ bool next(int i, Unit& u) const {
        const long L = (long)i * G + c; if (L >= nwg) return false;
        int wgid = (int)L; { const int q = nwg / NXCD, r = nwg % NXCD, xcd = wgid % NXCD, off = wgid / NXCD; wgid = (xcd < r ? xcd * (q + 1) : r * (q + 1) + (xcd - r) * q) + off; }
        const int nig = wgm * nN, gid = wgid / nig, fm = gid * wgm, gsz = (nM - fm) < wgm ? (nM - fm) : wgm;
        u.pm = fm + ((wgid % nig) % gsz); u.pn = (wgid % nig) / gsz; return true;
    }
    __device__ __forceinline__ void a_ready(const Unit&) const {}
    __device__ __forceinline__ void done(const Unit&) const {}
};

__device__ __forceinline__ unsigned cvt_pk_bf16(float lo, float hi) { unsigned r; asm volatile("v_cvt_pk_bf16_f32 %0, %1, %2" : "=v"(r) : "v"(lo), "v"(hi)); return r; }
typedef float f32x2 __attribute__((ext_vector_type(2)));
__device__ __forceinline__ float sigm(float x) { return __builtin_amdgcn_rcpf(1.0f + __builtin_amdgcn_exp2f(x * -1.4426950408889634f)); }
__device__ __forceinline__ float silu(float x) { return x * sigm(x); }
__device__ __forceinline__ float bflo(unsigned w) { return __builtin_bit_cast(float, w << 16); }
__device__ __forceinline__ float bfhi(unsigned w) { return __builtin_bit_cast(float, w & 0xffff0000u); }
typedef unsigned u32x2 __attribute__((ext_vector_type(2)));

constexpr size_t OFF_Q = 96u << 20, OFF_K = 128u << 20, OFF_V = 160u << 20, OFF_SZA = 192u << 20, OFF_CU = 224u << 20, OFF_GZ = 256u << 20, OFF_SGA = 320u << 20, OFF_SGB = 384u << 20;
struct EpiProj {
    static constexpr bool PERM = true, AFTER_DRAIN = false, MID = false;
    unsigned char* ws; const float *qg, *kg; float qscale, eps;
    __device__ __forceinline__ void operator()(const f32x4 (&acc)[2][2][4][2], const Unit& u, int wr, int wc, int fr, int fq) const {
        const int pn = u.pn; const size_t row0 = (size_t)u.pm * BM + wr * 64 + fr;
        if (pn < 4) {
            const bool isq = pn < 2; const float* g = isq ? qg : kg; bf16_t* dst = (bf16_t*)(ws + (isq ? OFF_Q : OFF_K)); const float sc = isq ? qscale : 1.0f;
            const int colb = (pn & 1) * 256 + 64 * wc + 8 * fq;
            f32x4 gv[2][2];
#pragma unroll
            for (int bj = 0; bj < 2; ++bj)
#pragma unroll
                for (int n = 0; n < 2; ++n) gv[bj][n] = *(const f32x4*)(g + 32 * bj + 8 * fq + 4 * n) * sc;
#pragma unroll
            for (int ai = 0; ai < 2; ++ai)
#pragma unroll
                for (int m = 0; m < 4; ++m) {
                    float ss = 0.f;
#pragma unroll
                    for (int bj = 0; bj < 2; ++bj)
#pragma unroll
                        for (int n = 0; n < 2; ++n) { const f32x4 x = acc[ai][bj][m][n]; ss += (x[0] * x[0] + x[1] * x[1]) + (x[2] * x[2] + x[3] * x[3]); }
                    ss += __shfl_xor(ss, 16); ss += __shfl_xor(ss, 32);
                    const float rstd = __builtin_amdgcn_rsqf(ss * (1.0f / 64.0f) + eps);
                    bf16_t* rowp = dst + (row0 + ai * HALF + m * 16) * 512 + colb;
#pragma unroll
                    for (int bj = 0; bj < 2; ++bj) { const f32x4 v0 = acc[ai][bj][m][0] * rstd * gv[bj][0], v1 = acc[ai][bj][m][1] * rstd * gv[bj][1];
                        u32x4 w; w.x = cvt_pk_bf16(v0[0], v0[1]); w.y = cvt_pk_bf16(v0[2], v0[3]); w.z = cvt_pk_bf16(v1[0], v1[1]); w.w = cvt_pk_bf16(v1[2], v1[3]);
                        *(u32x4*)(rowp + 32 * bj) = w; }
                }
        } else if (pn >= 8 && pn < 16) {
            const int col = 64 * (pn - 8) + 16 * wc + 8 * (fq >> 1); bf16_t* dstb = (bf16_t*)(ws + ((fq & 1) ? OFF_GZ : OFF_CU));
#pragma unroll
            for (int ai = 0; ai < 2; ++ai)
#pragma unroll
                for (int m = 0; m < 4; ++m) { const size_t off = (row0 + ai * HALF + m * 16) * 512 + col;
                    const f32x4 gb = acc[ai][0][m][0], gc = acc[ai][0][m][1], uu = acc[ai][1][m][0], zb = acc[ai][1][m][1];
                    const f32x4 cu = gc * uu; f32x4 gz; gz[0] = gb[0] * silu(zb[0]); gz[1] = gb[1] * silu(zb[1]); gz[2] = gb[2] * silu(zb[2]); gz[3] = gb[3] * silu(zb[3]);
                    u32x2 a, b; a.x = cvt_pk_bf16(cu[0], cu[1]); a.y = cvt_pk_bf16(cu[2], cu[3]); b.x = cvt_pk_bf16(gz[0], gz[1]); b.y = cvt_pk_bf16(gz[2], gz[3]);
                    const auto rx = __builtin_amdgcn_permlane16_swap(a.x, b.x, false, false), ry = __builtin_amdgcn_permlane16_swap(a.y, b.y, false, false);
                    u32x4 w; w.x = rx[0]; w.y = ry[0]; w.z = rx[1]; w.w = ry[1];
                    *(u32x4*)(dstb + off) = w; }
        } else if (pn >= 16) {
            const int col = 128 * (pn - 16) + 32 * wc + 8 * fq; bf16_t* RB = (bf16_t*)(ws + OFF_SGA); bf16_t* SB = (bf16_t*)(ws + OFF_SGB);
#pragma unroll
            for (int ai = 0; ai < 2; ++ai)
#pragma unroll
                for (int m = 0; m < 4; ++m) { const size_t off = (row0 + ai * HALF + m * 16) * 1024 + col;
                    float sb[8], rr[8];
#pragma unroll
                    for (int n = 0; n < 2; ++n)
#pragma unroll
                        for (int i = 0; i < 4; ++i) { const float ea = __builtin_amdgcn_exp2f(acc[ai][0][m][n][i] * -1.4426950408889634f), eb = __builtin_amdgcn_exp2f(acc[ai][1][m][n][i] * -1.4426950408889634f);
                            sb[4 * n + i] = __builtin_amdgcn_rcpf(1.0f + eb); rr[4 * n + i] = (1.0f + eb) * __builtin_amdgcn_rcpf(1.0f + ea); }
                    u32x4 w, v; w.x = cvt_pk_bf16(rr[0], rr[1]); w.y = cvt_pk_bf16(rr[2], rr[3]); w.z = cvt_pk_bf16(rr[4], rr[5]); w.w = cvt_pk_bf16(rr[6], rr[7]);
                    v.x = cvt_pk_bf16(sb[0], sb[1]); v.y = cvt_pk_bf16(sb[2], sb[3]); v.z = cvt_pk_bf16(sb[4], sb[5]); v.w = cvt_pk_bf16(sb[6], sb[7]);
                    *(u32x4*)(RB + off) = w; *(u32x4*)(SB + off) = v; }
        } else {
            size_t doff; int ld, tcol, act;
            if (pn < 6) { doff = OFF_V; ld = 512; tcol = (pn - 4) * 256; act = 0; }
            else { doff = OFF_SZA; ld = 512; tcol = (pn - 6) * 256; act = 1; }
            bf16_t* dst = (bf16_t*)(ws + doff);
            const int colb = tcol + 64 * wc + 8 * fq;
#pragma unroll
            for (int ai = 0; ai < 2; ++ai)
#pragma unroll
                for (int m = 0; m < 4; ++m) { bf16_t* rowp = dst + (row0 + ai * HALF + m * 16) * ld + colb;
#pragma unroll
                    for (int bj = 0; bj < 2; ++bj) { f32x4 v0 = acc[ai][bj][m][0], v1 = acc[ai][bj][m][1];
                        if (act == 1) { v0[0] = silu(v0[0]); v0[1] = silu(v0[1]); v0[2] = silu(v0[2]); v0[3] = silu(v0[3]); v1[0] = silu(v1[0]); v1[1] = silu(v1[1]); v1[2] = silu(v1[2]); v1[3] = silu(v1[3]); }
                        u32x4 w; w.x = cvt_pk_bf16(v0[0], v0[1]); w.y = cvt_pk_bf16(v0[2], v0[3]); w.z = cvt_pk_bf16(v1[0], v1[1]); w.w = cvt_pk_bf16(v1[2], v1[3]);
                        *(u32x4*)(rowp + 32 * bj) = w; } }
        }
    }
};
__host__ __device__ __forceinline__ int proj_src_col(int p) {
    const int pn = p >> 8, r = p & 255, bj = r >> 7, wc = (r >> 5) & 3, jj = r & 31;
    if (pn >= 8 && pn < 16) { const int fq = jj >> 3, n = (jj >> 2) & 1, i = jj & 3; const int sect = bj == 0 ? (n == 0 ? 2056 : 2568) : (n == 0 ? 3080 : 3592); return sect + 64 * (pn - 8) + 16 * wc + 4 * fq + i; }
    if (pn >= 16) return (bj == 0 ? 4104 : 5128) + 128 * (pn - 16) + 32 * wc + jj;
    const int nat = 64 * wc + 32 * bj + jj;
    if (pn < 6) return 256 * pn + nat;
    return 1544 + 256 * (pn - 6) + nat;
}

struct EpiMerge {
    static constexpr bool PERM = true, AFTER_DRAIN = false, MID = true;
    const bf16_t* R; const bf16_t* SB; bf16_t* MG;
    __device__ __forceinline__ void mid(f32x4 (&acc)[2][2][4][2], const Unit& u, int wr, int wc, int fr, int fq) const {
        const size_t row0 = (size_t)u.pm * BM + wr * 64 + fr; const int col0 = u.pn * BM + wc * 32 + 8 * fq;
#pragma unroll
        for (int ai = 0; ai < 2; ++ai)
#pragma unroll
            for (int m = 0; m < 4; ++m) { const size_t off = (row0 + ai * HALF + m * 16) * 1024 + col0;
#pragma unroll
                for (int bj = 0; bj < 2; ++bj) { const u32x4 g = *(const u32x4*)(R + off + bj * HALF);
                    acc[ai][bj][m][0] *= (f32x4){bflo(g.x), bfhi(g.x), bflo(g.y), bfhi(g.y)}; acc[ai][bj][m][1] *= (f32x4){bflo(g.z), bfhi(g.z), bflo(g.w), bfhi(g.w)}; }
                if (m == 3) asm volatile("" ::: "memory"); }
    }
    __device__ __forceinline__ void operator()(const f32x4 (&acc)[2][2][4][2], const Unit& u, int wr, int wc, int fr, int fq) const {
        const size_t row0 = (size_t)u.pm * BM + wr * 64 + fr; const int col0 = u.pn * BM + wc * 32 + 8 * fq;
#pragma unroll
        for (int ai = 0; ai < 2; ++ai)
#pragma unroll
            for (int m = 0; m < 4; ++m) { const size_t off = (row0 + ai * HALF + m * 16) * 1024 + col0;
#pragma unroll
                for (int bj = 0; bj < 2; ++bj) { const u32x4 g = *(const u32x4*)(SB + off + bj * HALF); const f32x4 v0 = acc[ai][bj][m][0], v1 = acc[ai][bj][m][1];
                    u32x4 w; w.x = cvt_pk_bf16(v0[0] * bflo(g.x), v0[1] * bfhi(g.x)); w.y = cvt_pk_bf16(v0[2] * bflo(g.y), v0[3] * bfhi(g.y));
                    w.z = cvt_pk_bf16(v1[0] * bflo(g.z), v1[1] * bfhi(g.z)); w.w = cvt_pk_bf16(v1[2] * bflo(g.w), v1[3] * bfhi(g.w));
                    *(u32x4*)(MG + off + bj * HALF) = w; } }
    }
};
struct EpiOut {
    static constexpr bool PERM = false, AFTER_DRAIN = false, MID = false;
    const float* x; const float* gate; float* out;
    __device__ __forceinline__ void operator()(const f32x4 (&acc)[2][2][4][2], const Unit& u, int wr, int wc, int fr, int fq) const {
        const size_t row0 = (size_t)u.pm * BM + wr * 64 + fr; const int col0 = u.pn * BM + wc * 32 + 4 * fq; const float* gp = gate + (size_t)(u.pm >> 4) * 3072 + col0;
        f32x4 gv[2][2];
#pragma unroll
        for (int bj = 0; bj < 2; ++bj)
#pragma unroll
            for (int n = 0; n < 2; ++n) gv[bj][n] = *(const f32x4*)(gp + bj * HALF + n * 16);
#pragma unroll
        for (int ai = 0; ai < 2; ++ai) {
            f32x4 xv[4][2][2];
#pragma unroll
            for (int m = 0; m < 4; ++m) { const size_t off = (row0 + ai * HALF + m * 16) * 1024 + col0;
#pragma unroll
                for (int bj = 0; bj < 2; ++bj)
#pragma unroll
                    for (int n = 0; n < 2; ++n) xv[m][bj][n] = *(const f32x4*)(x + off + bj * HALF + n * 16); }
            asm volatile("" ::: "memory");
#pragma unroll
            for (int m = 0; m < 4; ++m) { const size_t off = (row0 + ai * HALF + m * 16) * 1024 + col0;
#pragma unroll
                for (int bj = 0; bj < 2; ++bj)
#pragma unroll
                    for (int n = 0; n < 2; ++n) *(f32x4*)(out + off + bj * HALF + n * 16) = xv[m][bj][n] + gv[bj][n] * acc[ai][bj][m][n]; }
            asm volatile("" ::: "memory"); }
    }
};

template <class Epi, class Sched, bool ALIGN_EPI = false, bool SP2 = false>
__device__ __forceinline__ void gemm_phase(PG8_LAS unsigned char* lds, const Gemm g, const Sched& S, const Epi& E) {
    int tid_ = threadIdx.x; asm volatile("" : "+v"(tid_));
    const int tid = tid_, wid = __builtin_amdgcn_readfirstlane(tid >> 6), lane = tid & 63, wr = wid >> 2, wc = wid & 3, fr = lane & 15, fq = lane >> 4;
    const int K = g.K, nt = K / BK;
    unsigned voffA[2], voffB[2];
#pragma unroll
    for (int i = 0; i < 2; ++i) { int R, C; stage_rc(tid * 16 + i * 8192, R, C); const int Rb = Epi::PERM ? ((R & ~31) + perm32(R & 31)) : R;
        voffA[i] = (unsigned)(R * K + C) * 2u; voffB[i] = (unsigned)(Rb * K + C) * 2u; }
    const size_t kstep = (size_t)(BK * 2);
    const size_t hstep = (size_t)HALF * K * 2;
    const size_t tstep = 2 * hstep;
    const unsigned ldsw = (unsigned)wid * 1024u;
    const int aoff = lds_byte(wr * 64 + fr, fq * 8), boff = lds_byte(wc * 32 + fr, fq * 8);
#define PG8_SA(b, h) (((b) * 2 + (h)) * HTB)
#define PG8_SB(b, h) ((4 + (b) * 2 + (h)) * HTB)
#define PG8_STAGE(bufoff, gbase, voff) do { _Pragma("unroll") for (int _i = 0; _i < 2; ++_i) \
        __builtin_amdgcn_global_load_lds((const unsigned*)((const char*)(gbase) + (voff)[_i]), (PG8_LAS unsigned*)(lds + (bufoff) + ldsw + _i * 8192), 16, 0, 0); } while (0)
#define PG8_LDA(dst, b, h) do { _Pragma("unroll") for (int m = 0; m < 4; ++m) _Pragma("unroll") for (int k = 0; k < 2; ++k) dst[m][k] = *(const PG8_LAS bf16x8*)(lds + PG8_SA(b, h) + aoff + m * 2048 + k * 1024); } while (0)
#define PG8_LDB(dst, b, h) do { _Pragma("unroll") for (int n = 0; n < 2; ++n) _Pragma("unroll") for (int k = 0; k < 2; ++k) dst[n][k] = *(const PG8_LAS bf16x8*)(lds + PG8_SB(b, h) + boff + n * 2048 + k * 1024); } while (0)
#define PG8_MMA(ai, bj, At, Bt) do { __builtin_amdgcn_s_setprio(1); _Pragma("unroll") for (int m = 0; m < 4; ++m) _Pragma("unroll") for (int n = 0; n < 2; ++n) _Pragma("unroll") for (int k = 0; k < 2; ++k) \
        acc[ai][bj][m][n] = __builtin_amdgcn_mfma_f32_16x16x32_bf16(Bt[n][k], At[m][k], acc[ai][bj][m][n], 0, 0, 0); __builtin_amdgcn_s_setprio(0); } while (0)
#define PG8_WAIT_V(n) asm volatile("s_waitcnt vmcnt(" #n ")" ::: "memory")
#define PG8_WAIT_L(n) asm volatile("s_waitcnt lgkmcnt(" #n ")" ::: "memory")
#define PG8_BAR __builtin_amdgcn_s_barrier()
#define PG8_SCHED __builtin_amdgcn_sched_barrier(0)
    Unit cur, nxt; int ui = 0;
    if (!S.next(0, cur)) return;
    f32x4 acc[2][2][4][2];
#pragma unroll
    for (int a = 0; a < 2; ++a)
#pragma unroll
        for (int b = 0; b < 2; ++b)
#pragma unroll
            for (int m = 0; m < 4; ++m)
#pragma unroll
                for (int n = 0; n < 2; ++n) acc[a][b][m][n] = (f32x4){0.f, 0.f, 0.f, 0.f};
    bf16x8 At[4][2], B0[2][2], B1[2][2];
    const char* cA = (const char*)g.A + (size_t)cur.pm * tstep; const char* cB = (const char*)g.Bt + (size_t)cur.pn * tstep;
    S.a_ready(cur);
    if constexpr (SP2) {
        PG8_STAGE(PG8_SB(0, 0), cB, voffB); PG8_STAGE(PG8_SB(0, 1), cB + hstep, voffB); PG8_STAGE(PG8_SA(0, 0), cA, voffA); PG8_STAGE(PG8_SA(0, 1), cA + hstep, voffA);
        if (wr == 1) PG8_BAR;
        PG8_WAIT_V(2); PG8_BAR;
        PG8_STAGE(PG8_SB(1, 0), cB + kstep, voffB); PG8_STAGE(PG8_SA(1, 0), cA + kstep, voffA); PG8_STAGE(PG8_SB(1, 1), cB + hstep + kstep, voffB);
        PG8_WAIT_V(6); PG8_BAR;
    } else {
        PG8_STAGE(PG8_SB(0, 0), cB, voffB); PG8_STAGE(PG8_SA(0, 0), cA, voffA); PG8_STAGE(PG8_SB(0, 1), cB + hstep, voffB); PG8_STAGE(PG8_SA(0, 1), cA + hstep, voffA);
        if (wr == 1) PG8_BAR;
        PG8_WAIT_V(4); PG8_BAR;
        PG8_STAGE(PG8_SB(1, 0), cB + kstep, voffB); PG8_STAGE(PG8_SA(1, 0), cA + kstep, voffA); PG8_STAGE(PG8_SB(1, 1), cB + hstep + kstep, voffB);
        PG8_WAIT_V(6); PG8_BAR;
    }
    for (;;) {
        const bool has_next = S.next(ui + 1, nxt);
        const char* nA = has_next ? (const char*)g.A + (size_t)nxt.pm * tstep : cA; const char* nB = has_next ? (const char*)g.Bt + (size_t)nxt.pn * tstep : cB;
        for (int t = 0; t < nt; t += 2) {
            if constexpr (Epi::MID) { if (t == nt / 2) E.mid(acc, cur, wr, wc, fr, fq); }
            const bool last = (t == nt - 2);
            const char* a1 = cA + (size_t)(t + 1) * kstep;
            const char* a2 = last ? nA : cA + (size_t)(t + 2) * kstep; const char* b2 = last ? nB : cB + (size_t)(t + 2) * kstep;
            const char* a3 = a2 + kstep; const char* b3 = b2 + kstep;
            if (last && has_next) S.a_ready(nxt);
            if constexpr (SP2) {
            PG8_LDB(B0, 0, 0); PG8_LDB(B1, 0, 1); PG8_SCHED; PG8_LDA(At, 0, 0); PG8_STAGE(PG8_SA(1, 1), a1 + hstep, voffA);
            PG8_WAIT_V(8); PG8_WAIT_L(0); PG8_BAR; PG8_MMA(0, 0, At, B0); PG8_MMA(0, 1, At, B1); PG8_BAR; PG8_SCHED;
            PG8_LDA(At, 0, 1); PG8_STAGE(PG8_SB(0, 0), b2, voffB); PG8_STAGE(PG8_SB(0, 1), b2 + hstep, voffB); PG8_STAGE(PG8_SA(0, 0), a2, voffA);
            PG8_WAIT_V(8); PG8_WAIT_L(0); PG8_BAR; PG8_MMA(1, 0, At, B0); PG8_MMA(1, 1, At, B1); PG8_BAR; PG8_SCHED;
            PG8_LDB(B0, 1, 0); PG8_LDB(B1, 1, 1); PG8_SCHED; PG8_LDA(At, 1, 0); PG8_STAGE(PG8_SA(0, 1), a2 + hstep, voffA);
            PG8_WAIT_V(8); PG8_WAIT_L(0); PG8_BAR; PG8_MMA(0, 0, At, B0); PG8_MMA(0, 1, At, B1); PG8_BAR; PG8_SCHED;
            PG8_LDA(At, 1, 1); PG8_STAGE(PG8_SB(1, 0), b3, voffB); PG8_STAGE(PG8_SB(1, 1), b3 + hstep, voffB); PG8_STAGE(PG8_SA(1, 0), a3, voffA);
            PG8_WAIT_V(8); PG8_WAIT_L(0); PG8_BAR; PG8_MMA(1, 0, At, B0); PG8_MMA(1, 1, At, B1); PG8_BAR; PG8_SCHED;
            } else {
            PG8_LDB(B0, 0, 0); PG8_SCHED; PG8_LDA(At, 0, 0); PG8_STAGE(PG8_SA(1, 1), a1 + hstep, voffA);
            PG8_WAIT_L(8); PG8_BAR; PG8_WAIT_L(0); PG8_MMA(0, 0, At, B0); PG8_BAR; PG8_SCHED;
            PG8_LDB(B1, 0, 1); PG8_STAGE(PG8_SB(0, 0), b2, voffB);
            PG8_BAR; PG8_WAIT_L(0); PG8_MMA(0, 1, At, B1); PG8_BAR;
            PG8_LDA(At, 0, 1); PG8_STAGE(PG8_SA(0, 0), a2, voffA);
            PG8_BAR; PG8_WAIT_L(0); PG8_MMA(1, 0, At, B0); PG8_BAR; PG8_SCHED;
            PG8_STAGE(PG8_SB(0, 1), b2 + hstep, voffB);
            PG8_WAIT_V(6); PG8_BAR; PG8_MMA(1, 1, At, B1); PG8_BAR;
            PG8_LDB(B0, 1, 0); PG8_SCHED; PG8_LDA(At, 1, 0); PG8_STAGE(PG8_SA(0, 1), a2 + hstep, voffA);
            PG8_WAIT_L(8); PG8_BAR; PG8_WAIT_L(0); PG8_MMA(0, 0, At, B0); PG8_BAR; PG8_SCHED;
            PG8_LDB(B1, 1, 1); PG8_STAGE(PG8_SB(1, 0), b3, voffB);
            PG8_BAR; PG8_WAIT_L(0); PG8_MMA(0, 1, At, B1); PG8_BAR;
            PG8_LDA(At, 1, 1); PG8_STAGE(PG8_SA(1, 0), a3, voffA);
            PG8_BAR; PG8_WAIT_L(0); PG8_MMA(1, 0, At, B0); PG8_BAR; PG8_SCHED;
            PG8_STAGE(PG8_SB(1, 1), b3 + hstep, voffB);
            PG8_WAIT_V(6); PG8_BAR; PG8_MMA(1, 1, At, B1); PG8_BAR;
            }
        }
        if constexpr (ALIGN_EPI) { if (wr == 0) PG8_BAR; }
        if constexpr (!Epi::AFTER_DRAIN) { E(acc, cur, wr, wc, fr, fq); S.done(cur); }
        if (!has_next) break;
#pragma unroll
        for (int a = 0; a < 2; ++a)
#pragma unroll
            for (int b = 0; b < 2; ++b)
#pragma unroll
                for (int m = 0; m < 4; ++m)
#pragma unroll
                    for (int n = 0; n < 2; ++n) acc[a][b][m][n] = (f32x4){0.f, 0.f, 0.f, 0.f};
        cur = nxt; cA = nA; cB = nB; ++ui;
        if constexpr (ALIGN_EPI) { if (wr == 1) PG8_BAR; }
    }
    PG8_WAIT_V(0);
    if constexpr (!ALIGN_EPI) { if (wr == 0) PG8_BAR; }
    PG8_BAR;
    if constexpr (Epi::AFTER_DRAIN) { E.fused(acc, cur, wr, wc, fr, fq, lds, wid, lane); S.done(cur); }
#undef PG8_SA
#undef PG8_SB
#undef PG8_STAGE
#undef PG8_LDA
#undef PG8_LDB
#undef PG8_MMA
#undef PG8_WAIT_V
#undef PG8_WAIT_L
#undef PG8_BAR
#undef PG8_SCHED
}
}

#ifndef PG8_SP2
#define PG8_SP2 true
#endif
#ifndef PG8_ALIGN
#define PG8_ALIGN true
#endif
#include <hip/hip_bf16.h>
#include <cmath>
namespace attn_body {
using bf16=__hip_bfloat16;
using bf16x8=__attribute__((ext_vector_type(8)))short;
using s16x4=__attribute__((ext_vector_type(4)))short;
using f32x16=__attribute__((ext_vector_type(16)))float;
using u32x4=__attribute__((ext_vector_type(4)))unsigned;
using f32x4v=__attribute__((ext_vector_type(4)))float;
constexpr int BATCH=8,NHEAD=8,SEQ=4096,D=64,DM=NHEAD*D;
constexpr int NW=8,QBLK=32,QB=QBLK*NW,KVBLK=64,NQB=SEQ/QB;
constexpr int ATTN_PITCH=DM, ATTN_UNIT_ROWS=QB, OPITCH=1024;
__device__ __forceinline__ int crow(int r,int hi){return (r&3)+8*(r>>2)+4*hi;}
#define SBAR() __builtin_amdgcn_sched_barrier(0)
__device__ __forceinline__ void cmask(f32x16&p0,f32x16&p1,int jb,int qrel,int hi){
  const float NEG=-INFINITY; int kb=64*jb+4*hi;
  #pragma unroll
  for(int r=0;r<16;++r){int kv=kb+(r&3)+8*(r>>2); if(kv>qrel)p0[r]=NEG; if(kv+32>qrel)p1[r]=NEG;}
}

constexpr int NSLOT=3, SLOTB=8192;
constexpr int LDS_K=0, LDS_V=NSLOT*SLOTB, LDS_WS=2*NSLOT*SLOTB, LDS_OST=LDS_WS+NW*64*4, LDS_BIAS=LDS_OST+NW*4096, LDS_BYTES=LDS_BIAS+SEQ*4;
constexpr float C2=0.125f*1.4426950408889634f;
__device__ __forceinline__ void glds16(const void*gsrc,unsigned lds_dst){unsigned keep;
  asm volatile("s_mov_b32 %0, m0\n\ts_mov_b32 m0, %2\n\ts_nop 0\n\tglobal_load_lds_dwordx4 %1, off\n\ts_mov_b32 m0, %0":"=&s"(keep):"v"(gsrc),"s"(lds_dst):"memory");}
__device__ __forceinline__ float max3f(float a,float b,float c){float r;asm("v_max3_f32 %0, %1, %2, %3":"=v"(r):"v"(a),"v"(b),"v"(c));return r;}
__device__ __forceinline__ float max2f(float a,float b){float r;asm("v_max_f32_e32 %0, %1, %2":"=v"(r):"v"(a),"v"(b));return r;}
__device__ __forceinline__ float fadd_s(float a,float b){float r;asm("v_add_f32_e32 %0, %1, %2":"=v"(r):"v"(a),"v"(b));return r;}
__device__ __forceinline__ float fsub_s(float a,float b){float r;asm("v_sub_f32_e32 %0, %1, %2":"=v"(r):"v"(a),"v"(b));return r;}
typedef float f32x2_t __attribute__((ext_vector_type(2))); typedef __bf16 bf16x2_t __attribute__((ext_vector_type(2)));
__device__ __forceinline__ unsigned cvtpk_s(float lo,float hi){f32x2_t v={lo,hi};bf16x2_t b=__builtin_convertvector(v,bf16x2_t);return __builtin_bit_cast(unsigned,b);}
#define WAIT_BAR(N) asm volatile("s_waitcnt vmcnt(" #N ") lgkmcnt(0)\n\ts_barrier":::"memory")

__device__ __forceinline__ void qkt(f32x16&p0,f32x16&p1,const char*Kslot,const bf16x8*qr,int r32,int hi){
  const char*kb=Kslot+hi*1024+r32*16;
  #pragma unroll
  for(int d0=0;d0<4;++d0){
    const bf16x8 b0=*reinterpret_cast<const bf16x8*>(kb+d0*2048);
    const bf16x8 b1=*reinterpret_cast<const bf16x8*>(kb+d0*2048+512);
    p0=__builtin_amdgcn_mfma_f32_32x32x16_bf16(b0,qr[d0],p0,0,0,0);p1=__builtin_amdgcn_mfma_f32_32x32x16_bf16(b1,qr[d0],p1,0,0,0);}
}
typedef __attribute__((address_space(3))) const char* lds_cptr;
typedef short v4i16_t __attribute__((ext_vector_type(4)));
__device__ __forceinline__ void kload8(bf16x8*kf,lds_cptr kp){
  kf[0]=*(const __attribute__((address_space(3))) bf16x8*)(kp);      kf[1]=*(const __attribute__((address_space(3))) bf16x8*)(kp+512);
  kf[2]=*(const __attribute__((address_space(3))) bf16x8*)(kp+2048); kf[3]=*(const __attribute__((address_space(3))) bf16x8*)(kp+2560);
  kf[4]=*(const __attribute__((address_space(3))) bf16x8*)(kp+4096); kf[5]=*(const __attribute__((address_space(3))) bf16x8*)(kp+4608);
  kf[6]=*(const __attribute__((address_space(3))) bf16x8*)(kp+6144); kf[7]=*(const __attribute__((address_space(3))) bf16x8*)(kp+6656);
}
__device__ __forceinline__ void kload2(bf16x8*kf,lds_cptr kp,int j){ kf[2*j]=*(const __attribute__((address_space(3))) bf16x8*)(kp+j*2048); kf[2*j+1]=*(const __attribute__((address_space(3))) bf16x8*)(kp+j*2048+512); }
__device__ __forceinline__ s16x4 vtr(lds_cptr p){ return __builtin_bit_cast(s16x4,__builtin_amdgcn_ds_read_tr16_b64_v4i16((__attribute__((address_space(3))) v4i16_t*)p)); }
__device__ __forceinline__ float rowmax(const f32x16&p0,const f32x16&p1){
  float a=max3f(p0[0],p0[1],p1[0]),b=max3f(p0[2],p0[3],p1[1]);a=max3f(a,p1[2],p1[3]);
  #pragma unroll
  for(int r=4;r<16;r+=4){a=max3f(a,p0[r],p0[r+1]);b=max3f(b,p0[r+2],p0[r+3]);a=max3f(a,p1[r],p1[r+1]);b=max3f(b,p1[r+2],p1[r+3]);}
  const float m=max2f(a,b);
  auto rr=__builtin_amdgcn_permlane32_swap(__float_as_uint(m),__float_as_uint(m),false,false);
  return max2f(__uint_as_float(rr[0]),__uint_as_float(rr[1]));
}
__device__ __forceinline__ void pv(f32x16*o,int vb,bf16x8 pa0,bf16x8 pa1,bf16x8 pa2,bf16x8 pa3){
  #pragma unroll
  for(int d0=0;d0<2;++d0){s16x4 lo[4],hi[4];
    #pragma unroll
    for(int ks=0;ks<4;++ks){
      asm volatile("ds_read_b64_tr_b16 %0,%1 offset:%c2":"=&v"(lo[ks]):"v"(vb),"i"(d0*4096+ks*1024):"memory");
      asm volatile("ds_read_b64_tr_b16 %0,%1 offset:%c2":"=&v"(hi[ks]):"v"(vb),"i"(d0*4096+ks*1024+512):"memory");}
    asm volatile("s_waitcnt lgkmcnt(0)":::"memory");SBAR();
    #define PK(k) (bf16x8){lo[k][0],lo[k][1],lo[k][2],lo[k][3],hi[k][0],hi[k][1],hi[k][2],hi[k][3]}
    o[d0]=__builtin_amdgcn_mfma_f32_32x32x16_bf16(pa0,PK(0),o[d0],0,0,0);
    o[d0]=__builtin_amdgcn_mfma_f32_32x32x16_bf16(pa1,PK(1),o[d0],0,0,0);
    o[d0]=__builtin_amdgcn_mfma_f32_32x32x16_bf16(pa2,PK(2),o[d0],0,0,0);
    o[d0]=__builtin_amdgcn_mfma_f32_32x32x16_bf16(pa3,PK(3),o[d0],0,0,0);
    #undef PK
  }
}

#ifndef ATTN_STORE16
#define ATTN_STORE16(p,v) (*(u32x4*)(p)=(v))
#endif
struct AttnTensors { unsigned char* ws; size_t oq,ok,ov,oz,olf,oo,obias,oj0; float gap,hdr; };
template<int THRL> __device__ __forceinline__ void attn_unit(int b,int h,int qb,int j0,f32x4v brow0,f32x4v brow1,unsigned*ctr,unsigned&nxt,const AttnTensors&T_,char*shm){
  const bf16*Q=(const bf16*)(T_.ws+T_.oq); const bf16*__restrict__ K=(const bf16*)(T_.ws+T_.ok); const bf16*__restrict__ V=(const bf16*)(T_.ws+T_.ov);
  const int tid=threadIdx.x,lane=tid&63,r32=lane&31,hi=lane>>5; const int wid=__builtin_amdgcn_readfirstlane(tid>>6);
  const long rowbase=(long)b*SEQ; const int q0=qb*QB;
  const bf16*Qw=Q+(rowbase+q0+wid*QBLK)*DM+h*D;
  const bf16*Kh=K+(rowbase+(long)j0*KVBLK)*DM+h*D,*Vh=V+(rowbase+(long)j0*KVBLK)*DM+h*D;
  const unsigned lds0=(unsigned)(uintptr_t)shm;
  float*wsf=(float*)(shm+LDS_WS)+wid*64;
  const bf16*ksrc=Kh+(long)lane*DM+wid*8;
  const bf16*vsrc=Vh+(long)(16*(wid&3)+(lane>>2))*DM+(wid>>2)*32+(lane&3)*8;
  const unsigned kdst=lds0+LDS_K+wid*1024, vdst=lds0+LDS_V+wid*1024;
  #define DMA_K(t,slot) glds16(ksrc+(long)(t)*KVBLK*DM,(unsigned)__builtin_amdgcn_readfirstlane(kdst+(slot)))
  #define DMA_V(t,slot) glds16(vsrc+(long)(t)*KVBLK*DM,(unsigned)__builtin_amdgcn_readfirstlane(vdst+(slot)))
  const int vb0=(int)(lds0+LDS_V)+((lane>>4)&1)*32+(lane&3)*8+(4*hi+((lane&15)>>2))*64;
  const char*Kbase=shm+LDS_K; bf16x8 kf[8];
  const lds_cptr shm3=(lds_cptr)shm; const lds_cptr kp0=shm3+LDS_K+hi*1024+r32*16; const lds_cptr vp0=shm3+LDS_V+((lane>>4)&1)*32+(lane&3)*8+(4*hi+((lane&15)>>2))*64;
  const int NT=(q0+QB)/KVBLK-j0;
  DMA_K(0,0);DMA_V(0,0);DMA_K(1,SLOTB);
  bf16x8 qr[4];
  #pragma unroll
  for(int d0=0;d0<4;++d0)qr[d0]=*reinterpret_cast<const bf16x8*>(&Qw[(long)r32*DM+d0*16+hi*8]);
  float mhat=0.f,l_reg=0.f;f32x16 o[2];o[0]=f32x16{};o[1]=f32x16{};
  const lds_cptr bp0=shm3+LDS_BIAS+hi*16+j0*256;
  #define BL(P,t,g,off) do{ const f32x4v a_=*(const __attribute__((address_space(3))) f32x4v*)(bp0+(t)*256+(off)+(g)*32); P[4*(g)]=a_[0];P[4*(g)+1]=a_[1];P[4*(g)+2]=a_[2];P[4*(g)+3]=a_[3]; }while(0)
  #define BS(P,g) do{ P[4*(g)]-=mhat;P[4*(g)+1]-=mhat;P[4*(g)+2]-=mhat;P[4*(g)+3]-=mhat; }while(0)
  #define BINIT(P0,P1,t) do{ _Pragma("unroll") for(int g_=0;g_<4;++g_){BL(P0,t,g_,0);BL(P1,t,g_,128);} _Pragma("unroll") for(int g_=0;g_<4;++g_){BS(P0,g_);BS(P1,g_);} }while(0)
  const int qrel=wid*QBLK+r32;
  #define CMASK(P0,P1,t) do{int jb_=(t)-(NT-4); if(jb_>=0)cmask(P0,P1,jb_,qrel,hi);}while(0)
  bool resc=false;
  #define START(P0,P1) do{ resc=false; \
    if(THRL>=0){ const float rm=rowmax(P0,P1); if(__builtin_expect(__any(rm>(float)THRL),0)){ const float dl=__builtin_fmaxf(rm,0.f); mhat=fadd_s(mhat,dl); \
      _Pragma("unroll") for(int r=0;r<16;++r){P0[r]=fsub_s(P0[r],dl);P1[r]=fsub_s(P1[r],dl);} } } \
    _Pragma("unroll") for(int r=0;r<16;++r)P0[r]=__builtin_amdgcn_exp2f(P0[r]); }while(0)
  #define RESC() do{ if(resc){ asm volatile("s_waitcnt lgkmcnt(0)":::"memory"); \
      _Pragma("unroll") for(int d_=0;d_<2;++d_) _Pragma("unroll") for(int r=0;r<16;++r)o[d_][r]*=wsf[crow(r,hi)]; } }while(0)
  f32x16 pA0,pA1,pB0,pB1;
  int sl_prev=0,sl_cur=0,sl_next=SLOTB;
  #define ROT() do{sl_prev=sl_cur;sl_cur=sl_next;sl_next=(sl_next==(NSLOT-1)*SLOTB)?0:sl_next+SLOTB;}while(0)
  DMA_K(2,2*SLOTB);
  { __attribute__((address_space(3))) f32x4v*bd=(__attribute__((address_space(3))) f32x4v*)((__attribute__((address_space(3))) char*)shm+LDS_BIAS)+tid*2; bd[0]=brow0; bd[1]=brow1; }
  if(tid==0)nxt=gridDim.x+__hip_atomic_fetch_add(ctr,1u,__ATOMIC_RELAXED,__HIP_MEMORY_SCOPE_AGENT);
  WAIT_BAR(3);
  mhat=((const __attribute__((address_space(3))) float*)(shm3+LDS_BIAS))[q0+qrel]+T_.hdr;
  BINIT(pA0,pA1,0);
  qkt(pA0,pA1,Kbase,qr,r32,hi);asm volatile("s_nop 15\n\ts_nop 7":"+v"(pA0),"+v"(pA1));CMASK(pA0,pA1,0);
  START(pA0,pA1);
  BINIT(pB0,pB1,1);
  _Pragma("unroll") for(int r=0;r<16;++r)pA1[r]=__builtin_amdgcn_exp2f(pA1[r]);
  WAIT_BAR(0);
  DMA_K(3,0);DMA_V(1,SLOTB);
  ROT();
  kload8(kf,kp0+sl_cur);
  WAIT_BAR(2);
  s16x4 vlo[8],vhi[8]; u32x4 pw0,pw1,pw2,pw3;
  #define PKW(P,B) cvtpk_s(P[B],P[B+1])
  #define PAF(k) __builtin_bit_cast(bf16x8,pw##k)
  #define VFR(i) (bf16x8){vlo[i][0],vlo[i][1],vlo[i][2],vlo[i][3],vhi[i][0],vhi[i][1],vhi[i][2],vhi[i][3]}
  #define PIN(x) asm volatile("":"+v"(x))
  #define MX3(a,b,c) __builtin_fmaxf(__builtin_fmaxf((a),(b)),(c))
  #define GAPA(MF,A0,A1,A2,A3,W0,W1,PW) do{ MF; sacc+=A0; sacc+=A1; sacc+=A2; sacc+=A3; PIN(sacc); W0; W1; PIN(PW); SBAR(); }while(0)
  #define EX(v) __builtin_amdgcn_exp2f(v)
  #define GAPB(MF,X,B,E0,E1) do{ MF; X[B]=EX(X[B]); X[B+1]=EX(X[B+1]); X[B+2]=EX(X[B+2]); X[B+3]=EX(X[B+3]); PIN(X); E0; E1; SBAR(); }while(0)
  #define BLG(G,P,t,g,off) do{ if(G){ BL(P,t,g,off); } }while(0)
  #define BSG(G,P,g) do{ if(G){ BS(P,g); } }while(0)
  #define VRD(i) do{ vlo[i]=vtr(vp_+(((i)>>2)*4096+((i)&3)*1024)); vhi[i]=vtr(vp_+(((i)>>2)*4096+((i)&3)*1024+512)); }while(0)
  #define KRD(G,j) do{ if(G){ kload2(kf,kp0+sl_next,j); SBAR(); } }while(0)
  #define STEP(C0,C1,P0,P1,t,GK,GV,GL) do{ SBAR(); \
    const lds_cptr vp_=vp0+sl_prev; \
    VRD(0); SBAR(); float sacc=(P0[0]+P0[1]); \
    GAPA(C0=__builtin_amdgcn_mfma_f32_32x32x16_bf16(kf[0],qr[0],C0,0,0,0), P0[2],P0[3],P0[4],P0[5],     pw0[0]=PKW(P0,0), pw0[1]=PKW(P0,2), pw0); \
    VRD(4); SBAR(); GAPA(C1=__builtin_amdgcn_mfma_f32_32x32x16_bf16(kf[1],qr[0],C1,0,0,0), P0[6],P0[7],P0[8],P0[9],     pw0[2]=PKW(P0,4), pw0[3]=PKW(P0,6), pw0); \
    VRD(1); SBAR(); GAPA(C0=__builtin_amdgcn_mfma_f32_32x32x16_bf16(kf[2],qr[1],C0,0,0,0),   P0[10],P0[11],P0[12],P0[13], pw1[0]=PKW(P0,8), pw1[1]=PKW(P0,10), pw1); \
    VRD(5); SBAR(); GAPA(C1=__builtin_amdgcn_mfma_f32_32x32x16_bf16(kf[3],qr[1],C1,0,0,0),   P0[14],P0[15],P1[0],P1[1],   pw1[2]=PKW(P0,12),pw1[3]=PKW(P0,14), pw1); \
    VRD(2); SBAR(); GAPA(C0=__builtin_amdgcn_mfma_f32_32x32x16_bf16(kf[4],qr[2],C0,0,0,0),   P1[2],P1[3],P1[4],P1[5],     pw2[0]=PKW(P1,0), pw2[1]=PKW(P1,2), pw2); \
    VRD(6); SBAR(); GAPA(C1=__builtin_amdgcn_mfma_f32_32x32x16_bf16(kf[5],qr[2],C1,0,0,0),   P1[6],P1[7],P1[8],P1[9],     pw2[2]=PKW(P1,4), pw2[3]=PKW(P1,6), pw2); \
    VRD(3); SBAR(); GAPA(C0=__builtin_amdgcn_mfma_f32_32x32x16_bf16(kf[6],qr[3],C0,0,0,0),   P1[10],P1[11],P1[12],P1[13], pw3[0]=PKW(P1,8), pw3[1]=PKW(P1,10), pw3); \
    VRD(7); SBAR(); GAPA(C1=__builtin_amdgcn_mfma_f32_32x32x16_bf16(kf[7],qr[3],C1,0,0,0),   P1[14],P1[15],0.f,0.f,       pw3[2]=PKW(P1,12),pw3[3]=PKW(P1,14), pw3); \
    l_reg+=sacc; \
    if(GK){DMA_K((t)+3,sl_cur);} if(GV){DMA_V((t)+1,sl_next);} \
    CMASK(C0,C1,t); \
    if(THRL>=0){ float a=MX3(C0[0],C0[1],C1[0]),b=MX3(C0[2],C0[3],C1[1]); a=MX3(a,C1[2],C1[3]); \
      _Pragma("unroll") for(int r=4;r<16;r+=4){a=MX3(a,C0[r],C0[r+1]);b=MX3(b,C0[r+2],C0[r+3]);a=MX3(a,C1[r],C1[r+1]);b=MX3(b,C1[r+2],C1[r+3]);} \
      float rm=__builtin_fmaxf(a,b); { auto rr=__builtin_amdgcn_permlane32_swap(__float_as_uint(rm),__float_as_uint(rm),false,false); rm=__builtin_fmaxf(__uint_as_float(rr[0]),__uint_as_float(rr[1])); } \
      resc=false; \
      if(__builtin_expect(__any(rm>(float)THRL),0)){ const float dl=__builtin_fmaxf(rm,0.f); mhat+=dl; \
        _Pragma("unroll") for(int r=0;r<16;++r){C0[r]-=dl;C1[r]-=dl;} \
        const float f=__builtin_amdgcn_exp2f(-dl); l_reg*=f; if(hi==0)wsf[r32]=f; resc=true; } } \
    SBAR(); \
    GAPB(o[0]=__builtin_amdgcn_mfma_f32_32x32x16_bf16(PAF(0),VFR(0),o[0],0,0,0), C0,0,  BLG(GL,P0,(t)+1,0,0),  BLG(GL,P0,(t)+1,1,0)); \
    GAPB(o[1]=__builtin_amdgcn_mfma_f32_32x32x16_bf16(PAF(0),VFR(4),o[1],0,0,0), C0,4,  BLG(GL,P0,(t)+1,2,0),  BLG(GL,P0,(t)+1,3,0)); \
    KRD(GL,0); GAPB(o[0]=__builtin_amdgcn_mfma_f32_32x32x16_bf16(PAF(1),VFR(1),o[0],0,0,0), C0,8,  BLG(GL,P1,(t)+1,0,128), BLG(GL,P1,(t)+1,1,128)); \
    KRD(GL,1); GAPB(o[1]=__builtin_amdgcn_mfma_f32_32x32x16_bf16(PAF(1),VFR(5),o[1],0,0,0), C0,12, BLG(GL,P1,(t)+1,2,128), BLG(GL,P1,(t)+1,3,128)); \
    KRD(GL,2); GAPB(o[0]=__builtin_amdgcn_mfma_f32_32x32x16_bf16(PAF(2),VFR(2),o[0],0,0,0), C1,0,  BSG(GL,P0,0), BSG(GL,P0,1)); \
    KRD(GL,3); GAPB(o[1]=__builtin_amdgcn_mfma_f32_32x32x16_bf16(PAF(2),VFR(6),o[1],0,0,0), C1,4,  BSG(GL,P0,2), BSG(GL,P0,3)); \
    GAPB(o[0]=__builtin_amdgcn_mfma_f32_32x32x16_bf16(PAF(3),VFR(3),o[0],0,0,0), C1,8,  BSG(GL,P1,0), BSG(GL,P1,1)); \
    GAPB(o[1]=__builtin_amdgcn_mfma_f32_32x32x16_bf16(PAF(3),VFR(7),o[1],0,0,0), C1,12, BSG(GL,P1,2), BSG(GL,P1,3)); \
    }while(0)
  int t=1;
  #undef CMASK
  #define CMASK(P0,P1,t) do{}while(0)
  for(;t+5<NT;t+=2){
    STEP(pB0,pB1,pA0,pA1,t,true,true,true);     WAIT_BAR(2); RESC(); ROT();
    STEP(pA0,pA1,pB0,pB1,t+1,true,true,true);   WAIT_BAR(2); RESC(); ROT();
  }
  #undef CMASK
  #define CMASK(P0,P1,t) do{int jb_=(t)-(NT-4); if(jb_>=0)cmask(P0,P1,jb_,qrel,hi);}while(0)
  #define ENDW(tt) do{ if((tt)+3<NT){WAIT_BAR(2);} else if((tt)+2<NT){WAIT_BAR(1);} else {WAIT_BAR(0);} }while(0)
  for(;t+1<NT;t+=2){
    STEP(pB0,pB1,pA0,pA1,t,(t+3<NT),(t+1<NT),(t+1<NT));       ENDW(t);   RESC(); ROT();
    STEP(pA0,pA1,pB0,pB1,t+1,(t+4<NT),(t+2<NT),(t+2<NT));     ENDW(t+1); RESC(); ROT();
  }
  STEP(pB0,pB1,pA0,pA1,NT-1,false,false,false); RESC();
  const bf16*Zw=(const bf16*)(T_.ws+T_.oz)+(rowbase+q0+wid*QBLK)*DM+h*D;
  u32x4 zv[4];
  #pragma unroll
  for(int i=0;i<4;++i)zv[i]=*(const u32x4*)(Zw+(long)(i*8+(lane>>3))*DM+(lane&7)*8);
  { float sacc=pB0[0]+pB0[1]; _Pragma("unroll") for(int r=2;r<16;++r)sacc+=pB0[r]; _Pragma("unroll") for(int r=0;r<16;++r)sacc+=pB1[r]; l_reg+=sacc;
    pw0=(u32x4){PKW(pB0,0),PKW(pB0,2),PKW(pB0,4),PKW(pB0,6)};pw1=(u32x4){PKW(pB0,8),PKW(pB0,10),PKW(pB0,12),PKW(pB0,14)};pw2=(u32x4){PKW(pB1,0),PKW(pB1,2),PKW(pB1,4),PKW(pB1,6)};pw3=(u32x4){PKW(pB1,8),PKW(pB1,10),PKW(pB1,12),PKW(pB1,14)};
    SBAR(); pv(o,vb0+sl_cur,PAF(0),PAF(1),PAF(2),PAF(3)); }
  #undef PKW
  #undef PAF
  #undef VFR
  #undef PIN
  #undef MX3
  #undef GAPA
  #undef GAPB
  #undef EX
  #undef VRD
  #undef KRD
  #undef STEP
  #undef ENDW
  {auto rr=__builtin_amdgcn_permlane32_swap(__float_as_uint(l_reg),__float_as_uint(l_reg),false,false);l_reg=__uint_as_float(rr[0])+__uint_as_float(rr[1]);}
  if(hi==0)wsf[32+r32]=l_reg;asm volatile("s_waitcnt lgkmcnt(0)":::"memory");
  float rli[16];
  #pragma unroll
  for(int r=0;r<16;++r)rli[r]=__builtin_amdgcn_rcpf(wsf[32+crow(r,hi)]);
  bf16*Ow=(bf16*)(T_.ws+T_.oo)+(rowbase+q0+wid*QBLK)*OPITCH+h*D;
  { bf16*stg=(bf16*)(shm+LDS_OST)+wid*2048;
    #pragma unroll
    for(int r=0;r<16;++r){const int orow=crow(r,hi);
      #pragma unroll
      for(int d0=0;d0<2;++d0)stg[orow*64+d0*32+r32]=__float2bfloat16(o[d0][r]*rli[r]);}
    asm volatile("s_waitcnt lgkmcnt(0)":::"memory");
    #pragma unroll
    for(int i=0;i<4;++i){const int row=i*8+(lane>>3),ch=lane&7; u32x4 v=*(const u32x4*)(stg+row*64+ch*8);
      #pragma unroll
      for(int e=0;e<4;++e){ const float a0=__uint_as_float(v[e]<<16)*__uint_as_float(zv[i][e]<<16), a1=__uint_as_float(v[e]&0xffff0000u)*__uint_as_float(zv[i][e]&0xffff0000u); v[e]=cvtpk_s(a0,a1); }
      ATTN_STORE16(Ow+(long)row*OPITCH+ch*8,v);} }
  asm volatile("s_waitcnt lgkmcnt(0)\n\ts_barrier":::"memory");
  #undef DMA_K
  #undef DMA_V
  #undef CMASK
  #undef START
  #undef RESC
  #undef ROT
  #undef BL
  #undef BS
  #undef BINIT
  #undef BLG
  #undef BSG
}
constexpr int ATTN_LDS_BYTES=LDS_BYTES;
struct AttnUnit { int bh; int qb; };
__device__ __forceinline__ void bias_scan(char*shm,const float*__restrict__ lf,float*gdst=nullptr){
  const int tid=threadIdx.x,lane=tid&63,wid=tid>>6;
  float*bias=(float*)(shm+LDS_BIAS); float*wtot=(float*)(shm+LDS_WS);
  const f32x4v a=*(const f32x4v*)(lf+tid*8),b=*(const f32x4v*)(lf+tid*8+4);
  const float s0=a[0],s1=s0+a[1],s2=s1+a[2],s3=s2+a[3],s4=s3+b[0],s5=s4+b[1],s6=s5+b[2],s7=s6+b[3];
  float inc=s7;
  #pragma unroll
  for(int o=1;o<64;o<<=1){const float t=__shfl_up(inc,o); if(lane>=o)inc+=t;}
  if(lane==63)wtot[wid]=inc;
  asm volatile("s_waitcnt lgkmcnt(0)\n\ts_barrier":::"memory");
  float base=0.f;
  #pragma unroll
  for(int w=0;w<NW;++w){const float x=wtot[w]; if(w<wid)base+=x;}
  const float off=base+inc-s7; const float NL=-1.4426950408889634f;
  *(f32x4v*)(bias+tid*8)=(f32x4v){(off+s0)*NL,(off+s1)*NL,(off+s2)*NL,(off+s3)*NL};
  *(f32x4v*)(bias+tid*8+4)=(f32x4v){(off+s4)*NL,(off+s5)*NL,(off+s6)*NL,(off+s7)*NL};
  if(gdst){ *(f32x4v*)(gdst+tid*8)=(f32x4v){(off+s0)*NL,(off+s1)*NL,(off+s2)*NL,(off+s3)*NL}; *(f32x4v*)(gdst+tid*8+4)=(f32x4v){(off+s4)*NL,(off+s5)*NL,(off+s6)*NL,(off+s7)*NL}; }
  asm volatile("s_waitcnt lgkmcnt(0)\n\ts_barrier":::"memory");
}
__device__ __forceinline__ void j0_table(const char*shm,float gap,int*dst,int wave,int lane){
  const __attribute__((address_space(3))) float*bl=(const __attribute__((address_space(3))) float*)((const __attribute__((address_space(3))) char*)shm+LDS_BIAS);
  const float v=bl[64*lane+63];
  #pragma unroll
  for(int q=0;q<2;++q){ const int qb=2*wave+q; const float thr=bl[QB*qb]-gap; const unsigned long long mk=__ballot(v>=thr);
    int j0=mk?(int)__builtin_ctzll(mk):0; j0&=~1; const int jmax=4*qb; j0=j0<jmax?j0:jmax; if(lane==0)dst[qb]=j0; }
}
constexpr int LDS_J0=LDS_BIAS+SEQ*4;
static_assert(LDS_J0+4096<=131072,"attention LDS");
template<int THRL,class Extra> __device__ __forceinline__ void attn_phase_dyn(char*lds,const AttnTensors&T,unsigned*ctr,const Extra&X,int nextra){
  const int tid=threadIdx.x;
  volatile __attribute__((address_space(3))) unsigned* uw=(volatile __attribute__((address_space(3))) unsigned*)((__attribute__((address_space(3))) char*)lds+LDS_WS);
  volatile __attribute__((address_space(3))) int* jt=(volatile __attribute__((address_space(3))) int*)((__attribute__((address_space(3))) char*)lds+LDS_J0);
  for(int i=tid;i<BATCH*NHEAD*NQB;i+=NW*64)jt[i]=((const int*)(T.ws+T.oj0))[i];
  const unsigned G_=gridDim.x; unsigned nxt=blockIdx.x;
  for(;;){
    if(tid==0){uw[0]=nxt;}
    asm volatile("s_waitcnt lgkmcnt(0)\n\ts_barrier":::"memory");
    const unsigned u=(unsigned)__builtin_amdgcn_readfirstlane((int)uw[0]);
    if(u>=(unsigned)(BATCH*NHEAD*NQB+nextra))break;
    if(u>=(unsigned)(BATCH*NHEAD*NQB)){ if(tid==0)nxt=G_+__hip_atomic_fetch_add(ctr,1u,__ATOMIC_RELAXED,__HIP_MEMORY_SCOPE_AGENT);
      X((int)u-BATCH*NHEAD*NQB); asm volatile("s_waitcnt lgkmcnt(0)\n\ts_barrier":::"memory"); continue; }
    const int qb=NQB-1-(int)(u/(BATCH*NHEAD)), bh=(int)(u%(BATCH*NHEAD));
    const int j0=__builtin_amdgcn_readfirstlane((int)jt[bh*NQB+qb]);
    const f32x4v*src=(const f32x4v*)((const float*)(T.ws+T.obias)+(long)bh*SEQ)+tid*2; const f32x4v ba=src[0],bb=src[1];
    attn_unit<THRL>(bh/NHEAD,bh%NHEAD,qb,j0,ba,bb,ctr,nxt,T,lds);
  }
}
#undef SBAR
#undef WAIT_BAR
}
constexpr int NWAVES = 8;
#ifndef MK_N_LAUNCHES
#define MK_N_LAUNCHES 1
#endif
constexpr int N_LAUNCHES = MK_N_LAUNCHES;
constexpr int PER_PHASE = 6;

constexpr int BATCH = 8, T = 4096, D = 1024, H = 8, HD = 64, AW = 512, CW = 512, INW = 6152, NPROJ = 6144;
constexpr int M = BATCH * T;
constexpr float EPS = 1e-6f;
constexpr int SRC_F = 1536;

constexpr size_t MiB = 1u << 20;
constexpr size_t WS_ADA = 0;
constexpr size_t WS_WF = 128 * 1024;
constexpr size_t WS_CTL = 256 * 1024;
constexpr int CW_ATTNQ = 3456 + 128;
constexpr size_t WS_LF = 1 * MiB;
constexpr size_t WS_W1 = 2 * MiB;
constexpr size_t WS_WAB = 14 * MiB, WS_WO = 16 * MiB;
constexpr size_t WS_HB = 32 * MiB;
constexpr size_t WS_OAB = WS_HB;
constexpr size_t WS_Q = pg8::OFF_Q;
constexpr size_t WS_K = pg8::OFF_K, WS_V = pg8::OFF_V;
constexpr size_t WS_MG = WS_K;
constexpr size_t WS_SZA = pg8::OFF_SZA, WS_CU = pg8::OFF_CU, WS_GZ = pg8::OFF_GZ;
constexpr size_t WS_R = pg8::OFF_SGA, WS_SGB = pg8::OFF_SGB;
constexpr size_t WS_BIAS = 448 * MiB;
constexpr size_t WS_J0 = 449 * MiB;
constexpr size_t WS_END = 450 * MiB;

constexpr int RING_OFF = 0, RING_BYTES = 131072;
constexpr int MISC_OFF = RING_BYTES + 320;
constexpr int LDS_BYTES = 147456;
static_assert(attn_body::ATTN_LDS_BYTES <= RING_BYTES, "attention LDS");

#define GAS __attribute__((address_space(1)))
#define LAS __attribute__((address_space(3)))
typedef unsigned short bf16;
typedef unsigned v4u __attribute__((ext_vector_type(4)));
typedef float f32x4 __attribute__((ext_vector_type(4)));
#define LDS_WAIT() asm volatile("s_waitcnt lgkmcnt(0)" ::: "memory")
__device__ __forceinline__ unsigned pk2(float lo, float hi) { return pg8::cvt_pk_bf16(lo, hi); }
__device__ __forceinline__ float wave_sum(float v) {
#pragma unroll
    for (int o = 1; o < 64; o <<= 1) v += __shfl_xor(v, o);
    return v;
}

template <bool MAP> __device__ __forceinline__ void p0_transpose_item(const float* W, int K, int NS, bf16* WT, LAS float* scr, int item, int nkb, int lane) {
    const int pb = item / nkb, kb = item % nkb, k0 = 64 * kb, p0 = 32 * pb;
    const int sc = MAP ? pg8::proj_src_col(p0 + (lane & 31)) : p0 + (lane & 31);
#pragma unroll 8
    for (int i = 0; i < 32; ++i) { const int kk = 2 * i + (lane >> 5); scr[kk * 33 + (lane & 31)] = W[(size_t)(k0 + kk) * NS + sc]; }
    LDS_WAIT(); asm volatile("" ::: "memory");
    const int c = lane & 7;
#pragma unroll
    for (int j = 0; j < 4; ++j) { const int n = (lane >> 3) + 8 * j; const LAS float* s = scr + (8 * c) * 33 + n;
        v4u o; o.x = pk2(s[0 * 33], s[1 * 33]); o.y = pk2(s[2 * 33], s[3 * 33]); o.z = pk2(s[4 * 33], s[5 * 33]); o.w = pk2(s[6 * 33], s[7 * 33]);
        *(GAS v4u*)(WT + (size_t)(p0 + n) * K + k0 + 8 * c) = o; }
    LDS_WAIT(); asm volatile("" ::: "memory");
}

#define XB_TMO      128
#define XB_XCNT(j)  (256  + 64 * (j))
#define XB_XSUB(j)  (1280 + 64 * (j))
#define XB_XGEN(j)  (2304 + 64 * (j))
#define XB_TOP      3328
#define XB_TOPGEN   3392
#define XCD_BAR_WORDS 3456
#define XB_SPIN_CAP (1u << 18)

__device__ __forceinline__ unsigned xb_ld(unsigned* p)              { return __hip_atomic_load(p, __ATOMIC_RELAXED, __HIP_MEMORY_SCOPE_AGENT); }
__device__ __forceinline__ unsigned xb_add(unsigned* p, unsigned v) { return __hip_atomic_fetch_add(p, v, __ATOMIC_RELAXED, __HIP_MEMORY_SCOPE_AGENT); }
__device__ __forceinline__ unsigned xb_xcc_id() { return (unsigned)__builtin_amdgcn_s_getreg((3 << 11) | 20) & 0xFu; }
#define XB_SPIN(cond, bar) do { unsigned _sp = 0; while (cond) { __builtin_amdgcn_s_sleep(1); \
    if ((++_sp & 255u) == 0u) { if (xb_ld(&(bar)[XB_TMO])) break; if (_sp > XB_SPIN_CAP) { atomicAdd(&(bar)[XB_TMO], 1u); break; } } } } while (0)

struct XcdBarrier {
    unsigned* bar; unsigned x;
    volatile LAS unsigned* st;
};

__device__ __forceinline__ XcdBarrier xcd_barrier_post(unsigned* bar, volatile LAS unsigned* st) {
    XcdBarrier b; b.bar = bar; b.x = xb_xcc_id(); b.st = st;
    if (threadIdx.x == 0) (void)xb_add(&bar[XB_XCNT(b.x)], 1u);
    return b;
}
__device__ __forceinline__ void xcd_barrier_complete(unsigned* bar, unsigned x, unsigned& nloc, unsigned& nx) {
    const unsigned G = gridDim.x * gridDim.y * gridDim.z;
    unsigned sum, cnt, mine, sp = 0u;
    for (;;) {
        sum = 0u; cnt = 0u; mine = 0u;
#pragma unroll
        for (unsigned j = 0; j < 16; ++j) { const unsigned c = xb_ld(&bar[XB_XCNT(j)]); sum += c; cnt += (c > 0u) ? 1u : 0u; mine = (j == x) ? c : mine; }
        if (sum == G) break;
        __builtin_amdgcn_s_sleep(1);
        if ((++sp & 255u) == 0u) { if (xb_ld(&bar[XB_TMO])) break; if (sp > XB_SPIN_CAP) { atomicAdd(&bar[XB_TMO], 1u); break; } }
    }
    nloc = mine > 0u ? mine : 1u; nx = cnt > 0u ? cnt : 1u;
}

__device__ __forceinline__ void xcd_barrier(const XcdBarrier& b) {
    asm volatile("s_waitcnt vmcnt(0)" ::: "memory");
    __syncthreads();
    if (threadIdx.x == 0) {
        unsigned* bar = b.bar;
        __builtin_amdgcn_s_waitcnt(0);
        unsigned nloc = b.st[0], nx = b.st[1];
        if (nloc == 0u) { xcd_barrier_complete(bar, b.x, nloc, nx); b.st[0] = nloc; b.st[1] = nx; }
        const unsigned old = xb_add(&bar[XB_XSUB(b.x)], 1u);
        const unsigned gen = old / nloc;
        if (old + 1u == (gen + 1u) * nloc) {
            __builtin_amdgcn_fence(__ATOMIC_RELEASE, "agent");
            asm volatile("s_waitcnt vmcnt(0)" ::: "memory");
            const unsigned og = xb_add(&bar[XB_TOP], 1u);
            const unsigned tg = og / nx;
            if (og + 1u == (tg + 1u) * nx) xb_add(&bar[XB_TOPGEN], 1u);
            else XB_SPIN(xb_ld(&bar[XB_TOPGEN]) == tg, bar);
            __builtin_amdgcn_fence(__ATOMIC_ACQUIRE, "agent");
            xb_add(&bar[XB_XGEN(b.x)], 1u);
            asm volatile("s_waitcnt vmcnt(0)" ::: "memory");
        } else {
            XB_SPIN(xb_ld(&bar[XB_XGEN(b.x)]) == gen, bar);
            __builtin_amdgcn_fence(__ATOMIC_ACQUIRE, "agent");
            asm volatile("s_waitcnt vmcnt(0)" ::: "memory");
        }
    }
    __syncthreads();
}


__device__ __forceinline__ float qk_bound(const float* q_g, const float* k_g, int lane) {
    float gq = fabsf(q_g[lane]), gk = fabsf(k_g[lane]);
#pragma unroll
    for (int o = 1; o < 64; o <<= 1) { gq = fmaxf(gq, __shfl_xor(gq, o)); gk = fmaxf(gk, __shfl_xor(gk, o)); }
    return attn_body::C2 * 64.0f * 1.02f * gq * gk;
}
#ifndef GEMM1_WGM
#define GEMM1_WGM 16
#endif
constexpr float GAP_EXTRA = 38.0f;
struct Args { const float* in[13]; float* out; unsigned char* ws; };
struct ConvItems {
    LAS unsigned char* L;
    __device__ __forceinline__ void operator()(int item) const {
        const __attribute__((address_space(4))) Args* ap_ = (const __attribute__((address_space(4))) Args*)__builtin_amdgcn_kernarg_segment_ptr(); asm volatile("" : "+s"(ap_));
        unsigned char* ws = ap_->ws; const float* conv_w = ap_->in[9]; const float* w_a = ap_->in[10]; const float* w_b = ap_->in[11]; const float* w_o = ap_->in[12];
        const bf16* CUB = (const bf16*)(ws + WS_CU); const bf16* GZB = (const bf16*)(ws + WS_GZ); bf16* OAB = (bf16*)(ws + WS_OAB); bf16* WABT = (bf16*)(ws + WS_WAB); bf16* WOT = (bf16*)(ws + WS_WO);
        const int lane = threadIdx.x & 63, wave = __builtin_amdgcn_readfirstlane((int)threadIdx.x >> 6);
        if (item >= M / 128) {
            LAS float* scr = (LAS float*)(L + wave * 8704); int r = (item - M / 128) * 8 + wave;
            constexpr int I_A = (D / 32) * (AW / 64), I_B = (D / 32) * (CW / 64);
            if (r < I_A) p0_transpose_item<false>(w_a, D, D, WABT, scr, r, AW / 64, lane);
            else if (r < I_A + I_B) p0_transpose_item<false>(w_b, D, D, WABT + 512, scr, r - I_A, CW / 64, lane);
            else p0_transpose_item<false>(w_o, D, D, WOT, scr, r - I_A - I_B, D / 64, lane);
            return; }
        const int m0 = item * 128 + wave * 16; const int ch = 8 * lane;
        float w0[8], w1[8], w2[8];
#pragma unroll
        for (int e = 0; e < 8; ++e) { w0[e] = conv_w[ch + e]; w1[e] = conv_w[CW + ch + e]; w2[e] = conv_w[2 * CW + ch + e]; }
        float p1[8], p2[8];
        const bool first = (m0 % T) == 0;
        { v4u a = {0u, 0u, 0u, 0u}, bq = {0u, 0u, 0u, 0u};
          if (!first) { a = *(const v4u*)(CUB + (size_t)(m0 - 2) * CW + ch); bq = *(const v4u*)(CUB + (size_t)(m0 - 1) * CW + ch); }
#pragma unroll
          for (int e = 0; e < 4; ++e) { p2[2 * e] = pg8::bflo(a[e]); p2[2 * e + 1] = pg8::bfhi(a[e]); p1[2 * e] = pg8::bflo(bq[e]); p1[2 * e + 1] = pg8::bfhi(bq[e]); } }
#pragma unroll 4
        for (int r = 0; r < 16; ++r) { const int m = m0 + r;
            const v4u cv = *(const v4u*)(CUB + (size_t)m * CW + ch), gv = *(const v4u*)(GZB + (size_t)m * CW + ch);
            float cur[8], o[8];
#pragma unroll
            for (int e = 0; e < 4; ++e) { cur[2 * e] = pg8::bflo(cv[e]); cur[2 * e + 1] = pg8::bfhi(cv[e]); }
#pragma unroll
            for (int e = 0; e < 4; ++e) { o[2 * e] = pg8::bflo(gv[e]) * (w0[2 * e] * p2[2 * e] + w1[2 * e] * p1[2 * e] + w2[2 * e] * cur[2 * e]);
                o[2 * e + 1] = pg8::bfhi(gv[e]) * (w0[2 * e + 1] * p2[2 * e + 1] + w1[2 * e + 1] * p1[2 * e + 1] + w2[2 * e + 1] * cur[2 * e + 1]); }
            v4u ov; ov.x = pk2(o[0], o[1]); ov.y = pk2(o[2], o[3]); ov.z = pk2(o[4], o[5]); ov.w = pk2(o[6], o[7]);
            *(v4u*)(OAB + (size_t)m * 1024 + 512 + ch) = ov;
#pragma unroll
            for (int e = 0; e < 8; ++e) { p2[e] = p1[e]; p1[e] = cur[e]; }
        }
    }
};
constexpr int N_CONV_ITEMS = M / 128 + ((D / 32) * (AW / 64) + (D / 32) * (CW / 64) + (D / 32) * (D / 64)) / 8;

template <int LO, int HI> __global__ void __launch_bounds__(NWAVES * 64, 2) fox_fwd(Args args) {
    extern __shared__ __attribute__((aligned(16))) unsigned char lds[];
    LAS unsigned char* L = (LAS unsigned char*)lds;
    if (threadIdx.x < 2) ((volatile LAS unsigned*)(L + MISC_OFF))[threadIdx.x] = 0u;
    if (HI - LO > 1 && threadIdx.x == 0) (void)xb_add(&((unsigned*)(args.ws + WS_CTL))[XB_XCNT(xb_xcc_id())], 1u);
    __syncthreads();
#define PHASE_IDS() int tid = threadIdx.x; asm volatile("" : "+v"(tid)); int bx = blockIdx.x; asm volatile("" : "+s"(bx)); int G = gridDim.x; asm volatile("" : "+s"(G)); \
    const int lane = tid & 63, wave = __builtin_amdgcn_readfirstlane(tid >> 6); const int vcu = (G % 8 == 0) ? (bx % 8) * (G / 8) + bx / 8 : bx; const int gw = vcu * NWAVES + wave, NGW = G * NWAVES; (void)lane; (void)gw; (void)NGW
#define PHASE_PTRS() const __attribute__((address_space(4))) Args* ap_ = (const __attribute__((address_space(4))) Args*)__builtin_amdgcn_kernarg_segment_ptr(); asm volatile("" : "+s"(ap_)); unsigned char* ws = ap_->ws; const float* x = ap_->in[0]; const float* c = ap_->in[1]; const float* w_ada = ap_->in[2]; const float* b_ada = ap_->in[3]; const float* norm_g = ap_->in[4]; const float* w_in = ap_->in[5]; const float* b_f = ap_->in[6]; const float* q_g = ap_->in[7]; const float* k_g = ap_->in[8]; const float* conv_w = ap_->in[9]; const float* w_a = ap_->in[10]; const float* w_b = ap_->in[11]; const float* w_o = ap_->in[12]; float* ADA = (float*)(ws + WS_ADA); float* WF = (float*)(ws + WS_WF); float* LF = (float*)(ws + WS_LF); bf16* W1T = (bf16*)(ws + WS_W1); bf16* WABT = (bf16*)(ws + WS_WAB); bf16* WOT = (bf16*)(ws + WS_WO); bf16* HB = (bf16*)(ws + WS_HB); bf16* OAB = (bf16*)(ws + WS_OAB); bf16* QB = (bf16*)(ws + WS_Q); bf16* KB = (bf16*)(ws + WS_K); bf16* VB = (bf16*)(ws + WS_V); bf16* MG = (bf16*)(ws + WS_MG); bf16* SZA = (bf16*)(ws + WS_SZA); bf16* CUB = (bf16*)(ws + WS_CU); bf16* GZB = (bf16*)(ws + WS_GZ); bf16* RB = (bf16*)(ws + WS_R); bf16* SGB = (bf16*)(ws + WS_SGB);
#ifndef REPEAT_PHASE
#define REPEAT_PHASE -1
#endif
#define REPS(k) (REPEAT_PHASE == (k) ? 2 : 1)
#ifndef PHMASK
#define PHMASK 63
#endif
#define IN(k) ((((PHMASK) >> (k)) & 1) && LO <= (k) && (k) < HI)
#define BOTH(k) (IN(k) && IN((k) + 1))
#ifndef BAR_REPS
#define BAR_REPS 1
#endif
#define XBAR() for (int br_ = 0; br_ < BAR_REPS; ++br_) do { const __attribute__((address_space(4))) Args* bp_ = (const __attribute__((address_space(4))) Args*)__builtin_amdgcn_kernarg_segment_ptr(); asm volatile("" : "+s"(bp_)); XcdBarrier b_; b_.bar = (unsigned*)(bp_->ws + WS_CTL); b_.x = xb_xcc_id(); b_.st = (volatile LAS unsigned*)(L + MISC_OFF); xcd_barrier(b_); } while (0)

    for (int rep_ = 0; rep_ < REPS(0); ++rep_) if (IN(0)) {
        PHASE_PTRS(); PHASE_IDS();
        if (bx < 192) {
            LAS float* ct = (LAS float*)L;
            LAS float* red = (LAS float*)(L + 32768);
            for (int i = tid; i < 8192; i += NWAVES * 64) { const int b = i >> 10, k = i & 1023; ct[k * 8 + b] = c[i]; }
            __syncthreads();
            const int col = bx * 16 + (lane & 15), kpar = lane >> 4;
            float acc[8];
#pragma unroll
            for (int b = 0; b < 8; ++b) acc[b] = 0.f;
#pragma unroll 8
            for (int kk = 0; kk < 32; ++kk) { const int k = wave * 128 + 4 * kk + kpar; const float wv = w_ada[(size_t)k * 3072 + col];
                const f32x4 c0 = *(const LAS f32x4*)(ct + k * 8), c1 = *(const LAS f32x4*)(ct + k * 8 + 4);
                acc[0] += c0[0] * wv; acc[1] += c0[1] * wv; acc[2] += c0[2] * wv; acc[3] += c0[3] * wv; acc[4] += c1[0] * wv; acc[5] += c1[1] * wv; acc[6] += c1[2] * wv; acc[7] += c1[3] * wv; }
#pragma unroll
            for (int b = 0; b < 8; ++b) { acc[b] += __shfl_xor(acc[b], 16); acc[b] += __shfl_xor(acc[b], 32); if (lane < 16) red[(wave * 8 + b) * 16 + lane] = acc[b]; }
            __syncthreads();
            if (tid < 128) { const int b = tid >> 4, cl = tid & 15; float s = b_ada[bx * 16 + cl];
#pragma unroll
                for (int w = 0; w < 8; ++w) s += red[(w * 8 + b) * 16 + cl];
                ADA[b * 3072 + bx * 16 + cl] = s; }
            __syncthreads();
        }
        {
            const int i = bx * NWAVES * 64 + tid; if (i < 8192) { const int j = i >> 10, k = i & 1023; WF[i] = w_in[(size_t)k * INW + SRC_F + j]; }
        }
        if (bx >= 192) {
            LAS float* scr = (LAS float*)(L + wave * 8704); const int w2 = (bx - 192) * NWAVES + wave;
            p0_transpose_item<true>(w_in, D, INW, W1T, scr, 2048 + w2, D / 64, lane);
            p0_transpose_item<true>(w_in, D, INW, W1T, scr, 2048 + 512 + w2, D / 64, lane);
        }
        if (BOTH(0)) XBAR();
    }

    for (int rep_ = 0; rep_ < REPS(1); ++rep_) if (IN(1)) {
        PHASE_PTRS(); PHASE_IDS();
#define P1COL(j) (8 * lane + 512 * ((j) >> 1) + 4 * ((j) & 1))
        LAS float* wf = (LAS float*)L;
        for (int i = tid; i < 2048; i += NWAVES * 64) ((LAS f32x4*)wf)[i] = ((const f32x4*)WF)[i];
        __syncthreads();
        const int m0 = gw * 16, b = m0 / T;
        f32x4 gm[4], sh[4];
#pragma unroll
        for (int j = 0; j < 4; ++j) { const int col = P1COL(j); const f32x4 g = *(const f32x4*)(norm_g + col), scl = *(const f32x4*)(ADA + b * 3072 + 1024 + col);
            gm[j] = g * (scl + 1.0f); sh[j] = *(const f32x4*)(ADA + b * 3072 + col); }
        for (int r = 0; r < 16; ++r) { const int m = m0 + r; if (m >= M) break;
            const GAS float* xr = (const GAS float*)(x + (size_t)m * D);
            f32x4 v[4]; float s2 = 0.f;
#pragma unroll
            for (int j = 0; j < 4; ++j) { v[j] = *(const GAS f32x4*)(xr + P1COL(j)); s2 += (v[j][0] * v[j][0] + v[j][1] * v[j][1]) + (v[j][2] * v[j][2] + v[j][3] * v[j][3]); }
            const float rstd = 1.0f / sqrtf(wave_sum(s2) * (1.0f / D) + EPS);
#pragma unroll
            for (int j = 0; j < 4; ++j) v[j] = v[j] * rstd * gm[j] + sh[j];
#pragma unroll
            for (int j = 0; j < 2; ++j) { v4u o; o.x = pk2(v[2 * j][0], v[2 * j][1]); o.y = pk2(v[2 * j][2], v[2 * j][3]); o.z = pk2(v[2 * j + 1][0], v[2 * j + 1][1]); o.w = pk2(v[2 * j + 1][2], v[2 * j + 1][3]);
                *(GAS v4u*)(HB + (size_t)m * D + 8 * lane + 512 * j) = o; }
            float fl[8];
#pragma unroll
            for (int q = 0; q < 8; ++q) { float a = 0.f;
#pragma unroll
                for (int j = 0; j < 4; ++j) { const f32x4 w = *(const LAS f32x4*)(wf + q * 1024 + P1COL(j)); a += (v[j][0] * w[0] + v[j][1] * w[1]) + (v[j][2] * w[2] + v[j][3] * w[3]); }
                fl[q] = wave_sum(a); }
            float mine = fl[0];
#pragma unroll
            for (int q = 1; q < 8; ++q) mine = (lane == q) ? fl[q] : mine;
            if (lane < 8) { const float z = mine + b_f[lane]; const float ls = fminf(z, 0.f) - log1pf(__expf(-fabsf(z)));
                LF[(size_t)(b * 8 + lane) * T + (m - b * T)] = ls; }
        }
        {
            LAS float* scr = (LAS float*)(L + 32768 + wave * 8704);
            constexpr int I_1 = (NPROJ / 32) * (D / 64), I_A = (D / 32) * (AW / 64), I_B = (D / 32) * (CW / 64), I_O = (D / 32) * (D / 64);
            (void)I_A; (void)I_B; (void)I_O;
            static_assert(I_1 == 3072, "P0 converts items [2048, 3072) on its 64 GEMV-free workgroups");
            for (int it = gw; it < 2048; it += NGW) p0_transpose_item<true>(w_in, D, INW, W1T, scr, it, D / 64, lane);
        }
        __syncthreads();
        if (BOTH(1)) XBAR();
    }

    for (int rep_ = 0; rep_ < REPS(2); ++rep_) if (IN(2)) {
        PHASE_PTRS(); PHASE_IDS();
        if (bx < BATCH * H) {
            attn_body::bias_scan((char*)lds, LF + (size_t)bx * T, (float*)(ws + WS_BIAS) + (size_t)bx * T);
            attn_body::j0_table((const char*)lds, 2.0f * qk_bound(q_g, k_g, lane) + GAP_EXTRA, (int*)(ws + WS_J0) + bx * 16, wave, lane);
            __syncthreads(); }
        pg8::Gemm g{HB, W1T, M, NPROJ, D}; pg8::StaticOrder S; S.init(M, NPROJ, G, bx, GEMM1_WGM);
        pg8::EpiProj E{ws, q_g, k_g, attn_body::C2, EPS};
        pg8::gemm_phase<pg8::EpiProj, pg8::StaticOrder, PG8_ALIGN, PG8_SP2>(L + RING_OFF, g, S, E);
        if (BOTH(2)) XBAR();
    }

    for (int rep_ = 0; rep_ < REPS(3); ++rep_) if (IN(3)) {
        PHASE_PTRS(); PHASE_IDS();
        const float qkb = qk_bound(q_g, k_g, lane);
        const attn_body::AttnTensors AT{ws, WS_Q, WS_K, WS_V, WS_SZA, WS_LF, WS_OAB, WS_BIAS, WS_J0, 2.0f * qkb + GAP_EXTRA, qkb};
        const ConvItems CI{L};
        attn_body::attn_phase_dyn<-1, ConvItems>((char*)lds + RING_OFF, AT, (unsigned*)(ws + WS_CTL) + CW_ATTNQ, CI, N_CONV_ITEMS);
        if (BOTH(3)) XBAR();
    }

    for (int rep_ = 0; rep_ < REPS(4); ++rep_) if (IN(4)) {
        PHASE_PTRS(); PHASE_IDS();
        pg8::Gemm g{OAB, WABT, M, D, D}; pg8::StaticOrder S; S.init(M, D, G, bx);
        pg8::EpiMerge E{RB, SGB, MG};
        pg8::gemm_phase<pg8::EpiMerge, pg8::StaticOrder, PG8_ALIGN, PG8_SP2>(L + RING_OFF, g, S, E);
        if (BOTH(4)) XBAR();
    }

    for (int rep_ = 0; rep_ < REPS(5); ++rep_) if (IN(5)) {
        PHASE_PTRS(); PHASE_IDS();
        pg8::Gemm g{MG, WOT, M, D, D}; pg8::StaticOrder S; S.init(M, D, G, bx);
        pg8::EpiOut E{x, ADA + 2048, ap_->out};
        pg8::gemm_phase<pg8::EpiOut, pg8::StaticOrder, PG8_ALIGN, PG8_SP2>(L + RING_OFF, g, S, E);
    }
#undef IN
#undef BOTH
}

extern "C" void kernel_launch(void* const* d_in, const int* in_sizes, int n_in, void* d_out, int out_size, void* d_ws, size_t ws_size, hipStream_t stream) {
    static int grid = 0;
    if (grid == 0) {
        if (n_in != 13 || in_sizes[0] != M * D || out_size != M * D || ws_size < WS_END) { fprintf(stderr, "kernel_launch: shape/workspace mismatch (n_in %d, in0 %d, out %d, ws %zu); nothing launched\n", n_in, n_in > 0 ? in_sizes[0] : -1, out_size, ws_size); grid = -1; return; }
        int dev = 0, cus = 0, per_cu = 0;
        if (hipGetDevice(&dev) != hipSuccess || hipDeviceGetAttribute(&cus, hipDeviceAttributeMultiprocessorCount, dev) != hipSuccess) { fprintf(stderr, "kernel_launch: device query failed\n"); grid = -1; return; }
        bool ok = true;
#if MK_N_LAUNCHES == 1
        const void* kfull = (const void*)fox_fwd<0, PER_PHASE>;
        ok = hipFuncSetAttribute(kfull, hipFuncAttributeMaxDynamicSharedMemorySize, LDS_BYTES) == hipSuccess;
#else
        const void* kph[PER_PHASE] = {(const void*)fox_fwd<0, 1>, (const void*)fox_fwd<1, 2>, (const void*)fox_fwd<2, 3>, (const void*)fox_fwd<3, 4>, (const void*)fox_fwd<4, 5>, (const void*)fox_fwd<5, 6>};
        const void* kfull = kph[3];
        for (int i = 0; i < PER_PHASE; ++i) ok = ok && hipFuncSetAttribute(kph[i], hipFuncAttributeMaxDynamicSharedMemorySize, LDS_BYTES) == hipSuccess;
#endif
        if (!ok) { fprintf(stderr, "kernel_launch: hipFuncSetAttribute failed\n"); grid = -1; return; }
        if (hipOccupancyMaxActiveBlocksPerMultiprocessor(&per_cu, kfull, NWAVES * 64, LDS_BYTES) != hipSuccess || per_cu < 1) { fprintf(stderr, "kernel_launch: occupancy query reports %d workgroups per CU\n", per_cu); (void)hipGetLastError(); grid = -1; return; }
        grid = cus;
        if (grid != 256) { fprintf(stderr, "kernel_launch: built for a 256-CU device (got %d CUs); nothing launched\n", cus); grid = -1; return; }
    }
    if (grid < 0) return;
    if (hipMemsetAsync((char*)d_ws + WS_CTL, 0, (XCD_BAR_WORDS + 256) * 4, stream) != hipSuccess) { fprintf(stderr, "kernel_launch: hipMemsetAsync failed\n"); return; }
    Args a{};
    for (int i = 0; i < 13; ++i) a.in[i] = (const float*)d_in[i];
    a.out = (float*)d_out; a.ws = (unsigned char*)d_ws;
#if MK_N_LAUNCHES == 1
    {
        void* kargs[] = {&a};
        const hipError_t e = hipLaunchCooperativeKernel((const void*)fox_fwd<0, PER_PHASE>, dim3(grid), dim3(NWAVES * 64), kargs, LDS_BYTES, stream);
        if (e != hipSuccess) fprintf(stderr, "kernel_launch: cooperative launch failed: %s (grid %d)\n", hipGetErrorString(e), grid);
    }
#else
    {
        hipLaunchKernelGGL((fox_fwd<0, 1>), dim3(grid), dim3(NWAVES * 64), LDS_BYTES, stream, a);
        hipLaunchKernelGGL((fox_fwd<1, 2>), dim3(grid), dim3(NWAVES * 64), LDS_BYTES, stream, a);
        hipLaunchKernelGGL((fox_fwd<2, 3>), dim3(grid), dim3(NWAVES * 64), LDS_BYTES, stream, a);
        hipLaunchKernelGGL((fox_fwd<3, 4>), dim3(grid), dim3(NWAVES * 64), LDS_BYTES, stream, a);
        hipLaunchKernelGGL((fox_fwd<4, 5>), dim3(grid), dim3(NWAVES * 64), LDS_BYTES, stream, a);
        hipLaunchKernelGGL((fox_fwd<5, 6>), dim3(grid), dim3(NWAVES * 64), LDS_BYTES, stream, a);
        const hipError_t le = hipPeekAtLastError();
        if (le != hipSuccess) fprintf(stderr, "kernel_launch: a phase launch failed: %s\n", hipGetErrorName(le));
    }
#endif
}
```

```cpp
#include <hip/hip_runtime.h>
#include <cstdio>
#include <cstdint>
namespace pg8 {
#define PG8_LAS __attribute__((address_space(3)))
typedef unsigned short bf16_t;
typedef short bf16x8 __attribute__((ext_vector_type(8)));
typedef float f32x4 __attribute__((ext_vector_type(4)));
typedef unsigned u32x4 __attribute__((ext_vector_type(4)));
constexpr int BM = 256, BK = 64, HALF = 128, HTB = HALF * BK * 2  , STAGE_BYTES = 8 * HTB, NXCD = 8, WGM = 8;

__host__ __device__ __forceinline__ int lds_byte(int r, int c) { const int st = (r >> 4) * 2 + (c >> 5), rr = r & 15, cc = c & 31, ob = rr * 64 + cc * 2; return st * 1024 + (ob ^ (((ob >> 9) & 1) << 5)); }
__host__ __device__ __forceinline__ void stage_rc(int b, int& R, int& C) { const int st = b / 1024, sb = b % 1024, swz = sb ^ (((sb >> 9) & 1) << 5); R = (st >> 1) * 16 + swz / 64; C = (st & 1) * 32 + (swz % 64) / 2; }
__host__ __device__ __forceinline__ int perm32(int rho) { const int n = rho >> 4, i = rho & 15; return 8 * (i >> 2) + 4 * n + (i & 3); }

struct Unit { int pm, pn; };
struct Gemm { const bf16_t* A; const bf16_t* Bt; int M, N, K; };

struct StaticOrder {
    int nM, nN, nwg, G, c, wgm;
    __host__ __device__ void init(int M, int N, int G_, int c_, int wgm_ = WGM) { nM = M / BM; nN = N / BM; nwg = nM * nN; G = G_; c = c_; wgm = wgm_; }
    __host__ __device__ bool next(int i, Unit& u) const {
        const long L = (long)i * G + c; if (L >= nwg) return false;
        int wgid = (int)L; { const int q = nwg / NXCD, r = nwg % NXCD, xcd = wgid % NXCD, off = wgid / NXCD; wgid = (xcd < r ? xcd * (q + 1) : r * (q + 1) + (xcd - r) * q) + off; }
        const int nig = wgm * nN, gid = wgid / nig, fm = gid * wgm, gsz = (nM - fm) < wgm ? (nM - fm) : wgm;
        u.pm = fm + ((wgid % nig) % gsz); u.pn = (wgid % nig) / gsz; return true;
    }
    __device__ __forceinline__ void a_ready(const Unit&) const {}
    __device__ __forceinline__ void done(const Unit&) const {}
};

__device__ __forceinline__ unsigned cvt_pk_bf16(float lo, float hi) { unsigned r; asm volatile("v_cvt_pk_bf16_f32 %0, %1, %2" : "=v"(r) : "v"(lo), "v"(hi)); return r; }
typedef float f32x2 __attribute__((ext_vector_type(2)));
__device__ __forceinline__ float sigm(float x) { return __builtin_amdgcn_rcpf(1.0f + __builtin_amdgcn_exp2f(x * -1.4426950408889634f)); }
__device__ __forceinline__ float silu(float x) { return x * sigm(x); }
__device__ __forceinline__ float bflo(unsigned w) { return __builtin_bit_cast(float, w << 16); }
__device__ __forceinline__ float bfhi(unsigned w) { return __builtin_bit_cast(float, w & 0xffff0000u); }
typedef unsigned u32x2 __attribute__((ext_vector_type(2)));

constexpr size_t OFF_Q = 96u << 20, OFF_K = 128u << 20, OFF_V = 160u << 20, OFF_SZA = 192u << 20, OFF_CU = 224u << 20, OFF_GZ = 256u << 20, OFF_SGA = 320u << 20, OFF_SGB = 384u << 20;
struct EpiProj {
    static constexpr bool PERM = true, AFTER_DRAIN = false, MID = false;
    unsigned char* ws; const float *qg, *kg; float qscale, eps;
    __device__ __forceinline__ void operator()(const f32x4 (&acc)[2][2][4][2], const Unit& u, int wr, int wc, int fr, int fq) const {
        const int pn = u.pn; const size_t row0 = (size_t)u.pm * BM + wr * 64 + fr;
        if (pn < 4) {
            const bool isq = pn < 2; const float* g = isq ? qg : kg; bf16_t* dst = (bf16_t*)(ws + (isq ? OFF_Q : OFF_K)); const float sc = isq ? qscale : 1.0f;
            const int colb = (pn & 1) * 256 + 64 * wc + 8 * fq;
            f32x4 gv[2][2];
#pragma unroll
            for (int bj = 0; bj < 2; ++bj)
#pragma unroll
                for (int n = 0; n < 2; ++n) gv[bj][n] = *(const f32x4*)(g + 32 * bj + 8 * fq + 4 * n) * sc;
#pragma unroll
            for (int ai = 0; ai < 2; ++ai)
#pragma unroll
                for (int m = 0; m < 4; ++m) {
                    float ss = 0.f;
#pragma unroll
                    for (int bj = 0; bj < 2; ++bj)
#pragma unroll
                        for (int n = 0; n < 2; ++n) { const f32x4 x = acc[ai][bj][m][n]; ss += (x[0] * x[0] + x[1] * x[1]) + (x[2] * x[2] + x[3] * x[3]); }
                    ss += __shfl_xor(ss, 16); ss += __shfl_xor(ss, 32);
                    const float rstd = __builtin_amdgcn_rsqf(ss * (1.0f / 64.0f) + eps);
                    bf16_t* rowp = dst + (row0 + ai * HALF + m * 16) * 512 + colb;
#pragma unroll
                    for (int bj = 0; bj < 2; ++bj) { const f32x4 v0 = acc[ai][bj][m][0] * rstd * gv[bj][0], v1 = acc[ai][bj][m][1] * rstd * gv[bj][1];
                        u32x4 w; w.x = cvt_pk_bf16(v0[0], v0[1]); w.y = cvt_pk_bf16(v0[2], v0[3]); w.z = cvt_pk_bf16(v1[0], v1[1]); w.w = cvt_pk_bf16(v1[2], v1[3]);
                        *(u32x4*)(rowp + 32 * bj) = w; }
                }
        } else if (pn >= 8 && pn < 16) {
            const int col = 64 * (pn - 8) + 16 * wc + 8 * (fq >> 1); bf16_t* dstb = (bf16_t*)(ws + ((fq & 1) ? OFF_GZ : OFF_CU));
#pragma unroll
            for (int ai = 0; ai < 2; ++ai)
#pragma unroll
                for (int m = 0; m < 4; ++m) { const size_t off = (row0 + ai * HALF + m * 16) * 512 + col;
                    const f32x4 gb = acc[ai][0][m][0], gc = acc[ai][0][m][1], uu = acc[ai][1][m][0], zb = acc[ai][1][m][1];
                    const f32x4 cu = gc * uu; f32x4 gz; gz[0] = gb[0] * silu(zb[0]); gz[1] = gb[1] * silu(zb[1]); gz[2] = gb[2] * silu(zb[2]); gz[3] = gb[3] * silu(zb[3]);
                    u32x2 a, b; a.x = cvt_pk_bf16(cu[0], cu[1]); a.y = cvt_pk_bf16(cu[2], cu[3]); b.x = cvt_pk_bf16(gz[0], gz[1]); b.y = cvt_pk_bf16(gz[2], gz[3]);
                    const auto rx = __builtin_amdgcn_permlane16_swap(a.x, b.x, false, false), ry = __builtin_amdgcn_permlane16_swap(a.y, b.y, false, false);
                    u32x4 w; w.x = rx[0]; w.y = ry[0]; w.z = rx[1]; w.w = ry[1];
                    *(u32x4*)(dstb + off) = w; }
        } else if (pn >= 16) {
            const int col = 128 * (pn - 16) + 32 * wc + 8 * fq; unsigned short* AB = (unsigned short*)(ws + OFF_SGA);
#pragma unroll
            for (int ai = 0; ai < 2; ++ai)
#pragma unroll
                for (int m = 0; m < 4; ++m) { const size_t off = (row0 + ai * HALF + m * 16) * 1024 + col;
                    unsigned wd[4];
#pragma unroll
                    for (int n = 0; n < 2; ++n)
#pragma unroll
                        for (int h = 0; h < 2; ++h) { unsigned d = 0u;
#pragma unroll
                            for (int e = 0; e < 2; ++e) { const int i = 2 * h + e; const unsigned ta = (unsigned)(sigm(acc[ai][0][m][n][i]) * 255.0f + 0.5f); unsigned tb = (unsigned)(sigm(acc[ai][1][m][n][i]) * 255.0f + 0.5f); tb = tb < 1u ? 1u : tb;
                                d |= (ta | (tb << 8)) << (16 * e); }
                            wd[2 * n + h] = d; }
                    *(u32x4*)(AB + off) = (u32x4){wd[0], wd[1], wd[2], wd[3]};
                    asm volatile("" ::: "memory"); }
        } else {
            size_t doff; int ld, tcol, act;
            if (pn < 6) { doff = OFF_V; ld = 512; tcol = (pn - 4) * 256; act = 0; }
            else { doff = OFF_SZA; ld = 512; tcol = (pn - 6) * 256; act = 1; }
            bf16_t* dst = (bf16_t*)(ws + doff);
            const int colb = tcol + 64 * wc + 8 * fq;
#pragma unroll
            for (int ai = 0; ai < 2; ++ai)
#pragma unroll
                for (int m = 0; m < 4; ++m) { bf16_t* rowp = dst + (row0 + ai * HALF + m * 16) * ld + colb;
#pragma unroll
                    for (int bj = 0; bj < 2; ++bj) { f32x4 v0 = acc[ai][bj][m][0], v1 = acc[ai][bj][m][1];
                        if (act == 1) { v0[0] = silu(v0[0]); v0[1] = silu(v0[1]); v0[2] = silu(v0[2]); v0[3] = silu(v0[3]); v1[0] = silu(v1[0]); v1[1] = silu(v1[1]); v1[2] = silu(v1[2]); v1[3] = silu(v1[3]); }
                        u32x4 w; w.x = cvt_pk_bf16(v0[0], v0[1]); w.y = cvt_pk_bf16(v0[2], v0[3]); w.z = cvt_pk_bf16(v1[0], v1[1]); w.w = cvt_pk_bf16(v1[2], v1[3]);
                        *(u32x4*)(rowp + 32 * bj) = w; } }
        }
    }
};
__host__ __device__ __forceinline__ int proj_src_col(int p) {
    const int pn = p >> 8, r = p & 255, bj = r >> 7, wc = (r >> 5) & 3, jj = r & 31;
    if (pn >= 8 && pn < 16) { const int fq = jj >> 3, n = (jj >> 2) & 1, i = jj & 3; const int sect = bj == 0 ? (n == 0 ? 2056 : 2568) : (n == 0 ? 3080 : 3592); return sect + 64 * (pn - 8) + 16 * wc + 4 * fq + i; }
    if (pn >= 16) return (bj == 0 ? 4104 : 5128) + 128 * (pn - 16) + 32 * wc + jj;
    const int nat = 64 * wc + 32 * bj + jj;
    if (pn < 6) return 256 * pn + nat;
    return 1544 + 256 * (pn - 6) + nat;
}

struct EpiMerge {
    static constexpr bool PERM = true, AFTER_DRAIN = false, MID = true;
    const unsigned short* AB; bf16_t* MG;
    static __device__ __forceinline__ float ub(unsigned w, int k) { return (float)((w >> (8 * k)) & 0xffu); }
    __device__ __forceinline__ void mid(f32x4 (&acc)[2][2][4][2], const Unit& u, int wr, int wc, int fr, int fq) const {
        unsigned off0 = (unsigned)((u.pm * BM + wr * 64 + fr) * 1024 + u.pn * BM + wc * 32 + 8 * fq);
        asm volatile("" : "+v"(off0));
#pragma unroll
        for (int ai = 0; ai < 2; ++ai)
#pragma unroll
            for (int m = 0; m < 4; ++m) { const unsigned off = off0 + (unsigned)((ai * HALF + m * 16) * 1024);
#pragma unroll
                for (int bj = 0; bj < 2; ++bj) { const u32x4 g = *(const u32x4*)(AB + (off + bj * HALF));
                    acc[ai][bj][m][0] *= (f32x4){ub(g.x, 0) * __builtin_amdgcn_rcpf(ub(g.x, 1)), ub(g.x, 2) * __builtin_amdgcn_rcpf(ub(g.x, 3)), ub(g.y, 0) * __builtin_amdgcn_rcpf(ub(g.y, 1)), ub(g.y, 2) * __builtin_amdgcn_rcpf(ub(g.y, 3))};
                    acc[ai][bj][m][1] *= (f32x4){ub(g.z, 0) * __builtin_amdgcn_rcpf(ub(g.z, 1)), ub(g.z, 2) * __builtin_amdgcn_rcpf(ub(g.z, 3)), ub(g.w, 0) * __builtin_amdgcn_rcpf(ub(g.w, 1)), ub(g.w, 2) * __builtin_amdgcn_rcpf(ub(g.w, 3))}; }
                asm volatile("" ::: "memory"); }
    }
    __device__ __forceinline__ void operator()(const f32x4 (&acc)[2][2][4][2], const Unit& u, int wr, int wc, int fr, int fq) const {
        unsigned off0 = (unsigned)((u.pm * BM + wr * 64 + fr) * 1024 + u.pn * BM + wc * 32 + 8 * fq); const float s = 1.0f / 255.0f;
        asm volatile("" : "+v"(off0));
#pragma unroll
        for (int ai = 0; ai < 2; ++ai)
#pragma unroll
            for (int m = 0; m < 4; ++m) { const unsigned off = off0 + (unsigned)((ai * HALF + m * 16) * 1024);
#pragma unroll
                for (int bj = 0; bj < 2; ++bj) { const u32x4 g = *(const u32x4*)(AB + (off + bj * HALF)); const f32x4 v0 = acc[ai][bj][m][0] * s, v1 = acc[ai][bj][m][1] * s;
                    u32x4 w; w.x = cvt_pk_bf16(v0[0] * ub(g.x, 1), v0[1] * ub(g.x, 3)); w.y = cvt_pk_bf16(v0[2] * ub(g.y, 1), v0[3] * ub(g.y, 3));
                    w.z = cvt_pk_bf16(v1[0] * ub(g.z, 1), v1[1] * ub(g.z, 3)); w.w = cvt_pk_bf16(v1[2] * ub(g.w, 1), v1[3] * ub(g.w, 3));
                    *(u32x4*)((unsigned char*)MG + 2u * (off + bj * HALF)) = w; } }
    }
};
struct EpiOut {
    static constexpr bool PERM = false, AFTER_DRAIN = false, MID = false;
    const float* x; const float* gate; float* out;
    __device__ __forceinline__ void operator()(const f32x4 (&acc)[2][2][4][2], const Unit& u, int wr, int wc, int fr, int fq) const {
        const size_t row0 = (size_t)u.pm * BM + wr * 64 + fr; const int col0 = u.pn * BM + wc * 32 + 4 * fq; const float* gp = gate + (size_t)(u.pm >> 4) * 3072 + col0;
        f32x4 gv[2][2];
#pragma unroll
        for (int bj = 0; bj < 2; ++bj)
#pragma unroll
            for (int n = 0; n < 2; ++n) gv[bj][n] = *(const f32x4*)(gp + bj * HALF + n * 16);
#pragma unroll
        for (int ai = 0; ai < 2; ++ai) {
            f32x4 xv[4][2][2];
#pragma unroll
            for (int m = 0; m < 4; ++m) { const size_t off = (row0 + ai * HALF + m * 16) * 1024 + col0;
#pragma unroll
                for (int bj = 0; bj < 2; ++bj)
#pragma unroll
                    for (int n = 0; n < 2; ++n) xv[m][bj][n] = *(const f32x4*)(x + off + bj * HALF + n * 16); }
            asm volatile("" ::: "memory");
#pragma unroll
            for (int m = 0; m < 4; ++m) { const size_t off = (row0 + ai * HALF + m * 16) * 1024 + col0;
#pragma unroll
                for (int bj = 0; bj < 2; ++bj)
#pragma unroll
                    for (int n = 0; n < 2; ++n) *(f32x4*)(out + off + bj * HALF + n * 16) = xv[m][bj][n] + gv[bj][n] * acc[ai][bj][m][n]; }
            asm volatile("" ::: "memory"); }
    }
};

template <class Epi, class Sched, bool ALIGN_EPI = false, bool SP2 = false>
__device__ __forceinline__ void gemm_phase(PG8_LAS unsigned char* lds, const Gemm g, const Sched& S, const Epi& E) {
    int tid_ = threadIdx.x; asm volatile("" : "+v"(tid_));
    const int tid = tid_, wid = __builtin_amdgcn_readfirstlane(tid >> 6), lane = tid & 63, wr = wid >> 2, wc = wid & 3, fr = lane & 15, fq = lane >> 4;
    const int K = g.K, nt = K / BK;
    unsigned voffA[2], voffB[2];
#pragma unroll
    for (int i = 0; i < 2; ++i) { int R, C; stage_rc(tid * 16 + i * 8192, R, C); const int Rb = Epi::PERM ? ((R & ~31) + perm32(R & 31)) : R;
        voffA[i] = (unsigned)(R * K + C) * 2u; voffB[i] = (unsigned)(Rb * K + C) * 2u; }
    const size_t kstep = (size_t)(BK * 2);
    const size_t hstep = (size_t)HALF * K * 2;
    const size_t tstep = 2 * hstep;
    const unsigned ldsw = (unsigned)wid * 1024u;
    const int aoff = lds_byte(wr * 64 + fr, fq * 8), boff = lds_byte(wc * 32 + fr, fq * 8);
#define PG8_SA(b, h) (((b) * 2 + (h)) * HTB)
#define PG8_SB(b, h) ((4 + (b) * 2 + (h)) * HTB)
#define PG8_STAGE(bufoff, gbase, voff) do { _Pragma("unroll") for (int _i = 0; _i < 2; ++_i) \
        __builtin_amdgcn_global_load_lds((const unsigned*)((const char*)(gbase) + (voff)[_i]), (PG8_LAS unsigned*)(lds + (bufoff) + ldsw + _i * 8192), 16, 0, 0); } while (0)
#define PG8_LDA(dst, b, h) do { _Pragma("unroll") for (int m = 0; m < 4; ++m) _Pragma("unroll") for (int k = 0; k < 2; ++k) dst[m][k] = *(const PG8_LAS bf16x8*)(lds + PG8_SA(b, h) + aoff + m * 2048 + k * 1024); } while (0)
#define PG8_LDB(dst, b, h) do { _Pragma("unroll") for (int n = 0; n < 2; ++n) _Pragma("unroll") for (int k = 0; k < 2; ++k) dst[n][k] = *(const PG8_LAS bf16x8*)(lds + PG8_SB(b, h) + boff + n * 2048 + k * 1024); } while (0)
#define PG8_MMA(ai, bj, At, Bt) do { __builtin_amdgcn_s_setprio(1); _Pragma("unroll") for (int m = 0; m < 4; ++m) _Pragma("unroll") for (int n = 0; n < 2; ++n) _Pragma("unroll") for (int k = 0; k < 2; ++k) \
        acc[ai][bj][m][n] = __builtin_amdgcn_mfma_f32_16x16x32_bf16(Bt[n][k], At[m][k], acc[ai][bj][m][n], 0, 0, 0); __builtin_amdgcn_s_setprio(0); } while (0)
#define PG8_WAIT_V(n) asm volatile("s_waitcnt vmcnt(" #n ")" ::: "memory")
#define PG8_WAIT_L(n) asm volatile("s_waitcnt lgkmcnt(" #n ")" ::: "memory")
#define PG8_BAR __builtin_amdgcn_s_barrier()
#define PG8_SCHED __builtin_amdgcn_sched_barrier(0)
    Unit cur, nxt; int ui = 0;
    if (!S.next(0, cur)) return;
    f32x4 acc[2][2][4][2];
#pragma unroll
    for (int a = 0; a < 2; ++a)
#pragma unroll
        for (int b = 0; b < 2; ++b)
#pragma unroll
            for (int m = 0; m < 4; ++m)
#pragma unroll
                for (int n = 0; n < 2; ++n) acc[a][b][m][n] = (f32x4){0.f, 0.f, 0.f, 0.f};
    bf16x8 At[4][2], B0[2][2], B1[2][2];
    const char* cA = (const char*)g.A + (size_t)cur.pm * tstep; const char* cB = (const char*)g.Bt + (size_t)cur.pn * tstep;
    S.a_ready(cur);
    if constexpr (SP2) {
        PG8_STAGE(PG8_SB(0, 0), cB, voffB); PG8_STAGE(PG8_SB(0, 1), cB + hstep, voffB); PG8_STAGE(PG8_SA(0, 0), cA, voffA); PG8_STAGE(PG8_SA(0, 1), cA + hstep, voffA);
        if (wr == 1) PG8_BAR;
        PG8_WAIT_V(2); PG8_BAR;
        PG8_STAGE(PG8_SB(1, 0), cB + kstep, voffB); PG8_STAGE(PG8_SA(1, 0), cA + kstep, voffA); PG8_STAGE(PG8_SB(1, 1), cB + hstep + kstep, voffB);
        PG8_WAIT_V(6); PG8_BAR;
    } else {
        PG8_STAGE(PG8_SB(0, 0), cB, voffB); PG8_STAGE(PG8_SA(0, 0), cA, voffA); PG8_STAGE(PG8_SB(0, 1), cB + hstep, voffB); PG8_STAGE(PG8_SA(0, 1), cA + hstep, voffA);
        if (wr == 1) PG8_BAR;
        PG8_WAIT_V(4); PG8_BAR;
        PG8_STAGE(PG8_SB(1, 0), cB + kstep, voffB); PG8_STAGE(PG8_SA(1, 0), cA + kstep, voffA); PG8_STAGE(PG8_SB(1, 1), cB + hstep + kstep, voffB);
        PG8_WAIT_V(6); PG8_BAR;
    }
    for (;;) {
        const bool has_next = S.next(ui + 1, nxt);
        const char* nA = has_next ? (const char*)g.A + (size_t)nxt.pm * tstep : cA; const char* nB = has_next ? (const char*)g.Bt + (size_t)nxt.pn * tstep : cB;
        for (int t = 0; t < nt; t += 2) {
            if constexpr (Epi::MID) { if (t == nt / 2) E.mid(acc, cur, wr, wc, fr, fq); }
            const bool last = (t == nt - 2);
            const char* a1 = cA + (size_t)(t + 1) * kstep;
            const char* a2 = last ? nA : cA + (size_t)(t + 2) * kstep; const char* b2 = last ? nB : cB + (size_t)(t + 2) * kstep;
            const char* a3 = a2 + kstep; const char* b3 = b2 + kstep;
            if (last && has_next) S.a_ready(nxt);
            if constexpr (SP2) {
            PG8_LDB(B0, 0, 0); PG8_LDB(B1, 0, 1); PG8_SCHED; PG8_LDA(At, 0, 0); PG8_STAGE(PG8_SA(1, 1), a1 + hstep, voffA);
            PG8_WAIT_V(8); PG8_WAIT_L(0); PG8_BAR; PG8_MMA(0, 0, At, B0); PG8_MMA(0, 1, At, B1); PG8_BAR; PG8_SCHED;
            PG8_LDA(At, 0, 1); PG8_STAGE(PG8_SB(0, 0), b2, voffB); PG8_STAGE(PG8_SB(0, 1), b2 + hstep, voffB); PG8_STAGE(PG8_SA(0, 0), a2, voffA);
            PG8_WAIT_V(8); PG8_WAIT_L(0); PG8_BAR; PG8_MMA(1, 0, At, B0); PG8_MMA(1, 1, At, B1); PG8_BAR; PG8_SCHED;
            PG8_LDB(B0, 1, 0); PG8_LDB(B1, 1, 1); PG8_SCHED; PG8_LDA(At, 1, 0); PG8_STAGE(PG8_SA(0, 1), a2 + hstep, voffA);
            PG8_WAIT_V(8); PG8_WAIT_L(0); PG8_BAR; PG8_MMA(0, 0, At, B0); PG8_MMA(0, 1, At, B1); PG8_BAR; PG8_SCHED;
            PG8_LDA(At, 1, 1); PG8_STAGE(PG8_SB(1, 0), b3, voffB); PG8_STAGE(PG8_SB(1, 1), b3 + hstep, voffB); PG8_STAGE(PG8_SA(1, 0), a3, voffA);
            PG8_WAIT_V(8); PG8_WAIT_L(0); PG8_BAR; PG8_MMA(1, 0, At, B0); PG8_MMA(1, 1, At, B1); PG8_BAR; PG8_SCHED;
            } else {
            PG8_LDB(B0, 0, 0); PG8_SCHED; PG8_LDA(At, 0, 0); PG8_STAGE(PG8_SA(1, 1), a1 + hstep, voffA);
            PG8_WAIT_L(8); PG8_BAR; PG8_WAIT_L(0); PG8_MMA(0, 0, At, B0); PG8_BAR; PG8_SCHED;
            PG8_LDB(B1, 0, 1); PG8_STAGE(PG8_SB(0, 0), b2, voffB);
            PG8_BAR; PG8_WAIT_L(0); PG8_MMA(0, 1, At, B1); PG8_BAR;
            PG8_LDA(At, 0, 1); PG8_STAGE(PG8_SA(0, 0), a2, voffA);
            PG8_BAR; PG8_WAIT_L(0); PG8_MMA(1, 0, At, B0); PG8_BAR; PG8_SCHED;
            PG8_STAGE(PG8_SB(0, 1), b2 + hstep, voffB);
            PG8_WAIT_V(6); PG8_BAR; PG8_MMA(1, 1, At, B1); PG8_BAR;
            PG8_LDB(B0, 1, 0); PG8_SCHED; PG8_LDA(At, 1, 0); PG8_STAGE(PG8_SA(0, 1), a2 + hstep, voffA);
            PG8_WAIT_L(8); PG8_BAR; PG8_WAIT_L(0); PG8_MMA(0, 0, At, B0); PG8_BAR; PG8_SCHED;
            PG8_LDB(B1, 1, 1); PG8_STAGE(PG8_SB(1, 0), b3, voffB);
            PG8_BAR; PG8_WAIT_L(0); PG8_MMA(0, 1, At, B1); PG8_BAR;
            PG8_LDA(At, 1, 1); PG8_STAGE(PG8_SA(1, 0), a3, voffA);
            PG8_BAR; PG8_WAIT_L(0); PG8_MMA(1, 0, At, B0); PG8_BAR; PG8_SCHED;
            PG8_STAGE(PG8_SB(1, 1), b3 + hstep, voffB);
            PG8_WAIT_V(6); PG8_BAR; PG8_MMA(1, 1, At, B1); PG8_BAR;
            }
        }
        if constexpr (ALIGN_EPI) { if (wr == 0) PG8_BAR; }
        if constexpr (!Epi::AFTER_DRAIN) { E(acc, cur, wr, wc, fr, fq); S.done(cur); }
        if (!has_next) break;
#pragma unroll
        for (int a = 0; a < 2; ++a)
#pragma unroll
            for (int b = 0; b < 2; ++b)
#pragma unroll
                for (int m = 0; m < 4; ++m)
#pragma unroll
                    for (int n = 0; n < 2; ++n) acc[a][b][m][n] = (f32x4){0.f, 0.f, 0.f, 0.f};
        cur = nxt; cA = nA; cB = nB; ++ui;
        if constexpr (ALIGN_EPI) { if (wr == 1) PG8_BAR; }
    }
    PG8_WAIT_V(0);
    if constexpr (!ALIGN_EPI) { if (wr == 0) PG8_BAR; }
    PG8_BAR;
    if constexpr (Epi::AFTER_DRAIN) { E.fused(acc, cur, wr, wc, fr, fq, lds, wid, lane); S.done(cur); }
#undef PG8_SA
#undef PG8_SB
#undef PG8_STAGE
#undef PG8_LDA
#undef PG8_LDB
#undef PG8_MMA
#undef PG8_WAIT_V
#undef PG8_WAIT_L
#undef PG8_BAR
#undef PG8_SCHED
}
}

#ifndef PG8_SP2
#define PG8_SP2 true
#endif
#ifndef PG8_ALIGN
#define PG8_ALIGN true
#endif
#include <hip/hip_bf16.h>
#include <cmath>
namespace attn_body {
using bf16=__hip_bfloat16;
using bf16x8=__attribute__((ext_vector_type(8)))short;
using s16x4=__attribute__((ext_vector_type(4)))short;
using f32x16=__attribute__((ext_vector_type(16)))float;
using u32x4=__attribute__((ext_vector_type(4)))unsigned;
using f32x4v=__attribute__((ext_vector_type(4)))float;
constexpr int BATCH=8,NHEAD=8,SEQ=4096,D=64,DM=NHEAD*D;
constexpr int NW=8,QBLK=32,QB=QBLK*NW,KVBLK=64,NQB=SEQ/QB;
constexpr int ATTN_PITCH=DM, ATTN_UNIT_ROWS=QB, OPITCH=1024;
__device__ __forceinline__ int crow(int r,int hi){return (r&3)+8*(r>>2)+4*hi;}
#define SBAR() __builtin_amdgcn_sched_barrier(0)
__device__ __forceinline__ void cmask(f32x16&p0,f32x16&p1,int jb,int qrel,int hi){
  const float NEG=-INFINITY; int kb=64*jb+4*hi;
  #pragma unroll
  for(int r=0;r<16;++r){int kv=kb+(r&3)+8*(r>>2); if(kv>qrel)p0[r]=NEG; if(kv+32>qrel)p1[r]=NEG;}
}

constexpr int NSLOT=3, SLOTB=8192;
constexpr int LDS_K=0, LDS_V=NSLOT*SLOTB, LDS_WS=2*NSLOT*SLOTB, LDS_OST=LDS_WS+NW*64*4, LDS_BIAS=LDS_OST+NW*4096, LDS_BYTES=LDS_BIAS+SEQ*4;
constexpr float C2=0.125f*1.4426950408889634f;
__device__ __forceinline__ void glds16(const void*gsrc,unsigned lds_dst){unsigned keep;
  asm volatile("s_mov_b32 %0, m0\n\ts_mov_b32 m0, %2\n\ts_nop 0\n\tglobal_load_lds_dwordx4 %1, off\n\ts_mov_b32 m0, %0":"=&s"(keep):"v"(gsrc),"s"(lds_dst):"memory");}
__device__ __forceinline__ float max3f(float a,float b,float c){float r;asm("v_max3_f32 %0, %1, %2, %3":"=v"(r):"v"(a),"v"(b),"v"(c));return r;}
__device__ __forceinline__ float max2f(float a,float b){float r;asm("v_max_f32_e32 %0, %1, %2":"=v"(r):"v"(a),"v"(b));return r;}
__device__ __forceinline__ float fadd_s(float a,float b){float r;asm("v_add_f32_e32 %0, %1, %2":"=v"(r):"v"(a),"v"(b));return r;}
__device__ __forceinline__ float fsub_s(float a,float b){float r;asm("v_sub_f32_e32 %0, %1, %2":"=v"(r):"v"(a),"v"(b));return r;}
typedef float f32x2_t __attribute__((ext_vector_type(2))); typedef __bf16 bf16x2_t __attribute__((ext_vector_type(2)));
__device__ __forceinline__ unsigned cvtpk_s(float lo,float hi){f32x2_t v={lo,hi};bf16x2_t b=__builtin_convertvector(v,bf16x2_t);return __builtin_bit_cast(unsigned,b);}
#define WAIT_BAR(N) asm volatile("s_waitcnt vmcnt(" #N ") lgkmcnt(0)\n\ts_barrier":::"memory")

__device__ __forceinline__ void qkt(f32x16&p0,f32x16&p1,const char*Kslot,const bf16x8*qr,int r32,int hi){
  const char*kb=Kslot+hi*1024+r32*16;
  #pragma unroll
  for(int d0=0;d0<4;++d0){
    const bf16x8 b0=*reinterpret_cast<const bf16x8*>(kb+d0*2048);
    const bf16x8 b1=*reinterpret_cast<const bf16x8*>(kb+d0*2048+512);
    p0=__builtin_amdgcn_mfma_f32_32x32x16_bf16(b0,qr[d0],p0,0,0,0);p1=__builtin_amdgcn_mfma_f32_32x32x16_bf16(b1,qr[d0],p1,0,0,0);}
}
typedef __attribute__((address_space(3))) const char* lds_cptr;
typedef short v4i16_t __attribute__((ext_vector_type(4)));
__device__ __forceinline__ void kload8(bf16x8*kf,lds_cptr kp){
  kf[0]=*(const __attribute__((address_space(3))) bf16x8*)(kp);      kf[1]=*(const __attribute__((address_space(3))) bf16x8*)(kp+512);
  kf[2]=*(const __attribute__((address_space(3))) bf16x8*)(kp+2048); kf[3]=*(const __attribute__((address_space(3))) bf16x8*)(kp+2560);
  kf[4]=*(const __attribute__((address_space(3))) bf16x8*)(kp+4096); kf[5]=*(const __attribute__((address_space(3))) bf16x8*)(kp+4608);
  kf[6]=*(const __attribute__((address_space(3))) bf16x8*)(kp+6144); kf[7]=*(const __attribute__((address_space(3))) bf16x8*)(kp+6656);
}
__device__ __forceinline__ void kload2(bf16x8*kf,lds_cptr kp,int j){ kf[2*j]=*(const __attribute__((address_space(3))) bf16x8*)(kp+j*2048); kf[2*j+1]=*(const __attribute__((address_space(3))) bf16x8*)(kp+j*2048+512); }
__device__ __forceinline__ s16x4 vtr(lds_cptr p){ return __builtin_bit_cast(s16x4,__builtin_amdgcn_ds_read_tr16_b64_v4i16((__attribute__((address_space(3))) v4i16_t*)p)); }
__device__ __forceinline__ float rowmax(const f32x16&p0,const f32x16&p1){
  float a=max3f(p0[0],p0[1],p1[0]),b=max3f(p0[2],p0[3],p1[1]);a=max3f(a,p1[2],p1[3]);
  #pragma unroll
  for(int r=4;r<16;r+=4){a=max3f(a,p0[r],p0[r+1]);b=max3f(b,p0[r+2],p0[r+3]);a=max3f(a,p1[r],p1[r+1]);b=max3f(b,p1[r+2],p1[r+3]);}
  const float m=max2f(a,b);
  auto rr=__builtin_amdgcn_permlane32_swap(__float_as_uint(m),__float_as_uint(m),false,false);
  return max2f(__uint_as_float(rr[0]),__uint_as_float(rr[1]));
}
__device__ __forceinline__ void pv(f32x16*o,int vb,bf16x8 pa0,bf16x8 pa1,bf16x8 pa2,bf16x8 pa3){
  #pragma unroll
  for(int d0=0;d0<2;++d0){s16x4 lo[4],hi[4];
    #pragma unroll
    for(int ks=0;ks<4;++ks){
      asm volatile("ds_read_b64_tr_b16 %0,%1 offset:%c2":"=&v"(lo[ks]):"v"(vb),"i"(d0*4096+ks*1024):"memory");
      asm volatile("ds_read_b64_tr_b16 %0,%1 offset:%c2":"=&v"(hi[ks]):"v"(vb),"i"(d0*4096+ks*1024+512):"memory");}
    asm volatile("s_waitcnt lgkmcnt(0)":::"memory");SBAR();
    #define PK(k) (bf16x8){lo[k][0],lo[k][1],lo[k][2],lo[k][3],hi[k][0],hi[k][1],hi[k][2],hi[k][3]}
    o[d0]=__builtin_amdgcn_mfma_f32_32x32x16_bf16(pa0,PK(0),o[d0],0,0,0);
    o[d0]=__builtin_amdgcn_mfma_f32_32x32x16_bf16(pa1,PK(1),o[d0],0,0,0);
    o[d0]=__builtin_amdgcn_mfma_f32_32x32x16_bf16(pa2,PK(2),o[d0],0,0,0);
    o[d0]=__builtin_amdgcn_mfma_f32_32x32x16_bf16(pa3,PK(3),o[d0],0,0,0);
    #undef PK
  }
}

#ifndef ATTN_STORE16
#define ATTN_STORE16(p,v) (*(u32x4*)(p)=(v))
#endif
struct AttnTensors { unsigned char* ws; size_t oq,ok,ov,oz,olf,oo,obias,oj0; float gap,hdr; };
template<int THRL> __device__ __forceinline__ void attn_unit(int b,int h,int qb,int j0,f32x4v brow0,f32x4v brow1,unsigned*ctr,unsigned&nxt,const AttnTensors&T_,char*shm){
  const bf16*Q=(const bf16*)(T_.ws+T_.oq); const bf16*__restrict__ K=(const bf16*)(T_.ws+T_.ok); const bf16*__restrict__ V=(const bf16*)(T_.ws+T_.ov);
  const int tid=threadIdx.x,lane=tid&63,r32=lane&31,hi=lane>>5; const int wid=__builtin_amdgcn_readfirstlane(tid>>6);
  const long rowbase=(long)b*SEQ; const int q0=qb*QB;
  const bf16*Qw=Q+(rowbase+q0+wid*QBLK)*DM+h*D;
  const bf16*Kh=K+(rowbase+(long)j0*KVBLK)*DM+h*D,*Vh=V+(rowbase+(long)j0*KVBLK)*DM+h*D;
  const unsigned lds0=(unsigned)(uintptr_t)shm;
  float*wsf=(float*)(shm+LDS_WS)+wid*64;
  const bf16*ksrc=Kh+(long)lane*DM+wid*8;
  const bf16*vsrc=Vh+(long)(16*(wid&3)+(lane>>2))*DM+(wid>>2)*32+(lane&3)*8;
  const unsigned kdst=lds0+LDS_K+wid*1024, vdst=lds0+LDS_V+wid*1024;
  #define DMA_K(t,slot) glds16(ksrc+(long)(t)*KVBLK*DM,(unsigned)__builtin_amdgcn_readfirstlane(kdst+(slot)))
  #define DMA_V(t,slot) glds16(vsrc+(long)(t)*KVBLK*DM,(unsigned)__builtin_amdgcn_readfirstlane(vdst+(slot)))
  const int vb0=(int)(lds0+LDS_V)+((lane>>4)&1)*32+(lane&3)*8+(4*hi+((lane&15)>>2))*64;
  const char*Kbase=shm+LDS_K; bf16x8 kf[8];
  const lds_cptr shm3=(lds_cptr)shm; const lds_cptr kp0=shm3+LDS_K+hi*1024+r32*16; const lds_cptr vp0=shm3+LDS_V+((lane>>4)&1)*32+(lane&3)*8+(4*hi+((lane&15)>>2))*64;
  const int NT=(q0+QB)/KVBLK-j0;
  DMA_K(0,0);DMA_V(0,0);DMA_K(1,SLOTB);
  bf16x8 qr[4];
  #pragma unroll
  for(int d0=0;d0<4;++d0)qr[d0]=*reinterpret_cast<const bf16x8*>(&Qw[(long)r32*DM+d0*16+hi*8]);
  float mhat=0.f,l_reg=0.f;f32x16 o[2];o[0]=f32x16{};o[1]=f32x16{};
  const lds_cptr bp0=shm3+LDS_BIAS+hi*16+j0*256;
  #define BL(P,t,g,off) do{ const f32x4v a_=*(const __attribute__((address_space(3))) f32x4v*)(bp0+(t)*256+(off)+(g)*32); P[4*(g)]=a_[0];P[4*(g)+1]=a_[1];P[4*(g)+2]=a_[2];P[4*(g)+3]=a_[3]; }while(0)
  #define BS(P,g) do{ P[4*(g)]-=mhat;P[4*(g)+1]-=mhat;P[4*(g)+2]-=mhat;P[4*(g)+3]-=mhat; }while(0)
  #define BINIT(P0,P1,t) do{ _Pragma("unroll") for(int g_=0;g_<4;++g_){BL(P0,t,g_,0);BL(P1,t,g_,128);} _Pragma("unroll") for(int g_=0;g_<4;++g_){BS(P0,g_);BS(P1,g_);} }while(0)
  const int qrel=wid*QBLK+r32;
  #define CMASK(P0,P1,t) do{int jb_=(t)-(NT-4); if(jb_>=0)cmask(P0,P1,jb_,qrel,hi);}while(0)
  bool resc=false;
  #define START(P0,P1) do{ resc=false; \
    if(THRL>=0){ const float rm=rowmax(P0,P1); if(__builtin_expect(__any(rm>(float)THRL),0)){ const float dl=__builtin_fmaxf(rm,0.f); mhat=fadd_s(mhat,dl); \
      _Pragma("unroll") for(int r=0;r<16;++r){P0[r]=fsub_s(P0[r],dl);P1[r]=fsub_s(P1[r],dl);} } } \
    _Pragma("unroll") for(int r=0;r<16;++r)P0[r]=__builtin_amdgcn_exp2f(P0[r]); }while(0)
  #define RESC() do{ if(resc){ asm volatile("s_waitcnt lgkmcnt(0)":::"memory"); \
      _Pragma("unroll") for(int d_=0;d_<2;++d_) _Pragma("unroll") for(int r=0;r<16;++r)o[d_][r]*=wsf[crow(r,hi)]; } }while(0)
  f32x16 pA0,pA1,pB0,pB1;
  int sl_prev=0,sl_cur=0,sl_next=SLOTB;
  #define ROT() do{sl_prev=sl_cur;sl_cur=sl_next;sl_next=(sl_next==(NSLOT-1)*SLOTB)?0:sl_next+SLOTB;}while(0)
  DMA_K(2,2*SLOTB);
  { __attribute__((address_space(3))) f32x4v*bd=(__attribute__((address_space(3))) f32x4v*)((__attribute__((address_space(3))) char*)shm+LDS_BIAS)+tid*2; bd[0]=brow0; bd[1]=brow1; }
  if(tid==0)nxt=gridDim.x+__hip_atomic_fetch_add(ctr,1u,__ATOMIC_RELAXED,__HIP_MEMORY_SCOPE_AGENT);
  WAIT_BAR(3);
  mhat=((const __attribute__((address_space(3))) float*)(shm3+LDS_BIAS))[q0+qrel]+T_.hdr;
  BINIT(pA0,pA1,0);
  qkt(pA0,pA1,Kbase,qr,r32,hi);asm volatile("s_nop 15\n\ts_nop 7":"+v"(pA0),"+v"(pA1));CMASK(pA0,pA1,0);
  START(pA0,pA1);
  BINIT(pB0,pB1,1);
  _Pragma("unroll") for(int r=0;r<16;++r)pA1[r]=__builtin_amdgcn_exp2f(pA1[r]);
  WAIT_BAR(0);
  DMA_K(3,0);DMA_V(1,SLOTB);
  ROT();
  kload8(kf,kp0+sl_cur);
  WAIT_BAR(2);
  s16x4 vlo[8],vhi[8]; u32x4 pw0,pw1,pw2,pw3;
  #define PKW(P,B) cvtpk_s(P[B],P[B+1])
  #define PAF(k) __builtin_bit_cast(bf16x8,pw##k)
  #define VFR(i) (bf16x8){vlo[i][0],vlo[i][1],vlo[i][2],vlo[i][3],vhi[i][0],vhi[i][1],vhi[i][2],vhi[i][3]}
  #define PIN(x) asm volatile("":"+v"(x))
  #define MX3(a,b,c) __builtin_fmaxf(__builtin_fmaxf((a),(b)),(c))
  #define GAPA(MF,A0,A1,A2,A3,W0,W1,PW) do{ MF; sacc+=A0; sacc+=A1; sacc+=A2; sacc+=A3; PIN(sacc); W0; W1; PIN(PW); SBAR(); }while(0)
  #define EX(v) __builtin_amdgcn_exp2f(v)
  #define GAPB(MF,X,B,E0,E1) do{ MF; X[B]=EX(X[B]); X[B+1]=EX(X[B+1]); X[B+2]=EX(X[B+2]); X[B+3]=EX(X[B+3]); PIN(X); E0; E1; SBAR(); }while(0)
  #define BLG(G,P,t,g,off) do{ if(G){ BL(P,t,g,off); } }while(0)
  #define BSG(G,P,g) do{ if(G){ BS(P,g); } }while(0)
  #define VRD(i) do{ vlo[i]=vtr(vp_+(((i)>>2)*4096+((i)&3)*1024)); vhi[i]=vtr(vp_+(((i)>>2)*4096+((i)&3)*1024+512)); }while(0)
  #define KRD(G,j) do{ if(G){ kload2(kf,kp0+sl_next,j); SBAR(); } }while(0)
  #define STEP(C0,C1,P0,P1,t,GK,GV,GL) do{ SBAR(); \
    const lds_cptr vp_=vp0+sl_prev; \
    VRD(0); SBAR(); float sacc=(P0[0]+P0[1]); \
    GAPA(C0=__builtin_amdgcn_mfma_f32_32x32x16_bf16(kf[0],qr[0],C0,0,0,0), P0[2],P0[3],P0[4],P0[5],     pw0[0]=PKW(P0,0), pw0[1]=PKW(P0,2), pw0); \
    VRD(4); SBAR(); GAPA(C1=__builtin_amdgcn_mfma_f32_32x32x16_bf16(kf[1],qr[0],C1,0,0,0), P0[6],P0[7],P0[8],P0[9],     pw0[2]=PKW(P0,4), pw0[3]=PKW(P0,6), pw0); \
    VRD(1); SBAR(); GAPA(C0=__builtin_amdgcn_mfma_f32_32x32x16_bf16(kf[2],qr[1],C0,0,0,0),   P0[10],P0[11],P0[12],P0[13], pw1[0]=PKW(P0,8), pw1[1]=PKW(P0,10), pw1); \
    VRD(5); SBAR(); GAPA(C1=__builtin_amdgcn_mfma_f32_32x32x16_bf16(kf[3],qr[1],C1,0,0,0),   P0[14],P0[15],P1[0],P1[1],   pw1[2]=PKW(P0,12),pw1[3]=PKW(P0,14), pw1); \
    VRD(2); SBAR(); GAPA(C0=__builtin_amdgcn_mfma_f32_32x32x16_bf16(kf[4],qr[2],C0,0,0,0),   P1[2],P1[3],P1[4],P1[5],     pw2[0]=PKW(P1,0), pw2[1]=PKW(P1,2), pw2); \
    VRD(6); SBAR(); GAPA(C1=__builtin_amdgcn_mfma_f32_32x32x16_bf16(kf[5],qr[2],C1,0,0,0),   P1[6],P1[7],P1[8],P1[9],     pw2[2]=PKW(P1,4), pw2[3]=PKW(P1,6), pw2); \
    VRD(3); SBAR(); GAPA(C0=__builtin_amdgcn_mfma_f32_32x32x16_bf16(kf[6],qr[3],C0,0,0,0),   P1[10],P1[11],P1[12],P1[13], pw3[0]=PKW(P1,8), pw3[1]=PKW(P1,10), pw3); \
    VRD(7); SBAR(); GAPA(C1=__builtin_amdgcn_mfma_f32_32x32x16_bf16(kf[7],qr[3],C1,0,0,0),   P1[14],P1[15],0.f,0.f,       pw3[2]=PKW(P1,12),pw3[3]=PKW(P1,14), pw3); \
    l_reg+=sacc; \
    if(GK){DMA_K((t)+3,sl_cur);} if(GV){DMA_V((t)+1,sl_next);} \
    CMASK(C0,C1,t); \
    if(THRL>=0){ float a=MX3(C0[0],C0[1],C1[0]),b=MX3(C0[2],C0[3],C1[1]); a=MX3(a,C1[2],C1[3]); \
      _Pragma("unroll") for(int r=4;r<16;r+=4){a=MX3(a,C0[r],C0[r+1]);b=MX3(b,C0[r+2],C0[r+3]);a=MX3(a,C1[r],C1[r+1]);b=MX3(b,C1[r+2],C1[r+3]);} \
      float rm=__builtin_fmaxf(a,b); { auto rr=__builtin_amdgcn_permlane32_swap(__float_as_uint(rm),__float_as_uint(rm),false,false); rm=__builtin_fmaxf(__uint_as_float(rr[0]),__uint_as_float(rr[1])); } \
      resc=false; \
      if(__builtin_expect(__any(rm>(float)THRL),0)){ const float dl=__builtin_fmaxf(rm,0.f); mhat+=dl; \
        _Pragma("unroll") for(int r=0;r<16;++r){C0[r]-=dl;C1[r]-=dl;} \
        const float f=__builtin_amdgcn_exp2f(-dl); l_reg*=f; if(hi==0)wsf[r32]=f; resc=true; } } \
    SBAR(); \
    GAPB(o[0]=__builtin_amdgcn_mfma_f32_32x32x16_bf16(PAF(0),VFR(0),o[0],0,0,0), C0,0,  BLG(GL,P0,(t)+1,0,0),  BLG(GL,P0,(t)+1,1,0)); \
    GAPB(o[1]=__builtin_amdgcn_mfma_f32_32x32x16_bf16(PAF(0),VFR(4),o[1],0,0,0), C0,4,  BLG(GL,P0,(t)+1,2,0),  BLG(GL,P0,(t)+1,3,0)); \
    KRD(GL,0); GAPB(o[0]=__builtin_amdgcn_mfma_f32_32x32x16_bf16(PAF(1),VFR(1),o[0],0,0,0), C0,8,  BLG(GL,P1,(t)+1,0,128), BLG(GL,P1,(t)+1,1,128)); \
    KRD(GL,1); GAPB(o[1]=__builtin_amdgcn_mfma_f32_32x32x16_bf16(PAF(1),VFR(5),o[1],0,0,0), C0,12, BLG(GL,P1,(t)+1,2,128), BLG(GL,P1,(t)+1,3,128)); \
    KRD(GL,2); GAPB(o[0]=__builtin_amdgcn_mfma_f32_32x32x16_bf16(PAF(2),VFR(2),o[0],0,0,0), C1,0,  BSG(GL,P0,0), BSG(GL,P0,1)); \
    KRD(GL,3); GAPB(o[1]=__builtin_amdgcn_mfma_f32_32x32x16_bf16(PAF(2),VFR(6),o[1],0,0,0), C1,4,  BSG(GL,P0,2), BSG(GL,P0,3)); \
    GAPB(o[0]=__builtin_amdgcn_mfma_f32_32x32x16_bf16(PAF(3),VFR(3),o[0],0,0,0), C1,8,  BSG(GL,P1,0), BSG(GL,P1,1)); \
    GAPB(o[1]=__builtin_amdgcn_mfma_f32_32x32x16_bf16(PAF(3),VFR(7),o[1],0,0,0), C1,12, BSG(GL,P1,2), BSG(GL,P1,3)); \
    }while(0)
  int t=1;
  #undef CMASK
  #define CMASK(P0,P1,t) do{}while(0)
  for(;t+5<NT;t+=2){
    STEP(pB0,pB1,pA0,pA1,t,true,true,true);     WAIT_BAR(2); RESC(); ROT();
    STEP(pA0,pA1,pB0,pB1,t+1,true,true,true);   WAIT_BAR(2); RESC(); ROT();
  }
  #undef CMASK
  #define CMASK(P0,P1,t) do{int jb_=(t)-(NT-4); if(jb_>=0)cmask(P0,P1,jb_,qrel,hi);}while(0)
  #define ENDW(tt) do{ if((tt)+3<NT){WAIT_BAR(2);} else if((tt)+2<NT){WAIT_BAR(1);} else {WAIT_BAR(0);} }while(0)
  for(;t+1<NT;t+=2){
    STEP(pB0,pB1,pA0,pA1,t,(t+3<NT),(t+1<NT),(t+1<NT));       ENDW(t);   RESC(); ROT();
    STEP(pA0,pA1,pB0,pB1,t+1,(t+4<NT),(t+2<NT),(t+2<NT));     ENDW(t+1); RESC(); ROT();
  }
  STEP(pB0,pB1,pA0,pA1,NT-1,false,false,false); RESC();
  const bf16*Zw=(const bf16*)(T_.ws+T_.oz)+(rowbase+q0+wid*QBLK)*DM+h*D;
  u32x4 zv[4];
  #pragma unroll
  for(int i=0;i<4;++i)zv[i]=*(const u32x4*)(Zw+(long)(i*8+(lane>>3))*DM+(lane&7)*8);
  { float sacc=pB0[0]+pB0[1]; _Pragma("unroll") for(int r=2;r<16;++r)sacc+=pB0[r]; _Pragma("unroll") for(int r=0;r<16;++r)sacc+=pB1[r]; l_reg+=sacc;
    pw0=(u32x4){PKW(pB0,0),PKW(pB0,2),PKW(pB0,4),PKW(pB0,6)};pw1=(u32x4){PKW(pB0,8),PKW(pB0,10),PKW(pB0,12),PKW(pB0,14)};pw2=(u32x4){PKW(pB1,0),PKW(pB1,2),PKW(pB1,4),PKW(pB1,6)};pw3=(u32x4){PKW(pB1,8),PKW(pB1,10),PKW(pB1,12),PKW(pB1,14)};
    SBAR(); pv(o,vb0+sl_cur,PAF(0),PAF(1),PAF(2),PAF(3)); }
  #undef PKW
  #undef PAF
  #undef VFR
  #undef PIN
  #undef MX3
  #undef GAPA
  #undef GAPB
  #undef EX
  #undef VRD
  #undef KRD
  #undef STEP
  #undef ENDW
  {auto rr=__builtin_amdgcn_permlane32_swap(__float_as_uint(l_reg),__float_as_uint(l_reg),false,false);l_reg=__uint_as_float(rr[0])+__uint_as_float(rr[1]);}
  if(hi==0)wsf[32+r32]=l_reg;asm volatile("s_waitcnt lgkmcnt(0)":::"memory");
  float rli[16];
  #pragma unroll
  for(int r=0;r<16;++r)rli[r]=__builtin_amdgcn_rcpf(wsf[32+crow(r,hi)]);
  bf16*Ow=(bf16*)(T_.ws+T_.oo)+(rowbase+q0+wid*QBLK)*OPITCH+h*D;
  { bf16*stg=(bf16*)(shm+LDS_OST)+wid*2048;
    #pragma unroll
    for(int r=0;r<16;++r){const int orow=crow(r,hi);
      #pragma unroll
      for(int d0=0;d0<2;++d0)stg[orow*64+d0*32+r32]=__float2bfloat16(o[d0][r]*rli[r]);}
    asm volatile("s_waitcnt lgkmcnt(0)":::"memory");
    #pragma unroll
    for(int i=0;i<4;++i){const int row=i*8+(lane>>3),ch=lane&7; u32x4 v=*(const u32x4*)(stg+row*64+ch*8);
      #pragma unroll
      for(int e=0;e<4;++e){ const float a0=__uint_as_float(v[e]<<16)*__uint_as_float(zv[i][e]<<16), a1=__uint_as_float(v[e]&0xffff0000u)*__uint_as_float(zv[i][e]&0xffff0000u); v[e]=cvtpk_s(a0,a1); }
      ATTN_STORE16(Ow+(long)row*OPITCH+ch*8,v);} }
  asm volatile("s_waitcnt lgkmcnt(0)\n\ts_barrier":::"memory");
  #undef DMA_K
  #undef DMA_V
  #undef CMASK
  #undef START
  #undef RESC
  #undef ROT
  #undef BL
  #undef BS
  #undef BINIT
  #undef BLG
  #undef BSG
}
constexpr int ATTN_LDS_BYTES=LDS_BYTES;
struct AttnUnit { int bh; int qb; };
__device__ __forceinline__ void bias_scan(char*shm,const float*__restrict__ lf,float*gdst=nullptr){
  const int tid=threadIdx.x,lane=tid&63,wid=tid>>6;
  float*bias=(float*)(shm+LDS_BIAS); float*wtot=(float*)(shm+LDS_WS);
  const f32x4v a=*(const f32x4v*)(lf+tid*8),b=*(const f32x4v*)(lf+tid*8+4);
  const float s0=a[0],s1=s0+a[1],s2=s1+a[2],s3=s2+a[3],s4=s3+b[0],s5=s4+b[1],s6=s5+b[2],s7=s6+b[3];
  float inc=s7;
  #pragma unroll
  for(int o=1;o<64;o<<=1){const float t=__shfl_up(inc,o); if(lane>=o)inc+=t;}
  if(lane==63)wtot[wid]=inc;
  asm volatile("s_waitcnt lgkmcnt(0)\n\ts_barrier":::"memory");
  float base=0.f;
  #pragma unroll
  for(int w=0;w<NW;++w){const float x=wtot[w]; if(w<wid)base+=x;}
  const float off=base+inc-s7; const float NL=-1.4426950408889634f;
  *(f32x4v*)(bias+tid*8)=(f32x4v){(off+s0)*NL,(off+s1)*NL,(off+s2)*NL,(off+s3)*NL};
  *(f32x4v*)(bias+tid*8+4)=(f32x4v){(off+s4)*NL,(off+s5)*NL,(off+s6)*NL,(off+s7)*NL};
  if(gdst){ *(f32x4v*)(gdst+tid*8)=(f32x4v){(off+s0)*NL,(off+s1)*NL,(off+s2)*NL,(off+s3)*NL}; *(f32x4v*)(gdst+tid*8+4)=(f32x4v){(off+s4)*NL,(off+s5)*NL,(off+s6)*NL,(off+s7)*NL}; }
  asm volatile("s_waitcnt lgkmcnt(0)\n\ts_barrier":::"memory");
}
__device__ __forceinline__ void j0_table(const char*shm,float gap,int*dst,int wave,int lane){
  const __attribute__((address_space(3))) float*bl=(const __attribute__((address_space(3))) float*)((const __attribute__((address_space(3))) char*)shm+LDS_BIAS);
  const float v=bl[64*lane+63];
  #pragma unroll
  for(int q=0;q<2;++q){ const int qb=2*wave+q; const float thr=bl[QB*qb]-gap; const unsigned long long mk=__ballot(v>=thr);
    int j0=mk?(int)__builtin_ctzll(mk):0; j0&=~1; const int jmax=4*qb; j0=j0<jmax?j0:jmax; if(lane==0)dst[qb]=j0; }
}
constexpr int LDS_J0=LDS_BIAS+SEQ*4;
static_assert(LDS_J0+4096<=131072,"attention LDS");
template<int THRL,class Extra> __device__ __forceinline__ void attn_phase_dyn(char*lds,const AttnTensors&T,unsigned*ctr,const Extra&X,int nextra){
  const int tid=threadIdx.x;
  volatile __attribute__((address_space(3))) unsigned* uw=(volatile __attribute__((address_space(3))) unsigned*)((__attribute__((address_space(3))) char*)lds+LDS_WS);
  volatile __attribute__((address_space(3))) int* jt=(volatile __attribute__((address_space(3))) int*)((__attribute__((address_space(3))) char*)lds+LDS_J0);
  for(int i=tid;i<BATCH*NHEAD*NQB;i+=NW*64)jt[i]=((const int*)(T.ws+T.oj0))[i];
  const unsigned G_=gridDim.x; unsigned nxt=blockIdx.x;
  for(;;){
    if(tid==0){uw[0]=nxt;}
    asm volatile("s_waitcnt lgkmcnt(0)\n\ts_barrier":::"memory");
    const unsigned u=(unsigned)__builtin_amdgcn_readfirstlane((int)uw[0]);
    if(u>=(unsigned)(BATCH*NHEAD*NQB+nextra))break;
    if(u>=(unsigned)(BATCH*NHEAD*NQB)){ if(tid==0)nxt=G_+__hip_atomic_fetch_add(ctr,1u,__ATOMIC_RELAXED,__HIP_MEMORY_SCOPE_AGENT);
      X((int)u-BATCH*NHEAD*NQB); asm volatile("s_waitcnt lgkmcnt(0)\n\ts_barrier":::"memory"); continue; }
    const int qb=NQB-1-(int)(u/(BATCH*NHEAD)), bh=(int)(u%(BATCH*NHEAD));
    const int j0=__builtin_amdgcn_readfirstlane((int)jt[bh*NQB+qb]);
    const f32x4v*src=(const f32x4v*)((const float*)(T.ws+T.obias)+(long)bh*SEQ)+tid*2; const f32x4v ba=src[0],bb=src[1];
    attn_unit<THRL>(bh/NHEAD,bh%NHEAD,qb,j0,ba,bb,ctr,nxt,T,lds);
  }
}
#undef SBAR
#undef WAIT_BAR
}
constexpr int NWAVES = 8;
#ifndef MK_N_LAUNCHES
#define MK_N_LAUNCHES 1
#endif
constexpr int N_LAUNCHES = MK_N_LAUNCHES;
constexpr int PER_PHASE = 6;

constexpr int BATCH = 8, T = 4096, D = 1024, H = 8, HD = 64, AW = 512, CW = 512, INW = 6152, NPROJ = 6144;
constexpr int M = BATCH * T;
constexpr float EPS = 1e-6f;
constexpr int SRC_F = 1536;

constexpr size_t MiB = 1u << 20;
constexpr size_t WS_ADA = 0;
constexpr size_t WS_WF = 128 * 1024;
constexpr size_t WS_CTL = 256 * 1024;
constexpr int CW_ATTNQ = 3456 + 128;
constexpr size_t WS_LF = 1 * MiB;
constexpr size_t WS_W1 = 2 * MiB;
constexpr size_t WS_WAB = 14 * MiB, WS_WO = 16 * MiB;
constexpr size_t WS_HB = 32 * MiB;
constexpr size_t WS_OAB = WS_HB;
constexpr size_t WS_Q = pg8::OFF_Q;
constexpr size_t WS_K = pg8::OFF_K, WS_V = pg8::OFF_V;
constexpr size_t WS_MG = WS_K;
constexpr size_t WS_SZA = pg8::OFF_SZA, WS_CU = pg8::OFF_CU, WS_GZ = pg8::OFF_GZ;
constexpr size_t WS_R = pg8::OFF_SGA, WS_SGB = pg8::OFF_SGB;
constexpr size_t WS_BIAS = 448 * MiB;
constexpr size_t WS_J0 = 449 * MiB;
constexpr size_t WS_END = 450 * MiB;

constexpr int RING_OFF = 0, RING_BYTES = 131072;
constexpr int MISC_OFF = RING_BYTES + 320;
constexpr int LDS_BYTES = 147456;
static_assert(attn_body::ATTN_LDS_BYTES <= RING_BYTES, "attention LDS");

#define GAS __attribute__((address_space(1)))
#define LAS __attribute__((address_space(3)))
typedef unsigned short bf16;
typedef unsigned v4u __attribute__((ext_vector_type(4)));
typedef float f32x4 __attribute__((ext_vector_type(4)));
#define LDS_WAIT() asm volatile("s_waitcnt lgkmcnt(0)" ::: "memory")
__device__ __forceinline__ unsigned pk2(float lo, float hi) { return pg8::cvt_pk_bf16(lo, hi); }
__device__ __forceinline__ float wave_sum(float v) {
#pragma unroll
    for (int o = 1; o < 64; o <<= 1) v += __shfl_xor(v, o);
    return v;
}

template <bool MAP> __device__ __forceinline__ void p0_transpose_item(const float* W, int K, int NS, bf16* WT, LAS float* scr, int item, int nkb, int lane) {
    const int pb = item / nkb, kb = item % nkb, k0 = 64 * kb, p0 = 32 * pb;
    const int sc = MAP ? pg8::proj_src_col(p0 + (lane & 31)) : p0 + (lane & 31);
#pragma unroll 8
    for (int i = 0; i < 32; ++i) { const int kk = 2 * i + (lane >> 5); scr[kk * 33 + (lane & 31)] = W[(size_t)(k0 + kk) * NS + sc]; }
    LDS_WAIT(); asm volatile("" ::: "memory");
    const int c = lane & 7;
#pragma unroll
    for (int j = 0; j < 4; ++j) { const int n = (lane >> 3) + 8 * j; const LAS float* s = scr + (8 * c) * 33 + n;
        v4u o; o.x = pk2(s[0 * 33], s[1 * 33]); o.y = pk2(s[2 * 33], s[3 * 33]); o.z = pk2(s[4 * 33], s[5 * 33]); o.w = pk2(s[6 * 33], s[7 * 33]);
        *(GAS v4u*)(WT + (size_t)(p0 + n) * K + k0 + 8 * c) = o; }
    LDS_WAIT(); asm volatile("" ::: "memory");
}

#define XB_TMO      128
#define XB_XCNT(j)  (256  + 64 * (j))
#define XB_XSUB(j)  (1280 + 64 * (j))
#define XB_XGEN(j)  (2304 + 64 * (j))
#define XB_TOP      3328
#define XB_TOPGEN   3392
#define XCD_BAR_WORDS 3456
#define XB_SPIN_CAP (1u << 18)

__device__ __forceinline__ unsigned xb_ld(unsigned* p)              { return __hip_atomic_load(p, __ATOMIC_RELAXED, __HIP_MEMORY_SCOPE_AGENT); }
__device__ __forceinline__ unsigned xb_add(unsigned* p, unsigned v) { return __hip_atomic_fetch_add(p, v, __ATOMIC_RELAXED, __HIP_MEMORY_SCOPE_AGENT); }
__device__ __forceinline__ unsigned xb_xcc_id() { return (unsigned)__builtin_amdgcn_s_getreg((3 << 11) | 20) & 0xFu; }
#define XB_SPIN(cond, bar) do { unsigned _sp = 0; while (cond) { __builtin_amdgcn_s_sleep(1); \
    if ((++_sp & 255u) == 0u) { if (xb_ld(&(bar)[XB_TMO])) break; if (_sp > XB_SPIN_CAP) { atomicAdd(&(bar)[XB_TMO], 1u); break; } } } } while (0)

struct XcdBarrier {
    unsigned* bar; unsigned x;
    volatile LAS unsigned* st;
};

__device__ __forceinline__ XcdBarrier xcd_barrier_post(unsigned* bar, volatile LAS unsigned* st) {
    XcdBarrier b; b.bar = bar; b.x = xb_xcc_id(); b.st = st;
    if (threadIdx.x == 0) (void)xb_add(&bar[XB_XCNT(b.x)], 1u);
    return b;
}
__device__ __forceinline__ void xcd_barrier_complete(unsigned* bar, unsigned x, unsigned& nloc, unsigned& nx) {
    const unsigned G = gridDim.x * gridDim.y * gridDim.z;
    unsigned sum, cnt, mine, sp = 0u;
    for (;;) {
        sum = 0u; cnt = 0u; mine = 0u;
#pragma unroll
        for (unsigned j = 0; j < 16; ++j) { const unsigned c = xb_ld(&bar[XB_XCNT(j)]); sum += c; cnt += (c > 0u) ? 1u : 0u; mine = (j == x) ? c : mine; }
        if (sum == G) break;
        __builtin_amdgcn_s_sleep(1);
        if ((++sp & 255u) == 0u) { if (xb_ld(&bar[XB_TMO])) break; if (sp > XB_SPIN_CAP) { atomicAdd(&bar[XB_TMO], 1u); break; } }
    }
    nloc = mine > 0u ? mine : 1u; nx = cnt > 0u ? cnt : 1u;
}

__device__ __forceinline__ void xcd_barrier(const XcdBarrier& b) {
    asm volatile("s_waitcnt vmcnt(0)" ::: "memory");
    __syncthreads();
    if (threadIdx.x == 0) {
        unsigned* bar = b.bar;
        __builtin_amdgcn_s_waitcnt(0);
        unsigned nloc = b.st[0], nx = b.st[1];
        if (nloc == 0u) { xcd_barrier_complete(bar, b.x, nloc, nx); b.st[0] = nloc; b.st[1] = nx; }
        const unsigned old = xb_add(&bar[XB_XSUB(b.x)], 1u);
        const unsigned gen = old / nloc;
        if (old + 1u == (gen + 1u) * nloc) {
            __builtin_amdgcn_fence(__ATOMIC_RELEASE, "agent");
            asm volatile("s_waitcnt vmcnt(0)" ::: "memory");
            const unsigned og = xb_add(&bar[XB_TOP], 1u);
            const unsigned tg = og / nx;
            if (og + 1u == (tg + 1u) * nx) xb_add(&bar[XB_TOPGEN], 1u);
            else XB_SPIN(xb_ld(&bar[XB_TOPGEN]) == tg, bar);
            __builtin_amdgcn_fence(__ATOMIC_ACQUIRE, "agent");
            xb_add(&bar[XB_XGEN(b.x)], 1u);
            asm volatile("s_waitcnt vmcnt(0)" ::: "memory");
        } else {
            XB_SPIN(xb_ld(&bar[XB_XGEN(b.x)]) == gen, bar);
            __builtin_amdgcn_fence(__ATOMIC_ACQUIRE, "agent");
            asm volatile("s_waitcnt vmcnt(0)" ::: "memory");
        }
    }
    __syncthreads();
}


__device__ __forceinline__ float qk_bound(const float* q_g, const float* k_g, int lane) {
    float gq = fabsf(q_g[lane]), gk = fabsf(k_g[lane]);
#pragma unroll
    for (int o = 1; o < 64; o <<= 1) { gq = fmaxf(gq, __shfl_xor(gq, o)); gk = fmaxf(gk, __shfl_xor(gk, o)); }
    return attn_body::C2 * 64.0f * 1.02f * gq * gk;
}
#ifndef GEMM1_WGM
#define GEMM1_WGM 16
#endif
constexpr float GAP_EXTRA = 38.0f;
struct Args { const float* in[13]; float* out; unsigned char* ws; };
struct ConvItems {
    LAS unsigned char* L;
    __device__ __forceinline__ void operator()(int item) const {
        const __attribute__((address_space(4))) Args* ap_ = (const __attribute__((address_space(4))) Args*)__builtin_amdgcn_kernarg_segment_ptr(); asm volatile("" : "+s"(ap_));
        unsigned char* ws = ap_->ws; const float* conv_w = ap_->in[9]; const float* w_a = ap_->in[10]; const float* w_b = ap_->in[11]; const float* w_o = ap_->in[12];
        const bf16* CUB = (const bf16*)(ws + WS_CU); const bf16* GZB = (const bf16*)(ws + WS_GZ); bf16* OAB = (bf16*)(ws + WS_OAB); bf16* WABT = (bf16*)(ws + WS_WAB); bf16* WOT = (bf16*)(ws + WS_WO);
        const int lane = threadIdx.x & 63, wave = __builtin_amdgcn_readfirstlane((int)threadIdx.x >> 6);
        if (item >= M / 128) {
            LAS float* scr = (LAS float*)(L + wave * 8704); int r = (item - M / 128) * 8 + wave;
            constexpr int I_A = (D / 32) * (AW / 64), I_B = (D / 32) * (CW / 64);
            if (r < I_A) p0_transpose_item<false>(w_a, D, D, WABT, scr, r, AW / 64, lane);
            else if (r < I_A + I_B) p0_transpose_item<false>(w_b, D, D, WABT + 512, scr, r - I_A, CW / 64, lane);
            else p0_transpose_item<false>(w_o, D, D, WOT, scr, r - I_A - I_B, D / 64, lane);
            return; }
        const int m0 = item * 128 + wave * 16; const int ch = 8 * lane;
        float w0[8], w1[8], w2[8];
#pragma unroll
        for (int e = 0; e < 8; ++e) { w0[e] = conv_w[ch + e]; w1[e] = conv_w[CW + ch + e]; w2[e] = conv_w[2 * CW + ch + e]; }
        float p1[8], p2[8];
        const bool first = (m0 % T) == 0;
        { v4u a = {0u, 0u, 0u, 0u}, bq = {0u, 0u, 0u, 0u};
          if (!first) { a = *(const v4u*)(CUB + (size_t)(m0 - 2) * CW + ch); bq = *(const v4u*)(CUB + (size_t)(m0 - 1) * CW + ch); }
#pragma unroll
          for (int e = 0; e < 4; ++e) { p2[2 * e] = pg8::bflo(a[e]); p2[2 * e + 1] = pg8::bfhi(a[e]); p1[2 * e] = pg8::bflo(bq[e]); p1[2 * e + 1] = pg8::bfhi(bq[e]); } }
#pragma unroll 4
        for (int r = 0; r < 16; ++r) { const int m = m0 + r;
            const v4u cv = *(const v4u*)(CUB + (size_t)m * CW + ch), gv = *(const v4u*)(GZB + (size_t)m * CW + ch);
            float cur[8], o[8];
#pragma unroll
            for (int e = 0; e < 4; ++e) { cur[2 * e] = pg8::bflo(cv[e]); cur[2 * e + 1] = pg8::bfhi(cv[e]); }
#pragma unroll
            for (int e = 0; e < 4; ++e) { o[2 * e] = pg8::bflo(gv[e]) * (w0[2 * e] * p2[2 * e] + w1[2 * e] * p1[2 * e] + w2[2 * e] * cur[2 * e]);
                o[2 * e + 1] = pg8::bfhi(gv[e]) * (w0[2 * e + 1] * p2[2 * e + 1] + w1[2 * e + 1] * p1[2 * e + 1] + w2[2 * e + 1] * cur[2 * e + 1]); }
            v4u ov; ov.x = pk2(o[0], o[1]); ov.y = pk2(o[2], o[3]); ov.z = pk2(o[4], o[5]); ov.w = pk2(o[6], o[7]);
            *(v4u*)(OAB + (size_t)m * 1024 + 512 + ch) = ov;
#pragma unroll
            for (int e = 0; e < 8; ++e) { p2[e] = p1[e]; p1[e] = cur[e]; }
        }
    }
};
constexpr int N_CONV_ITEMS = M / 128 + ((D / 32) * (AW / 64) + (D / 32) * (CW / 64) + (D / 32) * (D / 64)) / 8;

template <int LO, int HI> __global__ void __launch_bounds__(NWAVES * 64, 2) fox_fwd(Args args) {
    extern __shared__ __attribute__((aligned(16))) unsigned char lds[];
    LAS unsigned char* L = (LAS unsigned char*)lds;
    if (threadIdx.x < 2) ((volatile LAS unsigned*)(L + MISC_OFF))[threadIdx.x] = 0u;
    if (HI - LO > 1 && threadIdx.x == 0) (void)xb_add(&((unsigned*)(args.ws + WS_CTL))[XB_XCNT(xb_xcc_id())], 1u);
    __syncthreads();
#define PHASE_IDS() int tid = threadIdx.x; asm volatile("" : "+v"(tid)); int bx = blockIdx.x; asm volatile("" : "+s"(bx)); int G = gridDim.x; asm volatile("" : "+s"(G)); \
    const int lane = tid & 63, wave = __builtin_amdgcn_readfirstlane(tid >> 6); const int vcu = (G % 8 == 0) ? (bx % 8) * (G / 8) + bx / 8 : bx; const int gw = vcu * NWAVES + wave, NGW = G * NWAVES; (void)lane; (void)gw; (void)NGW
#define PHASE_PTRS() const __attribute__((address_space(4))) Args* ap_ = (const __attribute__((address_space(4))) Args*)__builtin_amdgcn_kernarg_segment_ptr(); asm volatile("" : "+s"(ap_)); unsigned char* ws = ap_->ws; const float* x = ap_->in[0]; const float* c = ap_->in[1]; const float* w_ada = ap_->in[2]; const float* b_ada = ap_->in[3]; const float* norm_g = ap_->in[4]; const float* w_in = ap_->in[5]; const float* b_f = ap_->in[6]; const float* q_g = ap_->in[7]; const float* k_g = ap_->in[8]; const float* conv_w = ap_->in[9]; const float* w_a = ap_->in[10]; const float* w_b = ap_->in[11]; const float* w_o = ap_->in[12]; float* ADA = (float*)(ws + WS_ADA); float* WF = (float*)(ws + WS_WF); float* LF = (float*)(ws + WS_LF); bf16* W1T = (bf16*)(ws + WS_W1); bf16* WABT = (bf16*)(ws + WS_WAB); bf16* WOT = (bf16*)(ws + WS_WO); bf16* HB = (bf16*)(ws + WS_HB); bf16* OAB = (bf16*)(ws + WS_OAB); bf16* QB = (bf16*)(ws + WS_Q); bf16* KB = (bf16*)(ws + WS_K); bf16* VB = (bf16*)(ws + WS_V); bf16* MG = (bf16*)(ws + WS_MG); bf16* SZA = (bf16*)(ws + WS_SZA); bf16* CUB = (bf16*)(ws + WS_CU); bf16* GZB = (bf16*)(ws + WS_GZ); bf16* RB = (bf16*)(ws + WS_R); bf16* SGB = (bf16*)(ws + WS_SGB);
#ifndef REPEAT_PHASE
#define REPEAT_PHASE -1
#endif
#define REPS(k) (REPEAT_PHASE == (k) ? 2 : 1)
#ifndef PHMASK
#define PHMASK 63
#endif
#define IN(k) ((((PHMASK) >> (k)) & 1) && LO <= (k) && (k) < HI)
#define BOTH(k) (IN(k) && IN((k) + 1))
#ifndef BAR_REPS
#define BAR_REPS 1
#endif
#define XBAR() for (int br_ = 0; br_ < BAR_REPS; ++br_) do { const __attribute__((address_space(4))) Args* bp_ = (const __attribute__((address_space(4))) Args*)__builtin_amdgcn_kernarg_segment_ptr(); asm volatile("" : "+s"(bp_)); XcdBarrier b_; b_.bar = (unsigned*)(bp_->ws + WS_CTL); b_.x = xb_xcc_id(); b_.st = (volatile LAS unsigned*)(L + MISC_OFF); xcd_barrier(b_); } while (0)

    for (int rep_ = 0; rep_ < REPS(0); ++rep_) if (IN(0)) {
        PHASE_PTRS(); PHASE_IDS();
        if (bx < 192) {
            LAS float* ct = (LAS float*)L;
            LAS float* red = (LAS float*)(L + 32768);
            for (int i = tid; i < 8192; i += NWAVES * 64) { const int b = i >> 10, k = i & 1023; ct[k * 8 + b] = c[i]; }
            __syncthreads();
            const int col = bx * 16 + (lane & 15), kpar = lane >> 4;
            float acc[8];
#pragma unroll
            for (int b = 0; b < 8; ++b) acc[b] = 0.f;
#pragma unroll 8
            for (int kk = 0; kk < 32; ++kk) { const int k = wave * 128 + 4 * kk + kpar; const float wv = w_ada[(size_t)k * 3072 + col];
                const f32x4 c0 = *(const LAS f32x4*)(ct + k * 8), c1 = *(const LAS f32x4*)(ct + k * 8 + 4);
                acc[0] += c0[0] * wv; acc[1] += c0[1] * wv; acc[2] += c0[2] * wv; acc[3] += c0[3] * wv; acc[4] += c1[0] * wv; acc[5] += c1[1] * wv; acc[6] += c1[2] * wv; acc[7] += c1[3] * wv; }
#pragma unroll
            for (int b = 0; b < 8; ++b) { acc[b] += __shfl_xor(acc[b], 16); acc[b] += __shfl_xor(acc[b], 32); if (lane < 16) red[(wave * 8 + b) * 16 + lane] = acc[b]; }
            __syncthreads();
            if (tid < 128) { const int b = tid >> 4, cl = tid & 15; float s = b_ada[bx * 16 + cl];
#pragma unroll
                for (int w = 0; w < 8; ++w) s += red[(w * 8 + b) * 16 + cl];
                ADA[b * 3072 + bx * 16 + cl] = s; }
            __syncthreads();
        }
        {
            const int i = bx * NWAVES * 64 + tid; if (i < 8192) { const int j = i >> 10, k = i & 1023; WF[i] = w_in[(size_t)k * INW + SRC_F + j]; }
        }
        if (bx >= 192) {
            LAS float* scr = (LAS float*)(L + wave * 8704); const int w2 = (bx - 192) * NWAVES + wave;
            p0_transpose_item<true>(w_in, D, INW, W1T, scr, 2048 + w2, D / 64, lane);
            p0_transpose_item<true>(w_in, D, INW, W1T, scr, 2048 + 512 + w2, D / 64, lane);
        }
        if (BOTH(0)) XBAR();
    }

    for (int rep_ = 0; rep_ < REPS(1); ++rep_) if (IN(1)) {
        PHASE_PTRS(); PHASE_IDS();
#define P1COL(j) (8 * lane + 512 * ((j) >> 1) + 4 * ((j) & 1))
        LAS float* wf = (LAS float*)L;
        for (int i = tid; i < 2048; i += NWAVES * 64) ((LAS f32x4*)wf)[i] = ((const f32x4*)WF)[i];
        __syncthreads();
        const int m0 = gw * 16, b = m0 / T;
        f32x4 gm[4], sh[4];
#pragma unroll
        for (int j = 0; j < 4; ++j) { const int col = P1COL(j); const f32x4 g = *(const f32x4*)(norm_g + col), scl = *(const f32x4*)(ADA + b * 3072 + 1024 + col);
            gm[j] = g * (scl + 1.0f); sh[j] = *(const f32x4*)(ADA + b * 3072 + col); }
        for (int r = 0; r < 16; ++r) { const int m = m0 + r; if (m >= M) break;
            const GAS float* xr = (const GAS float*)(x + (size_t)m * D);
            f32x4 v[4]; float s2 = 0.f;
#pragma unroll
            for (int j = 0; j < 4; ++j) { v[j] = *(const GAS f32x4*)(xr + P1COL(j)); s2 += (v[j][0] * v[j][0] + v[j][1] * v[j][1]) + (v[j][2] * v[j][2] + v[j][3] * v[j][3]); }
            const float rstd = 1.0f / sqrtf(wave_sum(s2) * (1.0f / D) + EPS);
#pragma unroll
            for (int j = 0; j < 4; ++j) v[j] = v[j] * rstd * gm[j] + sh[j];
#pragma unroll
            for (int j = 0; j < 2; ++j) { v4u o; o.x = pk2(v[2 * j][0], v[2 * j][1]); o.y = pk2(v[2 * j][2], v[2 * j][3]); o.z = pk2(v[2 * j + 1][0], v[2 * j + 1][1]); o.w = pk2(v[2 * j + 1][2], v[2 * j + 1][3]);
                *(GAS v4u*)(HB + (size_t)m * D + 8 * lane + 512 * j) = o; }
            float fl[8];
#pragma unroll
            for (int q = 0; q < 8; ++q) { float a = 0.f;
#pragma unroll
                for (int j = 0; j < 4; ++j) { const f32x4 w = *(const LAS f32x4*)(wf + q * 1024 + P1COL(j)); a += (v[j][0] * w[0] + v[j][1] * w[1]) + (v[j][2] * w[2] + v[j][3] * w[3]); }
                fl[q] = wave_sum(a); }
            float mine = fl[0];
#pragma unroll
            for (int q = 1; q < 8; ++q) mine = (lane == q) ? fl[q] : mine;
            if (lane < 8) { const float z = mine + b_f[lane]; const float ls = fminf(z, 0.f) - log1pf(__expf(-fabsf(z)));
                LF[(size_t)(b * 8 + lane) * T + (m - b * T)] = ls; }
        }
        {
            LAS float* scr = (LAS float*)(L + 32768 + wave * 8704);
            constexpr int I_1 = (NPROJ / 32) * (D / 64), I_A = (D / 32) * (AW / 64), I_B = (D / 32) * (CW / 64), I_O = (D / 32) * (D / 64);
            (void)I_A; (void)I_B; (void)I_O;
            static_assert(I_1 == 3072, "P0 converts items [2048, 3072) on its 64 GEMV-free workgroups");
            for (int it = gw; it < 2048; it += NGW) p0_transpose_item<true>(w_in, D, INW, W1T, scr, it, D / 64, lane);
        }
        __syncthreads();
        if (BOTH(1)) XBAR();
    }

    for (int rep_ = 0; rep_ < REPS(2); ++rep_) if (IN(2)) {
        PHASE_PTRS(); PHASE_IDS();
        if (bx < BATCH * H) {
            attn_body::bias_scan((char*)lds, LF + (size_t)bx * T, (float*)(ws + WS_BIAS) + (size_t)bx * T);
            attn_body::j0_table((const char*)lds, 2.0f * qk_bound(q_g, k_g, lane) + GAP_EXTRA, (int*)(ws + WS_J0) + bx * 16, wave, lane);
            __syncthreads(); }
        pg8::Gemm g{HB, W1T, M, NPROJ, D}; pg8::StaticOrder S; S.init(M, NPROJ, G, bx, GEMM1_WGM);
        pg8::EpiProj E{ws, q_g, k_g, attn_body::C2, EPS};
        pg8::gemm_phase<pg8::EpiProj, pg8::StaticOrder, PG8_ALIGN, PG8_SP2>(L + RING_OFF, g, S, E);
        if (BOTH(2)) XBAR();
    }

    for (int rep_ = 0; rep_ < REPS(3); ++rep_) if (IN(3)) {
        PHASE_PTRS(); PHASE_IDS();
        const float qkb = qk_bound(q_g, k_g, lane);
        const attn_body::AttnTensors AT{ws, WS_Q, WS_K, WS_V, WS_SZA, WS_LF, WS_OAB, WS_BIAS, WS_J0, 2.0f * qkb + GAP_EXTRA, qkb};
        const ConvItems CI{L};
        attn_body::attn_phase_dyn<-1, ConvItems>((char*)lds + RING_OFF, AT, (unsigned*)(ws + WS_CTL) + CW_ATTNQ, CI, N_CONV_ITEMS);
        if (BOTH(3)) XBAR();
    }

    for (int rep_ = 0; rep_ < REPS(4); ++rep_) if (IN(4)) {
        PHASE_PTRS(); PHASE_IDS();
        pg8::Gemm g{OAB, WABT, M, D, D}; pg8::StaticOrder S; S.init(M, D, G, bx);
        pg8::EpiMerge E{(const unsigned short*)RB, MG};
        pg8::gemm_phase<pg8::EpiMerge, pg8::StaticOrder, PG8_ALIGN, PG8_SP2>(L + RING_OFF, g, S, E);
        if (BOTH(4)) XBAR();
    }

    for (int rep_ = 0; rep_ < REPS(5); ++rep_) if (IN(5)) {
        PHASE_PTRS(); PHASE_IDS();
        pg8::Gemm g{MG, WOT, M, D, D}; pg8::StaticOrder S; S.init(M, D, G, bx);
        pg8::EpiOut E{x, ADA + 2048, ap_->out};
        pg8::gemm_phase<pg8::EpiOut, pg8::StaticOrder, PG8_ALIGN, PG8_SP2>(L + RING_OFF, g, S, E);
    }
#undef IN
#undef BOTH
}

extern "C" void kernel_launch(void* const* d_in, const int* in_sizes, int n_in, void* d_out, int out_size, void* d_ws, size_t ws_size, hipStream_t stream) {
    static int grid = 0;
    if (grid == 0) {
        if (n_in != 13 || in_sizes[0] != M * D || out_size != M * D || ws_size < WS_END) { fprintf(stderr, "kernel_launch: shape/workspace mismatch (n_in %d, in0 %d, out %d, ws %zu); nothing launched\n", n_in, n_in > 0 ? in_sizes[0] : -1, out_size, ws_size); grid = -1; return; }
        int dev = 0, cus = 0, per_cu = 0;
        if (hipGetDevice(&dev) != hipSuccess || hipDeviceGetAttribute(&cus, hipDeviceAttributeMultiprocessorCount, dev) != hipSuccess) { fprintf(stderr, "kernel_launch: device query failed\n"); grid = -1; return; }
        bool ok = true;
#if MK_N_LAUNCHES == 1
        const void* kfull = (const void*)fox_fwd<0, PER_PHASE>;
        ok = hipFuncSetAttribute(kfull, hipFuncAttributeMaxDynamicSharedMemorySize, LDS_BYTES) == hipSuccess;
#else
        const void* kph[PER_PHASE] = {(const void*)fox_fwd<0, 1>, (const void*)fox_fwd<1, 2>, (const void*)fox_fwd<2, 3>, (const void*)fox_fwd<3, 4>, (const void*)fox_fwd<4, 5>, (const void*)fox_fwd<5, 6>};
        const void* kfull = kph[3];
        for (int i = 0; i < PER_PHASE; ++i) ok = ok && hipFuncSetAttribute(kph[i], hipFuncAttributeMaxDynamicSharedMemorySize, LDS_BYTES) == hipSuccess;
#endif
        if (!ok) { fprintf(stderr, "kernel_launch: hipFuncSetAttribute failed\n"); grid = -1; return; }
        if (hipOccupancyMaxActiveBlocksPerMultiprocessor(&per_cu, kfull, NWAVES * 64, LDS_BYTES) != hipSuccess || per_cu < 1) { fprintf(stderr, "kernel_launch: occupancy query reports %d workgroups per CU\n", per_cu); (void)hipGetLastError(); grid = -1; return; }
        grid = cus;
        if (grid != 256) { fprintf(stderr, "kernel_launch: built for a 256-CU device (got %d CUs); nothing launched\n", cus); grid = -1; return; }
    }
    if (grid < 0) return;
    if (hipMemsetAsync((char*)d_ws + WS_CTL, 0, (XCD_BAR_WORDS + 256) * 4, stream) != hipSuccess) { fprintf(stderr, "kernel_launch: hipMemsetAsync failed\n"); return; }
    Args a{};
    for (int i = 0; i < 13; ++i) a.in[i] = (const float*)d_in[i];
    a.out = (float*)d_out; a.ws = (unsigned char*)d_ws;
#if MK_N_LAUNCHES == 1
    {
        void* kargs[] = {&a};
        const hipError_t e = hipLaunchCooperativeKernel((const void*)fox_fwd<0, PER_PHASE>, dim3(grid), dim3(NWAVES * 64), kargs, LDS_BYTES, stream);
        if (e != hipSuccess) fprintf(stderr, "kernel_launch: cooperative launch failed: %s (grid %d)\n", hipGetErrorString(e), grid);
    }
#else
    {
        hipLaunchKernelGGL((fox_fwd<0, 1>), dim3(grid), dim3(NWAVES * 64), LDS_BYTES, stream, a);
        hipLaunchKernelGGL((fox_fwd<1, 2>), dim3(grid), dim3(NWAVES * 64), LDS_BYTES, stream, a);
        hipLaunchKernelGGL((fox_fwd<2, 3>), dim3(grid), dim3(NWAVES * 64), LDS_BYTES, stream, a);
        hipLaunchKernelGGL((fox_fwd<3, 4>), dim3(grid), dim3(NWAVES * 64), LDS_BYTES, stream, a);
        hipLaunchKernelGGL((fox_fwd<4, 5>), dim3(grid), dim3(NWAVES * 64), LDS_BYTES, stream, a);
        hipLaunchKernelGGL((fox_fwd<5, 6>), dim3(grid), dim3(NWAVES * 64), LDS_BYTES, stream, a);
        const hipError_t le = hipPeekAtLastError();
        if (le != hipSuccess) fprintf(stderr, "kernel_launch: a phase launch failed: %s\n", hipGetErrorName(le));
    }
#endif
}
```

```cpp
#include <hip/hip_runtime.h>
#include <cstdio>
#include <cstdint>
namespace pg8 {
#define PG8_LAS __attribute__((address_space(3)))
typedef unsigned short bf16_t;
typedef short bf16x8 __attribute__((ext_vector_type(8)));
typedef float f32x4 __attribute__((ext_vector_type(4)));
typedef unsigned u32x4 __attribute__((ext_vector_type(4)));
constexpr int BM = 256, BK = 64, HALF = 128, HTB = HALF * BK * 2  , STAGE_BYTES = 8 * HTB, NXCD = 8, WGM = 8;

__host__ __device__ __forceinline__ int lds_byte(int r, int c) { const int st = (r >> 4) * 2 + (c >> 5), rr = r & 15, cc = c & 31, ob = rr * 64 + cc * 2; return st * 1024 + (ob ^ (((ob >> 9) & 1) << 5)); }
__host__ __device__ __forceinline__ void stage_rc(int b, int& R, int& C) { const int st = b / 1024, sb = b % 1024, swz = sb ^ (((sb >> 9) & 1) << 5); R = (st >> 1) * 16 + swz / 64; C = (st & 1) * 32 + (swz % 64) / 2; }
__host__ __device__ __forceinline__ int perm32(int rho) { const int n = rho >> 4, i = rho & 15; return 8 * (i >> 2) + 4 * n + (i & 3); }

struct Unit { int pm, pn; };
struct Gemm { const bf16_t* A; const bf16_t* Bt; int M, N, K; };

struct StaticOrder {
    int nM, nN, nwg, G, c, wgm;
    __host__ __device__ void init(int M, int N, int G_, int c_, int wgm_ = WGM) { nM = M / BM; nN = N / BM; nwg = nM * nN; G = G_; c = c_; wgm = wgm_; }
    __host__ __device__ bool next(int i, Unit& u) const {
        const long L = (long)i * G + c; if (L >= nwg) return false;
        int wgid = (int)L; { const int q = nwg / NXCD, r = nwg % NXCD, xcd = wgid % NXCD, off = wgid / NXCD; wgid = (xcd < r ? xcd * (q + 1) : r * (q + 1) + (xcd - r) * q) + off; }
        const int nig = wgm * nN, gid = wgid / nig, fm = gid * wgm, gsz = (nM - fm) < wgm ? (nM - fm) : wgm;
        u.pm = fm + ((wgid % nig) % gsz); u.pn = (wgid % nig) / gsz; return true;
    }
    __device__ __forceinline__ void a_ready(const Unit&) const {}
    __device__ __forceinline__ void done(const Unit&) const {}
};

__device__ __forceinline__ unsigned cvt_pk_bf16(float lo, float hi) { unsigned r; asm volatile("v_cvt_pk_bf16_f32 %0, %1, %2" : "=v"(r) : "v"(lo), "v"(hi)); return r; }
typedef float f32x2 __attribute__((ext_vector_type(2)));
__device__ __forceinline__ float sigm(float x) { return __builtin_amdgcn_rcpf(1.0f + __builtin_amdgcn_exp2f(x * -1.4426950408889634f)); }
__device__ __forceinline__ float silu(float x) { return x * sigm(x); }
__device__ __forceinline__ float bflo(unsigned w) { return __builtin_bit_cast(float, w << 16); }
__device__ __forceinline__ float bfhi(unsigned w) { return __builtin_bit_cast(float, w & 0xffff0000u); }
typedef unsigned u32x2 __attribute__((ext_vector_type(2)));

constexpr size_t OFF_Q = 96u << 20, OFF_K = 128u << 20, OFF_V = 160u << 20, OFF_SZA = 192u << 20, OFF_CU = 224u << 20, OFF_GZ = 256u << 20, OFF_SGA = 320u << 20, OFF_SGB = 384u << 20;
struct EpiProj {
    static constexpr bool PERM = true, AFTER_DRAIN = false, MID = false;
    unsigned char* ws; const float *qg, *kg; float qscale, eps;
    __device__ __forceinline__ void operator()(const f32x4 (&acc)[2][2][4][2], const Unit& u, int wr, int wc, int fr, int fq) const {
        const int pn = u.pn; const size_t row0 = (size_t)u.pm * BM + wr * 64 + fr;
        if (pn < 4) {
            const bool isq = pn < 2; const float* g = isq ? qg : kg; bf16_t* dst = (bf16_t*)(ws + (isq ? OFF_Q : OFF_K)); const float sc = isq ? qscale : 1.0f;
            const int colb = (pn & 1) * 256 + 64 * wc + 8 * fq;
            f32x4 gv[2][2];
#pragma unroll
            for (int bj = 0; bj < 2; ++bj)
#pragma unroll
                for (int n = 0; n < 2; ++n) gv[bj][n] = *(const f32x4*)(g + 32 * bj + 8 * fq + 4 * n) * sc;
#pragma unroll
            for (int ai = 0; ai < 2; ++ai)
#pragma unroll
                for (int m = 0; m < 4; ++m) {
                    float ss = 0.f;
#pragma unroll
                    for (int bj = 0; bj < 2; ++bj)
#pragma unroll
                        for (int n = 0; n < 2; ++n) { const f32x4 x = acc[ai][bj][m][n]; ss += (x[0] * x[0] + x[1] * x[1]) + (x[2] * x[2] + x[3] * x[3]); }
                    ss += __shfl_xor(ss, 16); ss += __shfl_xor(ss, 32);
                    const float rstd = __builtin_amdgcn_rsqf(ss * (1.0f / 64.0f) + eps);
                    bf16_t* rowp = dst + (row0 + ai * HALF + m * 16) * 512 + colb;
#pragma unroll
                    for (int bj = 0; bj < 2; ++bj) { const f32x4 v0 = acc[ai][bj][m][0] * rstd * gv[bj][0], v1 = acc[ai][bj][m][1] * rstd * gv[bj][1];
                        u32x4 w; w.x = cvt_pk_bf16(v0[0], v0[1]); w.y = cvt_pk_bf16(v0[2], v0[3]); w.z = cvt_pk_bf16(v1[0], v1[1]); w.w = cvt_pk_bf16(v1[2], v1[3]);
                        *(u32x4*)(rowp + 32 * bj) = w; }
                }
        } else if (pn >= 8 && pn < 16) {
            const int col = 64 * (pn - 8) + 16 * wc + 8 * (fq >> 1); bf16_t* dstb = (bf16_t*)(ws + ((fq & 1) ? OFF_GZ : OFF_CU));
#pragma unroll
            for (int ai = 0; ai < 2; ++ai)
#pragma unroll
                for (int m = 0; m < 4; ++m) { const size_t off = (row0 + ai * HALF + m * 16) * 512 + col;
                    const f32x4 gb = acc[ai][0][m][0], gc = acc[ai][0][m][1], uu = acc[ai][1][m][0], zb = acc[ai][1][m][1];
                    const f32x4 cu = gc * uu; f32x4 gz; gz[0] = gb[0] * silu(zb[0]); gz[1] = gb[1] * silu(zb[1]); gz[2] = gb[2] * silu(zb[2]); gz[3] = gb[3] * silu(zb[3]);
                    u32x2 a, b; a.x = cvt_pk_bf16(cu[0], cu[1]); a.y = cvt_pk_bf16(cu[2], cu[3]); b.x = cvt_pk_bf16(gz[0], gz[1]); b.y = cvt_pk_bf16(gz[2], gz[3]);
                    const auto rx = __builtin_amdgcn_permlane16_swap(a.x, b.x, false, false), ry = __builtin_amdgcn_permlane16_swap(a.y, b.y, false, false);
                    u32x4 w; w.x = rx[0]; w.y = ry[0]; w.z = rx[1]; w.w = ry[1];
                    *(u32x4*)(dstb + off) = w; }
        } else if (pn >= 16) {
            const int col = 128 * (pn - 16) + 32 * wc + 8 * fq; unsigned short* AB = (unsigned short*)(ws + OFF_SGA);
#pragma unroll
            for (int ai = 0; ai < 2; ++ai)
#pragma unroll
                for (int m = 0; m < 4; ++m) { const size_t off = (row0 + ai * HALF + m * 16) * 1024 + col;
                    unsigned wd[4];
#pragma unroll
                    for (int n = 0; n < 2; ++n)
#pragma unroll
                        for (int h = 0; h < 2; ++h) { unsigned d = 0u;
#pragma unroll
                            for (int e = 0; e < 2; ++e) { const int i = 2 * h + e; const unsigned ta = (unsigned)(sigm(acc[ai][0][m][n][i]) * 255.0f + 0.5f); unsigned tb = (unsigned)(sigm(acc[ai][1][m][n][i]) * 255.0f + 0.5f); tb = tb < 1u ? 1u : tb;
                                d |= (ta | (tb << 8)) << (16 * e); }
                            wd[2 * n + h] = d; }
                    *(u32x4*)(AB + off) = (u32x4){wd[0], wd[1], wd[2], wd[3]};
                    asm volatile("" ::: "memory"); }
        } else {
            size_t doff; int ld, tcol, act;
            if (pn < 6) { doff = OFF_V; ld = 512; tcol = (pn - 4) * 256; act = 0; }
            else { doff = OFF_SZA; ld = 512; tcol = (pn - 6) * 256; act = 1; }
            bf16_t* dst = (bf16_t*)(ws + doff);
            const int colb = tcol + 64 * wc + 8 * fq;
#pragma unroll
            for (int ai = 0; ai < 2; ++ai)
#pragma unroll
                for (int m = 0; m < 4; ++m) { bf16_t* rowp = dst + (row0 + ai * HALF + m * 16) * ld + colb;
#pragma unroll
                    for (int bj = 0; bj < 2; ++bj) { f32x4 v0 = acc[ai][bj][m][0], v1 = acc[ai][bj][m][1];
                        if (act == 1) { v0[0] = silu(v0[0]); v0[1] = silu(v0[1]); v0[2] = silu(v0[2]); v0[3] = silu(v0[3]); v1[0] = silu(v1[0]); v1[1] = silu(v1[1]); v1[2] = silu(v1[2]); v1[3] = silu(v1[3]); }
                        u32x4 w; w.x = cvt_pk_bf16(v0[0], v0[1]); w.y = cvt_pk_bf16(v0[2], v0[3]); w.z = cvt_pk_bf16(v1[0], v1[1]); w.w = cvt_pk_bf16(v1[2], v1[3]);
                        *(u32x4*)(rowp + 32 * bj) = w; } }
        }
    }
};
__host__ __device__ __forceinline__ int proj_src_col(int p) {
    const int pn = p >> 8, r = p & 255, bj = r >> 7, wc = (r >> 5) & 3, jj = r & 31;
    if (pn >= 8 && pn < 16) { const int fq = jj >> 3, n = (jj >> 2) & 1, i = jj & 3; const int sect = bj == 0 ? (n == 0 ? 2056 : 2568) : (n == 0 ? 3080 : 3592); return sect + 64 * (pn - 8) + 16 * wc + 4 * fq + i; }
    if (pn >= 16) return (bj == 0 ? 4104 : 5128) + 128 * (pn - 16) + 32 * wc + jj;
    const int nat = 64 * wc + 32 * bj + jj;
    if (pn < 6) return 256 * pn + nat;
    return 1544 + 256 * (pn - 6) + nat;
}

struct EpiMerge {
    static constexpr bool PERM = true, AFTER_DRAIN = false, MID = true;
    const unsigned short* AB; bf16_t* MG;
    static __device__ __forceinline__ float ub(unsigned w, int k) { return (float)((w >> (8 * k)) & 0xffu); }
    __device__ __forceinline__ void mid(f32x4 (&acc)[2][2][4][2], const Unit& u, int wr, int wc, int fr, int fq) const {
        unsigned off0 = (unsigned)((u.pm * BM + wr * 64 + fr) * 1024 + u.pn * BM + wc * 32 + 8 * fq);
        asm volatile("" : "+v"(off0));
#pragma unroll
        for (int ai = 0; ai < 2; ++ai)
#pragma unroll
            for (int m = 0; m < 4; ++m) { const unsigned off = off0 + (unsigned)((ai * HALF + m * 16) * 1024);
#pragma unroll
                for (int bj = 0; bj < 2; ++bj) { const u32x4 g = *(const u32x4*)(AB + (off + bj * HALF));
                    acc[ai][bj][m][0] *= (f32x4){ub(g.x, 0) * __builtin_amdgcn_rcpf(ub(g.x, 1)), ub(g.x, 2) * __builtin_amdgcn_rcpf(ub(g.x, 3)), ub(g.y, 0) * __builtin_amdgcn_rcpf(ub(g.y, 1)), ub(g.y, 2) * __builtin_amdgcn_rcpf(ub(g.y, 3))};
                    acc[ai][bj][m][1] *= (f32x4){ub(g.z, 0) * __builtin_amdgcn_rcpf(ub(g.z, 1)), ub(g.z, 2) * __builtin_amdgcn_rcpf(ub(g.z, 3)), ub(g.w, 0) * __builtin_amdgcn_rcpf(ub(g.w, 1)), ub(g.w, 2) * __builtin_amdgcn_rcpf(ub(g.w, 3))}; } }
    }
    __device__ __forceinline__ void operator()(const f32x4 (&acc)[2][2][4][2], const Unit& u, int wr, int wc, int fr, int fq) const {
        unsigned off0 = (unsigned)((u.pm * BM + wr * 64 + fr) * 1024 + u.pn * BM + wc * 32 + 8 * fq); const float s = 1.0f / 255.0f;
        asm volatile("" : "+v"(off0));
#pragma unroll
        for (int ai = 0; ai < 2; ++ai)
#pragma unroll
            for (int m = 0; m < 4; ++m) { const unsigned off = off0 + (unsigned)((ai * HALF + m * 16) * 1024);
#pragma unroll
                for (int bj = 0; bj < 2; ++bj) { const u32x4 g = *(const u32x4*)(AB + (off + bj * HALF)); const f32x4 v0 = acc[ai][bj][m][0] * s, v1 = acc[ai][bj][m][1] * s;
                    u32x4 w; w.x = cvt_pk_bf16(v0[0] * ub(g.x, 1), v0[1] * ub(g.x, 3)); w.y = cvt_pk_bf16(v0[2] * ub(g.y, 1), v0[3] * ub(g.y, 3));
                    w.z = cvt_pk_bf16(v1[0] * ub(g.z, 1), v1[1] * ub(g.z, 3)); w.w = cvt_pk_bf16(v1[2] * ub(g.w, 1), v1[3] * ub(g.w, 3));
                    *(u32x4*)((unsigned char*)MG + 2u * (off + bj * HALF)) = w; } }
    }
};
struct EpiOut {
    static constexpr bool PERM = false, AFTER_DRAIN = false, MID = false;
    const float* x; const float* gate; float* out;
    __device__ __forceinline__ void operator()(const f32x4 (&acc)[2][2][4][2], const Unit& u, int wr, int wc, int fr, int fq) const {
        const size_t row0 = (size_t)u.pm * BM + wr * 64 + fr; const int col0 = u.pn * BM + wc * 32 + 4 * fq; const float* gp = gate + (size_t)(u.pm >> 4) * 3072 + col0;
        f32x4 gv[2][2];
#pragma unroll
        for (int bj = 0; bj < 2; ++bj)
#pragma unroll
            for (int n = 0; n < 2; ++n) gv[bj][n] = *(const f32x4*)(gp + bj * HALF + n * 16);
#pragma unroll
        for (int ai = 0; ai < 2; ++ai) {
            f32x4 xv[4][2][2];
#pragma unroll
            for (int m = 0; m < 4; ++m) { const size_t off = (row0 + ai * HALF + m * 16) * 1024 + col0;
#pragma unroll
                for (int bj = 0; bj < 2; ++bj)
#pragma unroll
                    for (int n = 0; n < 2; ++n) xv[m][bj][n] = *(const f32x4*)(x + off + bj * HALF + n * 16); }
            asm volatile("" ::: "memory");
#pragma unroll
            for (int m = 0; m < 4; ++m) { const size_t off = (row0 + ai * HALF + m * 16) * 1024 + col0;
#pragma unroll
                for (int bj = 0; bj < 2; ++bj)
#pragma unroll
                    for (int n = 0; n < 2; ++n) *(f32x4*)(out + off + bj * HALF + n * 16) = xv[m][bj][n] + gv[bj][n] * acc[ai][bj][m][n]; }
            asm volatile("" ::: "memory"); }
    }
};

template <class Epi, class Sched, bool ALIGN_EPI = false, bool SP2 = false>
__device__ __forceinline__ void gemm_phase(PG8_LAS unsigned char* lds, const Gemm g, const Sched& S, const Epi& E) {
    int tid_ = threadIdx.x; asm volatile("" : "+v"(tid_));
    const int tid = tid_, wid = __builtin_amdgcn_readfirstlane(tid >> 6), lane = tid & 63, wr = wid >> 2, wc = wid & 3, fr = lane & 15, fq = lane >> 4;
    const int K = g.K, nt = K / BK;
    unsigned voffA[2], voffB[2];
#pragma unroll
    for (int i = 0; i < 2; ++i) { int R, C; stage_rc(tid * 16 + i * 8192, R, C); const int Rb = Epi::PERM ? ((R & ~31) + perm32(R & 31)) : R;
        voffA[i] = (unsigned)(R * K + C) * 2u; voffB[i] = (unsigned)(Rb * K + C) * 2u; }
    const size_t kstep = (size_t)(BK * 2);
    const size_t hstep = (size_t)HALF * K * 2;
    const size_t tstep = 2 * hstep;
    const unsigned ldsw = (unsigned)wid * 1024u;
    const int aoff = lds_byte(wr * 64 + fr, fq * 8), boff = lds_byte(wc * 32 + fr, fq * 8);
#define PG8_SA(b, h) (((b) * 2 + (h)) * HTB)
#define PG8_SB(b, h) ((4 + (b) * 2 + (h)) * HTB)
#define PG8_STAGE(bufoff, gbase, voff) do { _Pragma("unroll") for (int _i = 0; _i < 2; ++_i) \
        __builtin_amdgcn_global_load_lds((const unsigned*)((const char*)(gbase) + (voff)[_i]), (PG8_LAS unsigned*)(lds + (bufoff) + ldsw + _i * 8192), 16, 0, 0); } while (0)
#define PG8_LDA(dst, b, h) do { _Pragma("unroll") for (int m = 0; m < 4; ++m) _Pragma("unroll") for (int k = 0; k < 2; ++k) dst[m][k] = *(const PG8_LAS bf16x8*)(lds + PG8_SA(b, h) + aoff + m * 2048 + k * 1024); } while (0)
#define PG8_LDB(dst, b, h) do { _Pragma("unroll") for (int n = 0; n < 2; ++n) _Pragma("unroll") for (int k = 0; k < 2; ++k) dst[n][k] = *(const PG8_LAS bf16x8*)(lds + PG8_SB(b, h) + boff + n * 2048 + k * 1024); } while (0)
#define PG8_MMA(ai, bj, At, Bt) do { __builtin_amdgcn_s_setprio(1); _Pragma("unroll") for (int m = 0; m < 4; ++m) _Pragma("unroll") for (int n = 0; n < 2; ++n) _Pragma("unroll") for (int k = 0; k < 2; ++k) \
        acc[ai][bj][m][n] = __builtin_amdgcn_mfma_f32_16x16x32_bf16(Bt[n][k], At[m][k], acc[ai][bj][m][n], 0, 0, 0); __builtin_amdgcn_s_setprio(0); } while (0)
#define PG8_WAIT_V(n) asm volatile("s_waitcnt vmcnt(" #n ")" ::: "memory")
#define PG8_WAIT_L(n) asm volatile("s_waitcnt lgkmcnt(" #n ")" ::: "memory")
#define PG8_BAR __builtin_amdgcn_s_barrier()
#define PG8_SCHED __builtin_amdgcn_sched_barrier(0)
    Unit cur, nxt; int ui = 0;
    if (!S.next(0, cur)) return;
    f32x4 acc[2][2][4][2];
#pragma unroll
    for (int a = 0; a < 2; ++a)
#pragma unroll
        for (int b = 0; b < 2; ++b)
#pragma unroll
            for (int m = 0; m < 4; ++m)
#pragma unroll
                for (int n = 0; n < 2; ++n) acc[a][b][m][n] = (f32x4){0.f, 0.f, 0.f, 0.f};
    bf16x8 At[4][2], B0[2][2], B1[2][2];
    const char* cA = (const char*)g.A + (size_t)cur.pm * tstep; const char* cB = (const char*)g.Bt + (size_t)cur.pn * tstep;
    S.a_ready(cur);
    if constexpr (SP2) {
        PG8_STAGE(PG8_SB(0, 0), cB, voffB); PG8_STAGE(PG8_SB(0, 1), cB + hstep, voffB); PG8_STAGE(PG8_SA(0, 0), cA, voffA); PG8_STAGE(PG8_SA(0, 1), cA + hstep, voffA);
        if (wr == 1) PG8_BAR;
        PG8_WAIT_V(2); PG8_BAR;
        PG8_STAGE(PG8_SB(1, 0), cB + kstep, voffB); PG8_STAGE(PG8_SA(1, 0), cA + kstep, voffA); PG8_STAGE(PG8_SB(1, 1), cB + hstep + kstep, voffB);
        PG8_WAIT_V(6); PG8_BAR;
    } else {
        PG8_STAGE(PG8_SB(0, 0), cB, voffB); PG8_STAGE(PG8_SA(0, 0), cA, voffA); PG8_STAGE(PG8_SB(0, 1), cB + hstep, voffB); PG8_STAGE(PG8_SA(0, 1), cA + hstep, voffA);
        if (wr == 1) PG8_BAR;
        PG8_WAIT_V(4); PG8_BAR;
        PG8_STAGE(PG8_SB(1, 0), cB + kstep, voffB); PG8_STAGE(PG8_SA(1, 0), cA + kstep, voffA); PG8_STAGE(PG8_SB(1, 1), cB + hstep + kstep, voffB);
        PG8_WAIT_V(6); PG8_BAR;
    }
    for (;;) {
        const bool has_next = S.next(ui + 1, nxt);
        const char* nA = has_next ? (const char*)g.A + (size_t)nxt.pm * tstep : cA; const char* nB = has_next ? (const char*)g.Bt + (size_t)nxt.pn * tstep : cB;
        for (int t = 0; t < nt; t += 2) {
            if constexpr (Epi::MID) { if (t == nt / 2) E.mid(acc, cur, wr, wc, fr, fq); }
            const bool last = (t == nt - 2);
            const char* a1 = cA + (size_t)(t + 1) * kstep;
            const char* a2 = last ? nA : cA + (size_t)(t + 2) * kstep; const char* b2 = last ? nB : cB + (size_t)(t + 2) * kstep;
            const char* a3 = a2 + kstep; const char* b3 = b2 + kstep;
            if (last && has_next) S.a_ready(nxt);
            if constexpr (SP2) {
            PG8_LDB(B0, 0, 0); PG8_LDB(B1, 0, 1); PG8_SCHED; PG8_LDA(At, 0, 0); PG8_STAGE(PG8_SA(1, 1), a1 + hstep, voffA);
            PG8_WAIT_V(8); PG8_WAIT_L(0); PG8_BAR; PG8_MMA(0, 0, At, B0); PG8_MMA(0, 1, At, B1); PG8_BAR; PG8_SCHED;
            PG8_LDA(At, 0, 1); PG8_STAGE(PG8_SB(0, 0), b2, voffB); PG8_STAGE(PG8_SB(0, 1), b2 + hstep, voffB); PG8_STAGE(PG8_SA(0, 0), a2, voffA);
            PG8_WAIT_V(8); PG8_WAIT_L(0); PG8_BAR; PG8_MMA(1, 0, At, B0); PG8_MMA(1, 1, At, B1); PG8_BAR; PG8_SCHED;
            PG8_LDB(B0, 1, 0); PG8_LDB(B1, 1, 1); PG8_SCHED; PG8_LDA(At, 1, 0); PG8_STAGE(PG8_SA(0, 1), a2 + hstep, voffA);
            PG8_WAIT_V(8); PG8_WAIT_L(0); PG8_BAR; PG8_MMA(0, 0, At, B0); PG8_MMA(0, 1, At, B1); PG8_BAR; PG8_SCHED;
            PG8_LDA(At, 1, 1); PG8_STAGE(PG8_SB(1, 0), b3, voffB); PG8_STAGE(PG8_SB(1, 1), b3 + hstep, voffB); PG8_STAGE(PG8_SA(1, 0), a3, voffA);
            PG8_WAIT_V(8); PG8_WAIT_L(0); PG8_BAR; PG8_MMA(1, 0, At, B0); PG8_MMA(1, 1, At, B1); PG8_BAR; PG8_SCHED;
            } else {
            PG8_LDB(B0, 0, 0); PG8_SCHED; PG8_LDA(At, 0, 0); PG8_STAGE(PG8_SA(1, 1), a1 + hstep, voffA);
            PG8_WAIT_L(8); PG8_BAR; PG8_WAIT_L(0); PG8_MMA(0, 0, At, B0); PG8_BAR; PG8_SCHED;
            PG8_LDB(B1, 0, 1); PG8_STAGE(PG8_SB(0, 0), b2, voffB);
            PG8_BAR; PG8_WAIT_L(0); PG8_MMA(0, 1, At, B1); PG8_BAR;
            PG8_LDA(At, 0, 1); PG8_STAGE(PG8_SA(0, 0), a2, voffA);
            PG8_BAR; PG8_WAIT_L(0); PG8_MMA(1, 0, At, B0); PG8_BAR; PG8_SCHED;
            PG8_STAGE(PG8_SB(0, 1), b2 + hstep, voffB);
            PG8_WAIT_V(6); PG8_BAR; PG8_MMA(1, 1, At, B1); PG8_BAR;
            PG8_LDB(B0, 1, 0); PG8_SCHED; PG8_LDA(At, 1, 0); PG8_STAGE(PG8_SA(0, 1), a2 + hstep, voffA);
            PG8_WAIT_L(8); PG8_BAR; PG8_WAIT_L(0); PG8_MMA(0, 0, At, B0); PG8_BAR; PG8_SCHED;
            PG8_LDB(B1, 1, 1); PG8_STAGE(PG8_SB(1, 0), b3, voffB);
            PG8_BAR; PG8_WAIT_L(0); PG8_MMA(0, 1, At, B1); PG8_BAR;
            PG8_LDA(At, 1, 1); PG8_STAGE(PG8_SA(1, 0), a3, voffA);
            PG8_BAR; PG8_WAIT_L(0); PG8_MMA(1, 0, At, B0); PG8_BAR; PG8_SCHED;
            PG8_STAGE(PG8_SB(1, 1), b3 + hstep, voffB);
            PG8_WAIT_V(6); PG8_BAR; PG8_MMA(1, 1, At, B1); PG8_BAR;
            }
        }
        if constexpr (ALIGN_EPI) { if (wr == 0) PG8_BAR; }
        if constexpr (!Epi::AFTER_DRAIN) { E(acc, cur, wr, wc, fr, fq); S.done(cur); }
        if (!has_next) break;
#pragma unroll
        for (int a = 0; a < 2; ++a)
#pragma unroll
            for (int b = 0; b < 2; ++b)
#pragma unroll
                for (int m = 0; m < 4; ++m)
#pragma unroll
                    for (int n = 0; n < 2; ++n) acc[a][b][m][n] = (f32x4){0.f, 0.f, 0.f, 0.f};
        cur = nxt; cA = nA; cB = nB; ++ui;
        if constexpr (ALIGN_EPI) { if (wr == 1) PG8_BAR; }
    }
    PG8_WAIT_V(0);
    if constexpr (!ALIGN_EPI) { if (wr == 0) PG8_BAR; }
    PG8_BAR;
    if constexpr (Epi::AFTER_DRAIN) { E.fused(acc, cur, wr, wc, fr, fq, lds, wid, lane); S.done(cur); }
#undef PG8_SA
#undef PG8_SB
#undef PG8_STAGE
#undef PG8_LDA
#undef PG8_LDB
#undef PG8_MMA
#undef PG8_WAIT_V
#undef PG8_WAIT_L
#undef PG8_BAR
#undef PG8_SCHED
}
}

#ifndef PG8_SP2
#define PG8_SP2 true
#endif
#ifndef PG8_ALIGN
#define PG8_ALIGN true
#endif
#include <hip/hip_bf16.h>
#include <cmath>
namespace attn_body {
using bf16=__hip_bfloat16;
using bf16x8=__attribute__((ext_vector_type(8)))short;
using s16x4=__attribute__((ext_vector_type(4)))short;
using f32x16=__attribute__((ext_vector_type(16)))float;
using u32x4=__attribute__((ext_vector_type(4)))unsigned;
using f32x4v=__attribute__((ext_vector_type(4)))float;
constexpr int BATCH=8,NHEAD=8,SEQ=4096,D=64,DM=NHEAD*D;
constexpr int NW=8,QBLK=32,QB=QBLK*NW,KVBLK=64,NQB=SEQ/QB;
constexpr int ATTN_PITCH=DM, ATTN_UNIT_ROWS=QB, OPITCH=1024;
__device__ __forceinline__ int crow(int r,int hi){return (r&3)+8*(r>>2)+4*hi;}
#define SBAR() __builtin_amdgcn_sched_barrier(0)
__device__ __forceinline__ void cmask(f32x16&p0,f32x16&p1,int jb,int qrel,int hi){
  const float NEG=-INFINITY; int kb=64*jb+4*hi;
  #pragma unroll
  for(int r=0;r<16;++r){int kv=kb+(r&3)+8*(r>>2); if(kv>qrel)p0[r]=NEG; if(kv+32>qrel)p1[r]=NEG;}
}

constexpr int NSLOT=3, SLOTB=8192;
constexpr int LDS_K=0, LDS_V=NSLOT*SLOTB, LDS_WS=2*NSLOT*SLOTB, LDS_OST=LDS_WS+NW*64*4, LDS_BIAS=LDS_OST+NW*4096, LDS_BYTES=LDS_BIAS+SEQ*4;
constexpr float C2=0.125f*1.4426950408889634f;
__device__ __forceinline__ void glds16(const void*gsrc,unsigned lds_dst){unsigned keep;
  asm volatile("s_mov_b32 %0, m0\n\ts_mov_b32 m0, %2\n\ts_nop 0\n\tglobal_load_lds_dwordx4 %1, off\n\ts_mov_b32 m0, %0":"=&s"(keep):"v"(gsrc),"s"(lds_dst):"memory");}
__device__ __forceinline__ float max3f(float a,float b,float c){float r;asm("v_max3_f32 %0, %1, %2, %3":"=v"(r):"v"(a),"v"(b),"v"(c));return r;}
__device__ __forceinline__ float max2f(float a,float b){float r;asm("v_max_f32_e32 %0, %1, %2":"=v"(r):"v"(a),"v"(b));return r;}
__device__ __forceinline__ float fadd_s(float a,float b){float r;asm("v_add_f32_e32 %0, %1, %2":"=v"(r):"v"(a),"v"(b));return r;}
__device__ __forceinline__ float fsub_s(float a,float b){float r;asm("v_sub_f32_e32 %0, %1, %2":"=v"(r):"v"(a),"v"(b));return r;}
typedef float f32x2_t __attribute__((ext_vector_type(2))); typedef __bf16 bf16x2_t __attribute__((ext_vector_type(2)));
__device__ __forceinline__ unsigned cvtpk_s(float lo,float hi){f32x2_t v={lo,hi};bf16x2_t b=__builtin_convertvector(v,bf16x2_t);return __builtin_bit_cast(unsigned,b);}
#define WAIT_BAR(N) asm volatile("s_waitcnt vmcnt(" #N ") lgkmcnt(0)\n\ts_barrier":::"memory")

__device__ __forceinline__ void qkt(f32x16&p0,f32x16&p1,const char*Kslot,const bf16x8*qr,int r32,int hi){
  const char*kb=Kslot+hi*1024+r32*16;
  #pragma unroll
  for(int d0=0;d0<4;++d0){
    const bf16x8 b0=*reinterpret_cast<const bf16x8*>(kb+d0*2048);
    const bf16x8 b1=*reinterpret_cast<const bf16x8*>(kb+d0*2048+512);
    p0=__builtin_amdgcn_mfma_f32_32x32x16_bf16(b0,qr[d0],p0,0,0,0);p1=__builtin_amdgcn_mfma_f32_32x32x16_bf16(b1,qr[d0],p1,0,0,0);}
}
typedef __attribute__((address_space(3))) const char* lds_cptr;
typedef short v4i16_t __attribute__((ext_vector_type(4)));
__device__ __forceinline__ void kload8(bf16x8*kf,lds_cptr kp){
  kf[0]=*(const __attribute__((address_space(3))) bf16x8*)(kp);      kf[1]=*(const __attribute__((address_space(3))) bf16x8*)(kp+512);
  kf[2]=*(const __attribute__((address_space(3))) bf16x8*)(kp+2048); kf[3]=*(const __attribute__((address_space(3))) bf16x8*)(kp+2560);
  kf[4]=*(const __attribute__((address_space(3))) bf16x8*)(kp+4096); kf[5]=*(const __attribute__((address_space(3))) bf16x8*)(kp+4608);
  kf[6]=*(const __attribute__((address_space(3))) bf16x8*)(kp+6144); kf[7]=*(const __attribute__((address_space(3))) bf16x8*)(kp+6656);
}
__device__ __forceinline__ void kload2(bf16x8*kf,lds_cptr kp,int j){ kf[2*j]=*(const __attribute__((address_space(3))) bf16x8*)(kp+j*2048); kf[2*j+1]=*(const __attribute__((address_space(3))) bf16x8*)(kp+j*2048+512); }
__device__ __forceinline__ s16x4 vtr(lds_cptr p){ return __builtin_bit_cast(s16x4,__builtin_amdgcn_ds_read_tr16_b64_v4i16((__attribute__((address_space(3))) v4i16_t*)p)); }
__device__ __forceinline__ float rowmax(const f32x16&p0,const f32x16&p1){
  float a=max3f(p0[0],p0[1],p1[0]),b=max3f(p0[2],p0[3],p1[1]);a=max3f(a,p1[2],p1[3]);
  #pragma unroll
  for(int r=4;r<16;r+=4){a=max3f(a,p0[r],p0[r+1]);b=max3f(b,p0[r+2],p0[r+3]);a=max3f(a,p1[r],p1[r+1]);b=max3f(b,p1[r+2],p1[r+3]);}
  const float m=max2f(a,b);
  auto rr=__builtin_amdgcn_permlane32_swap(__float_as_uint(m),__float_as_uint(m),false,false);
  return max2f(__uint_as_float(rr[0]),__uint_as_float(rr[1]));
}
__device__ __forceinline__ void pv(f32x16*o,int vb,bf16x8 pa0,bf16x8 pa1,bf16x8 pa2,bf16x8 pa3){
  #pragma unroll
  for(int d0=0;d0<2;++d0){s16x4 lo[4],hi[4];
    #pragma unroll
    for(int ks=0;ks<4;++ks){
      asm volatile("ds_read_b64_tr_b16 %0,%1 offset:%c2":"=&v"(lo[ks]):"v"(vb),"i"(d0*4096+ks*1024):"memory");
      asm volatile("ds_read_b64_tr_b16 %0,%1 offset:%c2":"=&v"(hi[ks]):"v"(vb),"i"(d0*4096+ks*1024+512):"memory");}
    asm volatile("s_waitcnt lgkmcnt(0)":::"memory");SBAR();
    #define PK(k) (bf16x8){lo[k][0],lo[k][1],lo[k][2],lo[k][3],hi[k][0],hi[k][1],hi[k][2],hi[k][3]}
    o[d0]=__builtin_amdgcn_mfma_f32_32x32x16_bf16(pa0,PK(0),o[d0],0,0,0);
    o[d0]=__builtin_amdgcn_mfma_f32_32x32x16_bf16(pa1,PK(1),o[d0],0,0,0);
    o[d0]=__builtin_amdgcn_mfma_f32_32x32x16_bf16(pa2,PK(2),o[d0],0,0,0);
    o[d0]=__builtin_amdgcn_mfma_f32_32x32x16_bf16(pa3,PK(3),o[d0],0,0,0);
    #undef PK
  }
}

#ifndef ATTN_STORE16
#define ATTN_STORE16(p,v) (*(u32x4*)(p)=(v))
#endif
struct AttnTensors { unsigned char* ws; size_t oq,ok,ov,oz,olf,oo,obias,oj0; float gap,hdr; };
template<int THRL> __device__ __forceinline__ void attn_unit(int b,int h,int qb,int j0,f32x4v brow0,f32x4v brow1,unsigned*ctr,unsigned&nxt,const AttnTensors&T_,char*shm){
  const bf16*Q=(const bf16*)(T_.ws+T_.oq); const bf16*__restrict__ K=(const bf16*)(T_.ws+T_.ok); const bf16*__restrict__ V=(const bf16*)(T_.ws+T_.ov);
  const int tid=threadIdx.x,lane=tid&63,r32=lane&31,hi=lane>>5; const int wid=__builtin_amdgcn_readfirstlane(tid>>6);
  const long rowbase=(long)b*SEQ; const int q0=qb*QB;
  const bf16*Qw=Q+(rowbase+q0+wid*QBLK)*DM+h*D;
  const bf16*Kh=K+(rowbase+(long)j0*KVBLK)*DM+h*D,*Vh=V+(rowbase+(long)j0*KVBLK)*DM+h*D;
  const unsigned lds0=(unsigned)(uintptr_t)shm;
  float*wsf=(float*)(shm+LDS_WS)+wid*64;
  const bf16*ksrc=Kh+(long)lane*DM+wid*8;
  const bf16*vsrc=Vh+(long)(16*(wid&3)+(lane>>2))*DM+(wid>>2)*32+(lane&3)*8;
  const unsigned kdst=lds0+LDS_K+wid*1024, vdst=lds0+LDS_V+wid*1024;
  #define DMA_K(t,slot) glds16(ksrc+(long)(t)*KVBLK*DM,(unsigned)__builtin_amdgcn_readfirstlane(kdst+(slot)))
  #define DMA_V(t,slot) glds16(vsrc+(long)(t)*KVBLK*DM,(unsigned)__builtin_amdgcn_readfirstlane(vdst+(slot)))
  const int vb0=(int)(lds0+LDS_V)+((lane>>4)&1)*32+(lane&3)*8+(4*hi+((lane&15)>>2))*64;
  const char*Kbase=shm+LDS_K; bf16x8 kf[8];
  const lds_cptr shm3=(lds_cptr)shm; const lds_cptr kp0=shm3+LDS_K+hi*1024+r32*16; const lds_cptr vp0=shm3+LDS_V+((lane>>4)&1)*32+(lane&3)*8+(4*hi+((lane&15)>>2))*64;
  const int NT=(q0+QB)/KVBLK-j0;
  DMA_K(0,0);DMA_V(0,0);DMA_K(1,SLOTB);
  bf16x8 qr[4];
  #pragma unroll
  for(int d0=0;d0<4;++d0)qr[d0]=*reinterpret_cast<const bf16x8*>(&Qw[(long)r32*DM+d0*16+hi*8]);
  float mhat=0.f,l_reg=0.f;f32x16 o[2];o[0]=f32x16{};o[1]=f32x16{};
  const lds_cptr bp0=shm3+LDS_BIAS+hi*16+j0*256;
  #define BL(P,t,g,off) do{ const f32x4v a_=*(const __attribute__((address_space(3))) f32x4v*)(bp0+(t)*256+(off)+(g)*32); P[4*(g)]=a_[0];P[4*(g)+1]=a_[1];P[4*(g)+2]=a_[2];P[4*(g)+3]=a_[3]; }while(0)
  #define BS(P,g) do{ P[4*(g)]-=mhat;P[4*(g)+1]-=mhat;P[4*(g)+2]-=mhat;P[4*(g)+3]-=mhat; }while(0)
  #define BINIT(P0,P1,t) do{ _Pragma("unroll") for(int g_=0;g_<4;++g_){BL(P0,t,g_,0);BL(P1,t,g_,128);} _Pragma("unroll") for(int g_=0;g_<4;++g_){BS(P0,g_);BS(P1,g_);} }while(0)
  const int qrel=wid*QBLK+r32;
  #define CMASK(P0,P1,t) do{int jb_=(t)-(NT-4); if(jb_>=0)cmask(P0,P1,jb_,qrel,hi);}while(0)
  bool resc=false;
  #define START(P0,P1) do{ resc=false; \
    if(THRL>=0){ const float rm=rowmax(P0,P1); if(__builtin_expect(__any(rm>(float)THRL),0)){ const float dl=__builtin_fmaxf(rm,0.f); mhat=fadd_s(mhat,dl); \
      _Pragma("unroll") for(int r=0;r<16;++r){P0[r]=fsub_s(P0[r],dl);P1[r]=fsub_s(P1[r],dl);} } } \
    _Pragma("unroll") for(int r=0;r<16;++r)P0[r]=__builtin_amdgcn_exp2f(P0[r]); }while(0)
  #define RESC() do{ if(resc){ asm volatile("s_waitcnt lgkmcnt(0)":::"memory"); \
      _Pragma("unroll") for(int d_=0;d_<2;++d_) _Pragma("unroll") for(int r=0;r<16;++r)o[d_][r]*=wsf[crow(r,hi)]; } }while(0)
  f32x16 pA0,pA1,pB0,pB1;
  int sl_prev=0,sl_cur=0,sl_next=SLOTB;
  #define ROT() do{sl_prev=sl_cur;sl_cur=sl_next;sl_next=(sl_next==(NSLOT-1)*SLOTB)?0:sl_next+SLOTB;}while(0)
  DMA_K(2,2*SLOTB);
  { __attribute__((address_space(3))) f32x4v*bd=(__attribute__((address_space(3))) f32x4v*)((__attribute__((address_space(3))) char*)shm+LDS_BIAS)+tid*2; bd[0]=brow0; bd[1]=brow1; }
  if(tid==0)nxt=gridDim.x+__hip_atomic_fetch_add(ctr,1u,__ATOMIC_RELAXED,__HIP_MEMORY_SCOPE_AGENT);
  WAIT_BAR(3);
  mhat=((const __attribute__((address_space(3))) float*)(shm3+LDS_BIAS))[q0+qrel]+T_.hdr;
  BINIT(pA0,pA1,0);
  qkt(pA0,pA1,Kbase,qr,r32,hi);asm volatile("s_nop 15\n\ts_nop 7":"+v"(pA0),"+v"(pA1));CMASK(pA0,pA1,0);
  START(pA0,pA1);
  BINIT(pB0,pB1,1);
  _Pragma("unroll") for(int r=0;r<16;++r)pA1[r]=__builtin_amdgcn_exp2f(pA1[r]);
  WAIT_BAR(0);
  DMA_K(3,0);DMA_V(1,SLOTB);
  ROT();
  kload8(kf,kp0+sl_cur);
  WAIT_BAR(2);
  s16x4 vlo[8],vhi[8]; u32x4 pw0,pw1,pw2,pw3;
  #define PKW(P,B) cvtpk_s(P[B],P[B+1])
  #define PAF(k) __builtin_bit_cast(bf16x8,pw##k)
  #define VFR(i) (bf16x8){vlo[i][0],vlo[i][1],vlo[i][2],vlo[i][3],vhi[i][0],vhi[i][1],vhi[i][2],vhi[i][3]}
  #define PIN(x) asm volatile("":"+v"(x))
  #define MX3(a,b,c) __builtin_fmaxf(__builtin_fmaxf((a),(b)),(c))
  #define GAPA(MF,A0,A1,A2,A3,W0,W1,PW) do{ MF; sacc+=A0; sacc+=A1; sacc+=A2; sacc+=A3; PIN(sacc); W0; W1; PIN(PW); SBAR(); }while(0)
  #define EX(v) __builtin_amdgcn_exp2f(v)
  #define GAPB(MF,X,B,E0,E1) do{ MF; X[B]=EX(X[B]); X[B+1]=EX(X[B+1]); X[B+2]=EX(X[B+2]); X[B+3]=EX(X[B+3]); PIN(X); E0; E1; SBAR(); }while(0)
  #define BLG(G,P,t,g,off) do{ if(G){ BL(P,t,g,off); } }while(0)
  #define BSG(G,P,g) do{ if(G){ BS(P,g); } }while(0)
  #define VRD(i) do{ vlo[i]=vtr(vp_+(((i)>>2)*4096+((i)&3)*1024)); vhi[i]=vtr(vp_+(((i)>>2)*4096+((i)&3)*1024+512)); }while(0)
  #define KRD(G,j) do{ if(G){ kload2(kf,kp0+sl_next,j); SBAR(); } }while(0)
  #define STEP(C0,C1,P0,P1,t,GK,GV,GL) do{ SBAR(); \
    const lds_cptr vp_=vp0+sl_prev; \
    VRD(0); SBAR(); float sacc=(P0[0]+P0[1]); \
    GAPA(C0=__builtin_amdgcn_mfma_f32_32x32x16_bf16(kf[0],qr[0],C0,0,0,0), P0[2],P0[3],P0[4],P0[5],     pw0[0]=PKW(P0,0), pw0[1]=PKW(P0,2), pw0); \
    VRD(4); SBAR(); GAPA(C1=__builtin_amdgcn_mfma_f32_32x32x16_bf16(kf[1],qr[0],C1,0,0,0), P0[6],P0[7],P0[8],P0[9],     pw0[2]=PKW(P0,4), pw0[3]=PKW(P0,6), pw0); \
    VRD(1); SBAR(); GAPA(C0=__builtin_amdgcn_mfma_f32_32x32x16_bf16(kf[2],qr[1],C0,0,0,0),   P0[10],P0[11],P0[12],P0[13], pw1[0]=PKW(P0,8), pw1[1]=PKW(P0,10), pw1); \
    VRD(5); SBAR(); GAPA(C1=__builtin_amdgcn_mfma_f32_32x32x16_bf16(kf[3],qr[1],C1,0,0,0),   P0[14],P0[15],P1[0],P1[1],   pw1[2]=PKW(P0,12),pw1[3]=PKW(P0,14), pw1); \
    VRD(2); SBAR(); GAPA(C0=__builtin_amdgcn_mfma_f32_32x32x16_bf16(kf[4],qr[2],C0,0,0,0),   P1[2],P1[3],P1[4],P1[5],     pw2[0]=PKW(P1,0), pw2[1]=PKW(P1,2), pw2); \
    VRD(6); SBAR(); GAPA(C1=__builtin_amdgcn_mfma_f32_32x32x16_bf16(kf[5],qr[2],C1,0,0,0),   P1[6],P1[7],P1[8],P1[9],     pw2[2]=PKW(P1,4), pw2[3]=PKW(P1,6), pw2); \
    VRD(3); SBAR(); GAPA(C0=__builtin_amdgcn_mfma_f32_32x32x16_bf16(kf[6],qr[3],C0,0,0,0),   P1[10],P1[11],P1[12],P1[13], pw3[0]=PKW(P1,8), pw3[1]=PKW(P1,10), pw3); \
    VRD(7); SBAR(); GAPA(C1=__builtin_amdgcn_mfma_f32_32x32x16_bf16(kf[7],qr[3],C1,0,0,0),   P1[14],P1[15],0.f,0.f,       pw3[2]=PKW(P1,12),pw3[3]=PKW(P1,14), pw3); \
    l_reg+=sacc; \
    if(GK){DMA_K((t)+3,sl_cur);} if(GV){DMA_V((t)+1,sl_next);} \
    CMASK(C0,C1,t); \
    if(THRL>=0){ float a=MX3(C0[0],C0[1],C1[0]),b=MX3(C0[2],C0[3],C1[1]); a=MX3(a,C1[2],C1[3]); \
      _Pragma("unroll") for(int r=4;r<16;r+=4){a=MX3(a,C0[r],C0[r+1]);b=MX3(b,C0[r+2],C0[r+3]);a=MX3(a,C1[r],C1[r+1]);b=MX3(b,C1[r+2],C1[r+3]);} \
      float rm=__builtin_fmaxf(a,b); { auto rr=__builtin_amdgcn_permlane32_swap(__float_as_uint(rm),__float_as_uint(rm),false,false); rm=__builtin_fmaxf(__uint_as_float(rr[0]),__uint_as_float(rr[1])); } \
      resc=false; \
      if(__builtin_expect(__any(rm>(float)THRL),0)){ const float dl=__builtin_fmaxf(rm,0.f); mhat+=dl; \
        _Pragma("unroll") for(int r=0;r<16;++r){C0[r]-=dl;C1[r]-=dl;} \
        const float f=__builtin_amdgcn_exp2f(-dl); l_reg*=f; if(hi==0)wsf[r32]=f; resc=true; } } \
    SBAR(); \
    GAPB(o[0]=__builtin_amdgcn_mfma_f32_32x32x16_bf16(PAF(0),VFR(0),o[0],0,0,0), C0,0,  BLG(GL,P0,(t)+1,0,0),  BLG(GL,P0,(t)+1,1,0)); \
    GAPB(o[1]=__builtin_amdgcn_mfma_f32_32x32x16_bf16(PAF(0),VFR(4),o[1],0,0,0), C0,4,  BLG(GL,P0,(t)+1,2,0),  BLG(GL,P0,(t)+1,3,0)); \
    KRD(GL,0); GAPB(o[0]=__builtin_amdgcn_mfma_f32_32x32x16_bf16(PAF(1),VFR(1),o[0],0,0,0), C0,8,  BLG(GL,P1,(t)+1,0,128), BLG(GL,P1,(t)+1,1,128)); \
    KRD(GL,1); GAPB(o[1]=__builtin_amdgcn_mfma_f32_32x32x16_bf16(PAF(1),VFR(5),o[1],0,0,0), C0,12, BLG(GL,P1,(t)+1,2,128), BLG(GL,P1,(t)+1,3,128)); \
    KRD(GL,2); GAPB(o[0]=__builtin_amdgcn_mfma_f32_32x32x16_bf16(PAF(2),VFR(2),o[0],0,0,0), C1,0,  BSG(GL,P0,0), BSG(GL,P0,1)); \
    KRD(GL,3); GAPB(o[1]=__builtin_amdgcn_mfma_f32_32x32x16_bf16(PAF(2),VFR(6),o[1],0,0,0), C1,4,  BSG(GL,P0,2), BSG(GL,P0,3)); \
    GAPB(o[0]=__builtin_amdgcn_mfma_f32_32x32x16_bf16(PAF(3),VFR(3),o[0],0,0,0), C1,8,  BSG(GL,P1,0), BSG(GL,P1,1)); \
    GAPB(o[1]=__builtin_amdgcn_mfma_f32_32x32x16_bf16(PAF(3),VFR(7),o[1],0,0,0), C1,12, BSG(GL,P1,2), BSG(GL,P1,3)); \
    }while(0)
  int t=1;
  #undef CMASK
  #define CMASK(P0,P1,t) do{}while(0)
  for(;t+5<NT;t+=2){
    STEP(pB0,pB1,pA0,pA1,t,true,true,true);     WAIT_BAR(2); RESC(); ROT();
    STEP(pA0,pA1,pB0,pB1,t+1,true,true,true);   WAIT_BAR(2); RESC(); ROT();
  }
  #undef CMASK
  #define CMASK(P0,P1,t) do{int jb_=(t)-(NT-4); if(jb_>=0)cmask(P0,P1,jb_,qrel,hi);}while(0)
  #define ENDW(tt) do{ if((tt)+3<NT){WAIT_BAR(2);} else if((tt)+2<NT){WAIT_BAR(1);} else {WAIT_BAR(0);} }while(0)
  for(;t+1<NT;t+=2){
    STEP(pB0,pB1,pA0,pA1,t,(t+3<NT),(t+1<NT),(t+1<NT));       ENDW(t);   RESC(); ROT();
    STEP(pA0,pA1,pB0,pB1,t+1,(t+4<NT),(t+2<NT),(t+2<NT));     ENDW(t+1); RESC(); ROT();
  }
  STEP(pB0,pB1,pA0,pA1,NT-1,false,false,false); RESC();
  const bf16*Zw=(const bf16*)(T_.ws+T_.oz)+(rowbase+q0+wid*QBLK)*DM+h*D;
  u32x4 zv[4];
  #pragma unroll
  for(int i=0;i<4;++i)zv[i]=*(const u32x4*)(Zw+(long)(i*8+(lane>>3))*DM+(lane&7)*8);
  { float sacc=pB0[0]+pB0[1]; _Pragma("unroll") for(int r=2;r<16;++r)sacc+=pB0[r]; _Pragma("unroll") for(int r=0;r<16;++r)sacc+=pB1[r]; l_reg+=sacc;
    pw0=(u32x4){PKW(pB0,0),PKW(pB0,2),PKW(pB0,4),PKW(pB0,6)};pw1=(u32x4){PKW(pB0,8),PKW(pB0,10),PKW(pB0,12),PKW(pB0,14)};pw2=(u32x4){PKW(pB1,0),PKW(pB1,2),PKW(pB1,4),PKW(pB1,6)};pw3=(u32x4){PKW(pB1,8),PKW(pB1,10),PKW(pB1,12),PKW(pB1,14)};
    SBAR(); pv(o,vb0+sl_cur,PAF(0),PAF(1),PAF(2),PAF(3)); }
  #undef PKW
  #undef PAF
  #undef VFR
  #undef PIN
  #undef MX3
  #undef GAPA
  #undef GAPB
  #undef EX
  #undef VRD
  #undef KRD
  #undef STEP
  #undef ENDW
  {auto rr=__builtin_amdgcn_permlane32_swap(__float_as_uint(l_reg),__float_as_uint(l_reg),false,false);l_reg=__uint_as_float(rr[0])+__uint_as_float(rr[1]);}
  if(hi==0)wsf[32+r32]=l_reg;asm volatile("s_waitcnt lgkmcnt(0)":::"memory");
  float rli[16];
  #pragma unroll
  for(int r=0;r<16;++r)rli[r]=__builtin_amdgcn_rcpf(wsf[32+crow(r,hi)]);
  bf16*Ow=(bf16*)(T_.ws+T_.oo)+(rowbase+q0+wid*QBLK)*OPITCH+h*D;
  { bf16*stg=(bf16*)(shm+LDS_OST)+wid*2048;
    #pragma unroll
    for(int r=0;r<16;++r){const int orow=crow(r,hi);
      #pragma unroll
      for(int d0=0;d0<2;++d0)stg[orow*64+d0*32+r32]=__float2bfloat16(o[d0][r]*rli[r]);}
    asm volatile("s_waitcnt lgkmcnt(0)":::"memory");
    #pragma unroll
    for(int i=0;i<4;++i){const int row=i*8+(lane>>3),ch=lane&7; u32x4 v=*(const u32x4*)(stg+row*64+ch*8);
      #pragma unroll
      for(int e=0;e<4;++e){ const float a0=__uint_as_float(v[e]<<16)*__uint_as_float(zv[i][e]<<16), a1=__uint_as_float(v[e]&0xffff0000u)*__uint_as_float(zv[i][e]&0xffff0000u); v[e]=cvtpk_s(a0,a1); }
      ATTN_STORE16(Ow+(long)row*OPITCH+ch*8,v);} }
  asm volatile("s_waitcnt lgkmcnt(0)\n\ts_barrier":::"memory");
  #undef DMA_K
  #undef DMA_V
  #undef CMASK
  #undef START
  #undef RESC
  #undef ROT
  #undef BL
  #undef BS
  #undef BINIT
  #undef BLG
  #undef BSG
}
constexpr int ATTN_LDS_BYTES=LDS_BYTES;
struct AttnUnit { int bh; int qb; };
__device__ __forceinline__ void bias_scan(char*shm,const float*__restrict__ lf,float*gdst=nullptr){
  const int tid=threadIdx.x,lane=tid&63,wid=tid>>6;
  float*bias=(float*)(shm+LDS_BIAS); float*wtot=(float*)(shm+LDS_WS);
  const f32x4v a=*(const f32x4v*)(lf+tid*8),b=*(const f32x4v*)(lf+tid*8+4);
  const float s0=a[0],s1=s0+a[1],s2=s1+a[2],s3=s2+a[3],s4=s3+b[0],s5=s4+b[1],s6=s5+b[2],s7=s6+b[3];
  float inc=s7;
  #pragma unroll
  for(int o=1;o<64;o<<=1){const float t=__shfl_up(inc,o); if(lane>=o)inc+=t;}
  if(lane==63)wtot[wid]=inc;
  asm volatile("s_waitcnt lgkmcnt(0)\n\ts_barrier":::"memory");
  float base=0.f;
  #pragma unroll
  for(int w=0;w<NW;++w){const float x=wtot[w]; if(w<wid)base+=x;}
  const float off=base+inc-s7; const float NL=-1.4426950408889634f;
  *(f32x4v*)(bias+tid*8)=(f32x4v){(off+s0)*NL,(off+s1)*NL,(off+s2)*NL,(off+s3)*NL};
  *(f32x4v*)(bias+tid*8+4)=(f32x4v){(off+s4)*NL,(off+s5)*NL,(off+s6)*NL,(off+s7)*NL};
  if(gdst){ *(f32x4v*)(gdst+tid*8)=(f32x4v){(off+s0)*NL,(off+s1)*NL,(off+s2)*NL,(off+s3)*NL}; *(f32x4v*)(gdst+tid*8+4)=(f32x4v){(off+s4)*NL,(off+s5)*NL,(off+s6)*NL,(off+s7)*NL}; }
  asm volatile("s_waitcnt lgkmcnt(0)\n\ts_barrier":::"memory");
}
__device__ __forceinline__ void j0_table(const char*shm,float gap,int*dst,int wave,int lane){
  const __attribute__((address_space(3))) float*bl=(const __attribute__((address_space(3))) float*)((const __attribute__((address_space(3))) char*)shm+LDS_BIAS);
  const float v=bl[64*lane+63];
  #pragma unroll
  for(int q=0;q<2;++q){ const int qb=2*wave+q; const float thr=bl[QB*qb]-gap; const unsigned long long mk=__ballot(v>=thr);
    int j0=mk?(int)__builtin_ctzll(mk):0; j0&=~1; const int jmax=4*qb; j0=j0<jmax?j0:jmax; if(lane==0)dst[qb]=j0; }
}
constexpr int LDS_J0=LDS_BIAS+SEQ*4;
static_assert(LDS_J0+4096<=131072,"attention LDS");
template<int THRL,class Extra> __device__ __forceinline__ void attn_phase_dyn(char*lds,const AttnTensors&T,unsigned*ctr,const Extra&X,int nextra){
  const int tid=threadIdx.x;
  volatile __attribute__((address_space(3))) unsigned* uw=(volatile __attribute__((address_space(3))) unsigned*)((__attribute__((address_space(3))) char*)lds+LDS_WS);
  volatile __attribute__((address_space(3))) int* jt=(volatile __attribute__((address_space(3))) int*)((__attribute__((address_space(3))) char*)lds+LDS_J0);
  for(int i=tid;i<BATCH*NHEAD*NQB;i+=NW*64)jt[i]=((const int*)(T.ws+T.oj0))[i];
  const unsigned G_=gridDim.x; unsigned nxt=blockIdx.x;
  for(;;){
    if(tid==0){uw[0]=nxt;}
    asm volatile("s_waitcnt lgkmcnt(0)\n\ts_barrier":::"memory");
    const unsigned u=(unsigned)__builtin_amdgcn_readfirstlane((int)uw[0]);
    if(u>=(unsigned)(BATCH*NHEAD*NQB+nextra))break;
    if(u>=(unsigned)(BATCH*NHEAD*NQB)){ if(tid==0)nxt=G_+__hip_atomic_fetch_add(ctr,1u,__ATOMIC_RELAXED,__HIP_MEMORY_SCOPE_AGENT);
      X((int)u-BATCH*NHEAD*NQB); asm volatile("s_waitcnt lgkmcnt(0)\n\ts_barrier":::"memory"); continue; }
    const int qb=NQB-1-(int)(u/(BATCH*NHEAD)), bh=(int)(u%(BATCH*NHEAD));
    const int j0=__builtin_amdgcn_readfirstlane((int)jt[bh*NQB+qb]);
    const f32x4v*src=(const f32x4v*)((const float*)(T.ws+T.obias)+(long)bh*SEQ)+tid*2; const f32x4v ba=src[0],bb=src[1];
    attn_unit<THRL>(bh/NHEAD,bh%NHEAD,qb,j0,ba,bb,ctr,nxt,T,lds);
  }
}
#undef SBAR
#undef WAIT_BAR
}
constexpr int NWAVES = 8;
#ifndef MK_N_LAUNCHES
#define MK_N_LAUNCHES 1
#endif
constexpr int N_LAUNCHES = MK_N_LAUNCHES;
constexpr int PER_PHASE = 6;

constexpr int BATCH = 8, T = 4096, D = 1024, H = 8, HD = 64, AW = 512, CW = 512, INW = 6152, NPROJ = 6144;
constexpr int M = BATCH * T;
constexpr float EPS = 1e-6f;
constexpr int SRC_F = 1536;

constexpr size_t MiB = 1u << 20;
constexpr size_t WS_ADA = 0;
constexpr size_t WS_WF = 128 * 1024;
constexpr size_t WS_CTL = 256 * 1024;
constexpr int CW_ATTNQ = 3456 + 128;
constexpr size_t WS_LF = 1 * MiB;
constexpr size_t WS_W1 = 2 * MiB;
constexpr size_t WS_WAB = 14 * MiB, WS_WO = 16 * MiB;
constexpr size_t WS_HB = 32 * MiB;
constexpr size_t WS_OAB = WS_HB;
constexpr size_t WS_Q = pg8::OFF_Q;
constexpr size_t WS_K = pg8::OFF_K, WS_V = pg8::OFF_V;
constexpr size_t WS_MG = WS_K;
constexpr size_t WS_SZA = pg8::OFF_SZA, WS_CU = pg8::OFF_CU, WS_GZ = pg8::OFF_GZ;
constexpr size_t WS_R = pg8::OFF_SGA, WS_SGB = pg8::OFF_SGB;
constexpr size_t WS_BIAS = 448 * MiB;
constexpr size_t WS_J0 = 449 * MiB;
constexpr size_t WS_END = 450 * MiB;

constexpr int RING_OFF = 0, RING_BYTES = 131072;
constexpr int MISC_OFF = RING_BYTES + 320;
constexpr int LDS_BYTES = 147456;
static_assert(attn_body::ATTN_LDS_BYTES <= RING_BYTES, "attention LDS");

#define GAS __attribute__((address_space(1)))
#define LAS __attribute__((address_space(3)))
typedef unsigned short bf16;
typedef unsigned v4u __attribute__((ext_vector_type(4)));
typedef float f32x4 __attribute__((ext_vector_type(4)));
#define LDS_WAIT() asm volatile("s_waitcnt lgkmcnt(0)" ::: "memory")
__device__ __forceinline__ unsigned pk2(float lo, float hi) { return pg8::cvt_pk_bf16(lo, hi); }
__device__ __forceinline__ float wave_sum(float v) {
#pragma unroll
    for (int o = 1; o < 64; o <<= 1) v += __shfl_xor(v, o);
    return v;
}

template <bool MAP> __device__ __forceinline__ void p0_transpose_item(const float* W, int K, int NS, bf16* WT, LAS float* scr, int item, int nkb, int lane) {
    const int pb = item / nkb, kb = item % nkb, k0 = 64 * kb, p0 = 32 * pb;
    const int sc = MAP ? pg8::proj_src_col(p0 + (lane & 31)) : p0 + (lane & 31);
#pragma unroll 8
    for (int i = 0; i < 32; ++i) { const int kk = 2 * i + (lane >> 5); scr[kk * 33 + (lane & 31)] = W[(size_t)(k0 + kk) * NS + sc]; }
    LDS_WAIT(); asm volatile("" ::: "memory");
    const int c = lane & 7;
#pragma unroll
    for (int j = 0; j < 4; ++j) { const int n = (lane >> 3) + 8 * j; const LAS float* s = scr + (8 * c) * 33 + n;
        v4u o; o.x = pk2(s[0 * 33], s[1 * 33]); o.y = pk2(s[2 * 33], s[3 * 33]); o.z = pk2(s[4 * 33], s[5 * 33]); o.w = pk2(s[6 * 33], s[7 * 33]);
        *(GAS v4u*)(WT + (size_t)(p0 + n) * K + k0 + 8 * c) = o; }
    LDS_WAIT(); asm volatile("" ::: "memory");
}

#define XB_TMO      128
#define XB_XCNT(j)  (256  + 64 * (j))
#define XB_XSUB(j)  (1280 + 64 * (j))
#define XB_XGEN(j)  (2304 + 64 * (j))
#define XB_TOP      3328
#define XB_TOPGEN   3392
#define XCD_BAR_WORDS 3456
#define XB_SPIN_CAP (1u << 18)

__device__ __forceinline__ unsigned xb_ld(unsigned* p)              { return __hip_atomic_load(p, __ATOMIC_RELAXED, __HIP_MEMORY_SCOPE_AGENT); }
__device__ __forceinline__ unsigned xb_add(unsigned* p, unsigned v) { return __hip_atomic_fetch_add(p, v, __ATOMIC_RELAXED, __HIP_MEMORY_SCOPE_AGENT); }
__device__ __forceinline__ unsigned xb_xcc_id() { return (unsigned)__builtin_amdgcn_s_getreg((3 << 11) | 20) & 0xFu; }
#define XB_SPIN(cond, bar) do { unsigned _sp = 0; while (cond) { __builtin_amdgcn_s_sleep(1); \
    if ((++_sp & 255u) == 0u) { if (xb_ld(&(bar)[XB_TMO])) break; if (_sp > XB_SPIN_CAP) { atomicAdd(&(bar)[XB_TMO], 1u); break; } } } } while (0)

struct XcdBarrier {
    unsigned* bar; unsigned x;
    volatile LAS unsigned* st;
};

__device__ __forceinline__ XcdBarrier xcd_barrier_post(unsigned* bar, volatile LAS unsigned* st) {
    XcdBarrier b; b.bar = bar; b.x = xb_xcc_id(); b.st = st;
    if (threadIdx.x == 0) (void)xb_add(&bar[XB_XCNT(b.x)], 1u);
    return b;
}
__device__ __forceinline__ void xcd_barrier_complete(unsigned* bar, unsigned x, unsigned& nloc, unsigned& nx) {
    const unsigned G = gridDim.x * gridDim.y * gridDim.z;
    unsigned sum, cnt, mine, sp = 0u;
    for (;;) {
        sum = 0u; cnt = 0u; mine = 0u;
#pragma unroll
        for (unsigned j = 0; j < 16; ++j) { const unsigned c = xb_ld(&bar[XB_XCNT(j)]); sum += c; cnt += (c > 0u) ? 1u : 0u; mine = (j == x) ? c : mine; }
        if (sum == G) break;
        __builtin_amdgcn_s_sleep(1);
        if ((++sp & 255u) == 0u) { if (xb_ld(&bar[XB_TMO])) break; if (sp > XB_SPIN_CAP) { atomicAdd(&bar[XB_TMO], 1u); break; } }
    }
    nloc = mine > 0u ? mine : 1u; nx = cnt > 0u ? cnt : 1u;
}

__device__ __forceinline__ void xcd_barrier(const XcdBarrier& b) {
    asm volatile("s_waitcnt vmcnt(0)" ::: "memory");
    __syncthreads();
    if (threadIdx.x == 0) {
        unsigned* bar = b.bar;
        __builtin_amdgcn_s_waitcnt(0);
        unsigned nloc = b.st[0], nx = b.st[1];
        if (nloc == 0u) { xcd_barrier_complete(bar, b.x, nloc, nx); b.st[0] = nloc; b.st[1] = nx; }
        const unsigned old = xb_add(&bar[XB_XSUB(b.x)], 1u);
        const unsigned gen = old / nloc;
        if (old + 1u == (gen + 1u) * nloc) {
            __builtin_amdgcn_fence(__ATOMIC_RELEASE, "agent");
            asm volatile("s_waitcnt vmcnt(0)" ::: "memory");
            const unsigned og = xb_add(&bar[XB_TOP], 1u);
            const unsigned tg = og / nx;
            if (og + 1u == (tg + 1u) * nx) xb_add(&bar[XB_TOPGEN], 1u);
            else XB_SPIN(xb_ld(&bar[XB_TOPGEN]) == tg, bar);
            __builtin_amdgcn_fence(__ATOMIC_ACQUIRE, "agent");
            xb_add(&bar[XB_XGEN(b.x)], 1u);
            asm volatile("s_waitcnt vmcnt(0)" ::: "memory");
        } else {
            XB_SPIN(xb_ld(&bar[XB_XGEN(b.x)]) == gen, bar);
            __builtin_amdgcn_fence(__ATOMIC_ACQUIRE, "agent");
            asm volatile("s_waitcnt vmcnt(0)" ::: "memory");
        }
    }
    __syncthreads();
}


__device__ __forceinline__ float qk_bound(const float* q_g, const float* k_g, int lane) {
    float gq = fabsf(q_g[lane]), gk = fabsf(k_g[lane]);
#pragma unroll
    for (int o = 1; o < 64; o <<= 1) { gq = fmaxf(gq, __shfl_xor(gq, o)); gk = fmaxf(gk, __shfl_xor(gk, o)); }
    return attn_body::C2 * 64.0f * 1.02f * gq * gk;
}
#ifndef GEMM1_WGM
#define GEMM1_WGM 16
#endif
constexpr float GAP_EXTRA = 38.0f;
struct Args { const float* in[13]; float* out; unsigned char* ws; };
struct ConvItems {
    LAS unsigned char* L;
    __device__ __forceinline__ void operator()(int item) const {
        const __attribute__((address_space(4))) Args* ap_ = (const __attribute__((address_space(4))) Args*)__builtin_amdgcn_kernarg_segment_ptr(); asm volatile("" : "+s"(ap_));
        unsigned char* ws = ap_->ws; const float* conv_w = ap_->in[9]; const float* w_a = ap_->in[10]; const float* w_b = ap_->in[11]; const float* w_o = ap_->in[12];
        const bf16* CUB = (const bf16*)(ws + WS_CU); const bf16* GZB = (const bf16*)(ws + WS_GZ); bf16* OAB = (bf16*)(ws + WS_OAB); bf16* WABT = (bf16*)(ws + WS_WAB); bf16* WOT = (bf16*)(ws + WS_WO);
        const int lane = threadIdx.x & 63, wave = __builtin_amdgcn_readfirstlane((int)threadIdx.x >> 6);
        if (item >= M / 128) {
            LAS float* scr = (LAS float*)(L + wave * 8704); int r = (item - M / 128) * 8 + wave;
            constexpr int I_A = (D / 32) * (AW / 64), I_B = (D / 32) * (CW / 64);
            if (r < I_A) p0_transpose_item<false>(w_a, D, D, WABT, scr, r, AW / 64, lane);
            else if (r < I_A + I_B) p0_transpose_item<false>(w_b, D, D, WABT + 512, scr, r - I_A, CW / 64, lane);
            else p0_transpose_item<false>(w_o, D, D, WOT, scr, r - I_A - I_B, D / 64, lane);
            return; }
        const int m0 = item * 128 + wave * 16; const int ch = 8 * lane;
        float w0[8], w1[8], w2[8];
#pragma unroll
        for (int e = 0; e < 8; ++e) { w0[e] = conv_w[ch + e]; w1[e] = conv_w[CW + ch + e]; w2[e] = conv_w[2 * CW + ch + e]; }
        float p1[8], p2[8];
        const bool first = (m0 % T) == 0;
        { v4u a = {0u, 0u, 0u, 0u}, bq = {0u, 0u, 0u, 0u};
          if (!first) { a = *(const v4u*)(CUB + (size_t)(m0 - 2) * CW + ch); bq = *(const v4u*)(CUB + (size_t)(m0 - 1) * CW + ch); }
#pragma unroll
          for (int e = 0; e < 4; ++e) { p2[2 * e] = pg8::bflo(a[e]); p2[2 * e + 1] = pg8::bfhi(a[e]); p1[2 * e] = pg8::bflo(bq[e]); p1[2 * e + 1] = pg8::bfhi(bq[e]); } }
#pragma unroll 4
        for (int r = 0; r < 16; ++r) { const int m = m0 + r;
            const v4u cv = *(const v4u*)(CUB + (size_t)m * CW + ch), gv = *(const v4u*)(GZB + (size_t)m * CW + ch);
            float cur[8], o[8];
#pragma unroll
            for (int e = 0; e < 4; ++e) { cur[2 * e] = pg8::bflo(cv[e]); cur[2 * e + 1] = pg8::bfhi(cv[e]); }
#pragma unroll
            for (int e = 0; e < 4; ++e) { o[2 * e] = pg8::bflo(gv[e]) * (w0[2 * e] * p2[2 * e] + w1[2 * e] * p1[2 * e] + w2[2 * e] * cur[2 * e]);
                o[2 * e + 1] = pg8::bfhi(gv[e]) * (w0[2 * e + 1] * p2[2 * e + 1] + w1[2 * e + 1] * p1[2 * e + 1] + w2[2 * e + 1] * cur[2 * e + 1]); }
            v4u ov; ov.x = pk2(o[0], o[1]); ov.y = pk2(o[2], o[3]); ov.z = pk2(o[4], o[5]); ov.w = pk2(o[6], o[7]);
            *(v4u*)(OAB + (size_t)m * 1024 + 512 + ch) = ov;
#pragma unroll
            for (int e = 0; e < 8; ++e) { p2[e] = p1[e]; p1[e] = cur[e]; }
        }
    }
};
constexpr int N_CONV_ITEMS = M / 128 + ((D / 32) * (AW / 64) + (D / 32) * (CW / 64) + (D / 32) * (D / 64)) / 8;

template <int LO, int HI> __global__ void __launch_bounds__(NWAVES * 64, 2) fox_fwd(Args args) {
    extern __shared__ __attribute__((aligned(16))) unsigned char lds[];
    LAS unsigned char* L = (LAS unsigned char*)lds;
    if (threadIdx.x < 2) ((volatile LAS unsigned*)(L + MISC_OFF))[threadIdx.x] = 0u;
    if (HI - LO > 1 && threadIdx.x == 0) (void)xb_add(&((unsigned*)(args.ws + WS_CTL))[XB_XCNT(xb_xcc_id())], 1u);
    __syncthreads();
#define PHASE_IDS() int tid = threadIdx.x; asm volatile("" : "+v"(tid)); int bx = blockIdx.x; asm volatile("" : "+s"(bx)); int G = gridDim.x; asm volatile("" : "+s"(G)); \
    const int lane = tid & 63, wave = __builtin_amdgcn_readfirstlane(tid >> 6); const int vcu = (G % 8 == 0) ? (bx % 8) * (G / 8) + bx / 8 : bx; const int gw = vcu * NWAVES + wave, NGW = G * NWAVES; (void)lane; (void)gw; (void)NGW
#define PHASE_PTRS() const __attribute__((address_space(4))) Args* ap_ = (const __attribute__((address_space(4))) Args*)__builtin_amdgcn_kernarg_segment_ptr(); asm volatile("" : "+s"(ap_)); unsigned char* ws = ap_->ws; const float* x = ap_->in[0]; const float* c = ap_->in[1]; const float* w_ada = ap_->in[2]; const float* b_ada = ap_->in[3]; const float* norm_g = ap_->in[4]; const float* w_in = ap_->in[5]; const float* b_f = ap_->in[6]; const float* q_g = ap_->in[7]; const float* k_g = ap_->in[8]; const float* conv_w = ap_->in[9]; const float* w_a = ap_->in[10]; const float* w_b = ap_->in[11]; const float* w_o = ap_->in[12]; float* ADA = (float*)(ws + WS_ADA); float* WF = (float*)(ws + WS_WF); float* LF = (float*)(ws + WS_LF); bf16* W1T = (bf16*)(ws + WS_W1); bf16* WABT = (bf16*)(ws + WS_WAB); bf16* WOT = (bf16*)(ws + WS_WO); bf16* HB = (bf16*)(ws + WS_HB); bf16* OAB = (bf16*)(ws + WS_OAB); bf16* QB = (bf16*)(ws + WS_Q); bf16* KB = (bf16*)(ws + WS_K); bf16* VB = (bf16*)(ws + WS_V); bf16* MG = (bf16*)(ws + WS_MG); bf16* SZA = (bf16*)(ws + WS_SZA); bf16* CUB = (bf16*)(ws + WS_CU); bf16* GZB = (bf16*)(ws + WS_GZ); bf16* RB = (bf16*)(ws + WS_R); bf16* SGB = (bf16*)(ws + WS_SGB);
#ifndef REPEAT_PHASE
#define REPEAT_PHASE -1
#endif
#define REPS(k) (REPEAT_PHASE == (k) ? 2 : 1)
#ifndef PHMASK
#define PHMASK 63
#endif
#define IN(k) ((((PHMASK) >> (k)) & 1) && LO <= (k) && (k) < HI)
#define BOTH(k) (IN(k) && IN((k) + 1))
#ifndef BAR_REPS
#define BAR_REPS 1
#endif
#define XBAR() for (int br_ = 0; br_ < BAR_REPS; ++br_) do { const __attribute__((address_space(4))) Args* bp_ = (const __attribute__((address_space(4))) Args*)__builtin_amdgcn_kernarg_segment_ptr(); asm volatile("" : "+s"(bp_)); XcdBarrier b_; b_.bar = (unsigned*)(bp_->ws + WS_CTL); b_.x = xb_xcc_id(); b_.st = (volatile LAS unsigned*)(L + MISC_OFF); xcd_barrier(b_); } while (0)

    for (int rep_ = 0; rep_ < REPS(0); ++rep_) if (IN(0)) {
        PHASE_PTRS(); PHASE_IDS();
        if (bx < 192) {
            LAS float* ct = (LAS float*)L;
            LAS float* red = (LAS float*)(L + 32768);
            for (int i = tid; i < 8192; i += NWAVES * 64) { const int b = i >> 10, k = i & 1023; ct[k * 8 + b] = c[i]; }
            __syncthreads();
            const int col = bx * 16 + (lane & 15), kpar = lane >> 4;
            float acc[8];
#pragma unroll
            for (int b = 0; b < 8; ++b) acc[b] = 0.f;
#pragma unroll 8
            for (int kk = 0; kk < 32; ++kk) { const int k = wave * 128 + 4 * kk + kpar; const float wv = w_ada[(size_t)k * 3072 + col];
                const f32x4 c0 = *(const LAS f32x4*)(ct + k * 8), c1 = *(const LAS f32x4*)(ct + k * 8 + 4);
                acc[0] += c0[0] * wv; acc[1] += c0[1] * wv; acc[2] += c0[2] * wv; acc[3] += c0[3] * wv; acc[4] += c1[0] * wv; acc[5] += c1[1] * wv; acc[6] += c1[2] * wv; acc[7] += c1[3] * wv; }
#pragma unroll
            for (int b = 0; b < 8; ++b) { acc[b] += __shfl_xor(acc[b], 16); acc[b] += __shfl_xor(acc[b], 32); if (lane < 16) red[(wave * 8 + b) * 16 + lane] = acc[b]; }
            __syncthreads();
            if (tid < 128) { const int b = tid >> 4, cl = tid & 15; float s = b_ada[bx * 16 + cl];
#pragma unroll
                for (int w = 0; w < 8; ++w) s += red[(w * 8 + b) * 16 + cl];
                ADA[b * 3072 + bx * 16 + cl] = s; }
            __syncthreads();
        }
        {
            const int i = bx * NWAVES * 64 + tid; if (i < 8192) { const int j = i >> 10, k = i & 1023; WF[i] = w_in[(size_t)k * INW + SRC_F + j]; }
        }
        if (bx >= 192) {
            LAS float* scr = (LAS float*)(L + wave * 8704); const int w2 = (bx - 192) * NWAVES + wave;
            p0_transpose_item<true>(w_in, D, INW, W1T, scr, 2048 + w2, D / 64, lane);
            p0_transpose_item<true>(w_in, D, INW, W1T, scr, 2048 + 512 + w2, D / 64, lane);
        }
        if (BOTH(0)) XBAR();
    }

    for (int rep_ = 0; rep_ < REPS(1); ++rep_) if (IN(1)) {
        PHASE_PTRS(); PHASE_IDS();
#define P1COL(j) (8 * lane + 512 * ((j) >> 1) + 4 * ((j) & 1))
        LAS float* wf = (LAS float*)L;
        for (int i = tid; i < 2048; i += NWAVES * 64) ((LAS f32x4*)wf)[i] = ((const f32x4*)WF)[i];
        __syncthreads();
        const int m0 = gw * 16, b = m0 / T;
        f32x4 gm[4], sh[4];
#pragma unroll
        for (int j = 0; j < 4; ++j) { const int col = P1COL(j); const f32x4 g = *(const f32x4*)(norm_g + col), scl = *(const f32x4*)(ADA + b * 3072 + 1024 + col);
            gm[j] = g * (scl + 1.0f); sh[j] = *(const f32x4*)(ADA + b * 3072 + col); }
        for (int r = 0; r < 16; ++r) { const int m = m0 + r; if (m >= M) break;
            const GAS float* xr = (const GAS float*)(x + (size_t)m * D);
            f32x4 v[4]; float s2 = 0.f;
#pragma unroll
            for (int j = 0; j < 4; ++j) { v[j] = *(const GAS f32x4*)(xr + P1COL(j)); s2 += (v[j][0] * v[j][0] + v[j][1] * v[j][1]) + (v[j][2] * v[j][2] + v[j][3] * v[j][3]); }
            const float rstd = 1.0f / sqrtf(wave_sum(s2) * (1.0f / D) + EPS);
#pragma unroll
            for (int j = 0; j < 4; ++j) v[j] = v[j] * rstd * gm[j] + sh[j];
#pragma unroll
            for (int j = 0; j < 2; ++j) { v4u o; o.x = pk2(v[2 * j][0], v[2 * j][1]); o.y = pk2(v[2 * j][2], v[2 * j][3]); o.z = pk2(v[2 * j + 1][0], v[2 * j + 1][1]); o.w = pk2(v[2 * j + 1][2], v[2 * j + 1][3]);
                *(GAS v4u*)(HB + (size_t)m * D + 8 * lane + 512 * j) = o; }
            float fl[8];
#pragma unroll
            for (int q = 0; q < 8; ++q) { float a = 0.f;
#pragma unroll
                for (int j = 0; j < 4; ++j) { const f32x4 w = *(const LAS f32x4*)(wf + q * 1024 + P1COL(j)); a += (v[j][0] * w[0] + v[j][1] * w[1]) + (v[j][2] * w[2] + v[j][3] * w[3]); }
                fl[q] = wave_sum(a); }
            float mine = fl[0];
#pragma unroll
            for (int q = 1; q < 8; ++q) mine = (lane == q) ? fl[q] : mine;
            if (lane < 8) { const float z = mine + b_f[lane]; const float ls = fminf(z, 0.f) - log1pf(__expf(-fabsf(z)));
                LF[(size_t)(b * 8 + lane) * T + (m - b * T)] = ls; }
        }
        {
            LAS float* scr = (LAS float*)(L + 32768 + wave * 8704);
            constexpr int I_1 = (NPROJ / 32) * (D / 64), I_A = (D / 32) * (AW / 64), I_B = (D / 32) * (CW / 64), I_O = (D / 32) * (D / 64);
            (void)I_A; (void)I_B; (void)I_O;
            static_assert(I_1 == 3072, "P0 converts items [2048, 3072) on its 64 GEMV-free workgroups");
            for (int it = gw; it < 2048; it += NGW) p0_transpose_item<true>(w_in, D, INW, W1T, scr, it, D / 64, lane);
        }
        __syncthreads();
        if (BOTH(1)) XBAR();
    }

    for (int rep_ = 0; rep_ < REPS(2); ++rep_) if (IN(2)) {
        PHASE_PTRS(); PHASE_IDS();
        if (bx < BATCH * H) {
            attn_body::bias_scan((char*)lds, LF + (size_t)bx * T, (float*)(ws + WS_BIAS) + (size_t)bx * T);
            attn_body::j0_table((const char*)lds, 2.0f * qk_bound(q_g, k_g, lane) + GAP_EXTRA, (int*)(ws + WS_J0) + bx * 16, wave, lane);
            __syncthreads(); }
        pg8::Gemm g{HB, W1T, M, NPROJ, D}; pg8::StaticOrder S; S.init(M, NPROJ, G, bx, GEMM1_WGM);
        pg8::EpiProj E{ws, q_g, k_g, attn_body::C2, EPS};
        pg8::gemm_phase<pg8::EpiProj, pg8::StaticOrder, PG8_ALIGN, PG8_SP2>(L + RING_OFF, g, S, E);
        if (BOTH(2)) XBAR();
    }

    for (int rep_ = 0; rep_ < REPS(3); ++rep_) if (IN(3)) {
        PHASE_PTRS(); PHASE_IDS();
        const float qkb = qk_bound(q_g, k_g, lane);
        const attn_body::AttnTensors AT{ws, WS_Q, WS_K, WS_V, WS_SZA, WS_LF, WS_OAB, WS_BIAS, WS_J0, 2.0f * qkb + GAP_EXTRA, qkb};
        const ConvItems CI{L};
        attn_body::attn_phase_dyn<-1, ConvItems>((char*)lds + RING_OFF, AT, (unsigned*)(ws + WS_CTL) + CW_ATTNQ, CI, N_CONV_ITEMS);
        if (BOTH(3)) XBAR();
    }

    for (int rep_ = 0; rep_ < REPS(4); ++rep_) if (IN(4)) {
        PHASE_PTRS(); PHASE_IDS();
        pg8::Gemm g{OAB, WABT, M, D, D}; pg8::StaticOrder S; S.init(M, D, G, bx);
        pg8::EpiMerge E{(const unsigned short*)RB, MG};
        pg8::gemm_phase<pg8::EpiMerge, pg8::StaticOrder, PG8_ALIGN, PG8_SP2>(L + RING_OFF, g, S, E);
        if (BOTH(4)) XBAR();
    }

    for (int rep_ = 0; rep_ < REPS(5); ++rep_) if (IN(5)) {
        PHASE_PTRS(); PHASE_IDS();
        pg8::Gemm g{MG, WOT, M, D, D}; pg8::StaticOrder S; S.init(M, D, G, bx);
        pg8::EpiOut E{x, ADA + 2048, ap_->out};
        pg8::gemm_phase<pg8::EpiOut, pg8::StaticOrder, PG8_ALIGN, PG8_SP2>(L + RING_OFF, g, S, E);
    }
#undef IN
#undef BOTH
}

extern "C" void kernel_launch(void* const* d_in, const int* in_sizes, int n_in, void* d_out, int out_size, void* d_ws, size_t ws_size, hipStream_t stream) {
    static int grid = 0;
    if (grid == 0) {
        if (n_in != 13 || in_sizes[0] != M * D || out_size != M * D || ws_size < WS_END) { fprintf(stderr, "kernel_launch: shape/workspace mismatch (n_in %d, in0 %d, out %d, ws %zu); nothing launched\n", n_in, n_in > 0 ? in_sizes[0] : -1, out_size, ws_size); grid = -1; return; }
        int dev = 0, cus = 0, per_cu = 0;
        if (hipGetDevice(&dev) != hipSuccess || hipDeviceGetAttribute(&cus, hipDeviceAttributeMultiprocessorCount, dev) != hipSuccess) { fprintf(stderr, "kernel_launch: device query failed\n"); grid = -1; return; }
        bool ok = true;
#if MK_N_LAUNCHES == 1
        const void* kfull = (const void*)fox_fwd<0, PER_PHASE>;
        ok = hipFuncSetAttribute(kfull, hipFuncAttributeMaxDynamicSharedMemorySize, LDS_BYTES) == hipSuccess;
#else
        const void* kph[PER_PHASE] = {(const void*)fox_fwd<0, 1>, (const void*)fox_fwd<1, 2>, (const void*)fox_fwd<2, 3>, (const void*)fox_fwd<3, 4>, (const void*)fox_fwd<4, 5>, (const void*)fox_fwd<5, 6>};
        const void* kfull = kph[3];
        for (int i = 0; i < PER_PHASE; ++i) ok = ok && hipFuncSetAttribute(kph[i], hipFuncAttributeMaxDynamicSharedMemorySize, LDS_BYTES) == hipSuccess;
#endif
        if (!ok) { fprintf(stderr, "kernel_launch: hipFuncSetAttribute failed\n"); grid = -1; return; }
        if (hipOccupancyMaxActiveBlocksPerMultiprocessor(&per_cu, kfull, NWAVES * 64, LDS_BYTES) != hipSuccess || per_cu < 1) { fprintf(stderr, "kernel_launch: occupancy query reports %d workgroups per CU\n", per_cu); (void)hipGetLastError(); grid = -1; return; }
        grid = cus;
        if (grid != 256) { fprintf(stderr, "kernel_launch: built for a 256-CU device (got %d CUs); nothing launched\n", cus); grid = -1; return; }
    }
    if (grid < 0) return;
    if (hipMemsetAsync((char*)d_ws + WS_CTL, 0, (XCD_BAR_WORDS + 256) * 4, stream) != hipSuccess) { fprintf(stderr, "kernel_launch: hipMemsetAsync failed\n"); return; }
    Args a{};
    for (int i = 0; i < 13; ++i) a.in[i] = (const float*)d_in[i];
    a.out = (float*)d_out; a.ws = (unsigned char*)d_ws;
#if MK_N_LAUNCHES == 1
    {
        void* kargs[] = {&a};
        const hipError_t e = hipLaunchCooperativeKernel((const void*)fox_fwd<0, PER_PHASE>, dim3(grid), dim3(NWAVES * 64), kargs, LDS_BYTES, stream);
        if (e != hipSuccess) fprintf(stderr, "kernel_launch: cooperative launch failed: %s (grid %d)\n", hipGetErrorString(e), grid);
    }
#else
    {
        hipLaunchKernelGGL((fox_fwd<0, 1>), dim3(grid), dim3(NWAVES * 64), LDS_BYTES, stream, a);
        hipLaunchKernelGGL((fox_fwd<1, 2>), dim3(grid), dim3(NWAVES * 64), LDS_BYTES, stream, a);
        hipLaunchKernelGGL((fox_fwd<2, 3>), dim3(grid), dim3(NWAVES * 64), LDS_BYTES, stream, a);
        hipLaunchKernelGGL((fox_fwd<3, 4>), dim3(grid), dim3(NWAVES * 64), LDS_BYTES, stream, a);
        hipLaunchKernelGGL((fox_fwd<4, 5>), dim3(grid), dim3(NWAVES * 64), LDS_BYTES, stream, a);
        hipLaunchKernelGGL((fox_fwd<5, 6>), dim3(grid), dim3(NWAVES * 64), LDS_BYTES, stream, a);
        const hipError_t le = hipPeekAtLastError();
        if (le != hipSuccess) fprintf(stderr, "kernel_launch: a phase launch failed: %s\n", hipGetErrorName(le));
    }
#endif
}
```

```cpp
#include <hip/hip_runtime.h>
#include <cstdio>
#include <cstdint>
namespace pg8 {
#define PG8_LAS __attribute__((address_space(3)))
typedef unsigned short bf16_t;
typedef short bf16x8 __attribute__((ext_vector_type(8)));
typedef float f32x4 __attribute__((ext_vector_type(4)));
typedef unsigned u32x4 __attribute__((ext_vector_type(4)));
constexpr int BM = 256, BK = 64, HALF = 128, HTB = HALF * BK * 2  , STAGE_BYTES = 8 * HTB, NXCD = 8, WGM = 8;

__host__ __device__ __forceinline__ int lds_byte(int r, int c) { const int st = (r >> 4) * 2 + (c >> 5), rr = r & 15, cc = c & 31, ob = rr * 64 + cc * 2; return st * 1024 + (ob ^ (((ob >> 9) & 1) << 5)); }
__host__ __device__ __forceinline__ void stage_rc(int b, int& R, int& C) { const int st = b / 1024, sb = b % 1024, swz = sb ^ (((sb >> 9) & 1) << 5); R = (st >> 1) * 16 + swz / 64; C = (st & 1) * 32 + (swz % 64) / 2; }
__host__ __device__ __forceinline__ int perm32(int rho) { const int n = rho >> 4, i = rho & 15; return 8 * (i >> 2) + 4 * n + (i & 3); }

struct Unit { int pm, pn; };
struct Gemm { const bf16_t* A; const bf16_t* Bt; int M, N, K; };

struct StaticOrder {
    int nM, nN, nwg, G, c, wgm;
    __host__ __device__ void init(int M, int N, int G_, int c_, int wgm_ = WGM) { nM = M / BM; nN = N / BM; nwg = nM * nN; G = G_; c = c_; wgm = wgm_; }
    __host__ __device__ bool next(int i, Unit& u) const {
        const long L = (long)i * G + c; if (L >= nwg) return false;
        int wgid = (int)L; { const int q = nwg / NXCD, r = nwg % NXCD, xcd = wgid % NXCD, off = wgid / NXCD; wgid = (xcd < r ? xcd * (q + 1) : r * (q + 1) + (xcd - r) * q) + off; }
        const int nig = wgm * nN, gid = wgid / nig, fm = gid * wgm, gsz = (nM - fm) < wgm ? (nM - fm) : wgm;
        u.pm = fm + ((wgid % nig) % gsz); u.pn = (wgid % nig) / gsz; return true;
    }
    __device__ __forceinline__ void a_ready(const Unit&) const {}
    __device__ __forceinline__ void done(const Unit&) const {}
};

__device__ __forceinline__ unsigned cvt_pk_bf16(float lo, float hi) { unsigned r; asm volatile("v_cvt_pk_bf16_f32 %0, %1, %2" : "=v"(r) : "v"(lo), "v"(hi)); return r; }
typedef float f32x2 __attribute__((ext_vector_type(2)));
__device__ __forceinline__ float sigm(float x) { return __builtin_amdgcn_rcpf(1.0f + __builtin_amdgcn_exp2f(x * -1.4426950408889634f)); }
__device__ __forceinline__ float silu(float x) { return x * sigm(x); }
__device__ __forceinline__ float bflo(unsigned w) { return __builtin_bit_cast(float, w << 16); }
__device__ __forceinline__ float bfhi(unsigned w) { return __builtin_bit_cast(float, w & 0xffff0000u); }
typedef unsigned u32x2 __attribute__((ext_vector_type(2)));

constexpr size_t OFF_Q = 96u << 20, OFF_K = 128u << 20, OFF_V = 160u << 20, OFF_SZA = 192u << 20, OFF_CU = 224u << 20, OFF_GZ = 256u << 20, OFF_SGA = 320u << 20, OFF_SGB = 384u << 20;
struct EpiProj {
    static constexpr bool PERM = true, AFTER_DRAIN = false, MID = false;
    unsigned char* ws; const float *qg, *kg; float qscale, eps;
    __device__ __forceinline__ void operator()(const f32x4 (&acc)[2][2][4][2], const Unit& u, int wr, int wc, int fr, int fq) const {
        const int pn = u.pn; const size_t row0 = (size_t)u.pm * BM + wr * 64 + fr;
        if (pn < 4) {
            const bool isq = pn < 2; const float* g = isq ? qg : kg; bf16_t* dst = (bf16_t*)(ws + (isq ? OFF_Q : OFF_K)); const float sc = isq ? qscale : 1.0f;
            const int colb = (pn & 1) * 256 + 64 * wc + 8 * fq;
            f32x4 gv[2][2];
#pragma unroll
            for (int bj = 0; bj < 2; ++bj)
#pragma unroll
                for (int n = 0; n < 2; ++n) gv[bj][n] = *(const f32x4*)(g + 32 * bj + 8 * fq + 4 * n) * sc;
#pragma unroll
            for (int ai = 0; ai < 2; ++ai)
#pragma unroll
                for (int m = 0; m < 4; ++m) {
                    float ss = 0.f;
#pragma unroll
                    for (int bj = 0; bj < 2; ++bj)
#pragma unroll
                        for (int n = 0; n < 2; ++n) { const f32x4 x = acc[ai][bj][m][n]; ss += (x[0] * x[0] + x[1] * x[1]) + (x[2] * x[2] + x[3] * x[3]); }
                    ss += __shfl_xor(ss, 16); ss += __shfl_xor(ss, 32);
                    const float rstd = __builtin_amdgcn_rsqf(ss * (1.0f / 64.0f) + eps);
                    bf16_t* rowp = dst + (row0 + ai * HALF + m * 16) * 512 + colb;
#pragma unroll
                    for (int bj = 0; bj < 2; ++bj) { const f32x4 v0 = acc[ai][bj][m][0] * rstd * gv[bj][0], v1 = acc[ai][bj][m][1] * rstd * gv[bj][1];
                        u32x4 w; w.x = cvt_pk_bf16(v0[0], v0[1]); w.y = cvt_pk_bf16(v0[2], v0[3]); w.z = cvt_pk_bf16(v1[0], v1[1]); w.w = cvt_pk_bf16(v1[2], v1[3]);
                        *(u32x4*)(rowp + 32 * bj) = w; }
                }
        } else if (pn >= 8 && pn < 16) {
            const int col = 64 * (pn - 8) + 16 * wc + 8 * (fq >> 1); bf16_t* dstb = (bf16_t*)(ws + ((fq & 1) ? OFF_GZ : OFF_CU));
#pragma unroll
            for (int ai = 0; ai < 2; ++ai)
#pragma unroll
                for (int m = 0; m < 4; ++m) { const size_t off = (row0 + ai * HALF + m * 16) * 512 + col;
                    const f32x4 gb = acc[ai][0][m][0], gc = acc[ai][0][m][1], uu = acc[ai][1][m][0], zb = acc[ai][1][m][1];
                    const f32x4 cu = gc * uu; f32x4 gz; gz[0] = gb[0] * silu(zb[0]); gz[1] = gb[1] * silu(zb[1]); gz[2] = gb[2] * silu(zb[2]); gz[3] = gb[3] * silu(zb[3]);
                    u32x2 a, b; a.x = cvt_pk_bf16(cu[0], cu[1]); a.y = cvt_pk_bf16(cu[2], cu[3]); b.x = cvt_pk_bf16(gz[0], gz[1]); b.y = cvt_pk_bf16(gz[2], gz[3]);
                    const auto rx = __builtin_amdgcn_permlane16_swap(a.x, b.x, false, false), ry = __builtin_amdgcn_permlane16_swap(a.y, b.y, false, false);
                    u32x4 w; w.x = rx[0]; w.y = ry[0]; w.z = rx[1]; w.w = ry[1];
                    *(u32x4*)(dstb + off) = w; }
        } else if (pn >= 16) {
            const int col = 128 * (pn - 16) + 32 * wc + 8 * fq; unsigned short* AB = (unsigned short*)(ws + OFF_SGA);
#pragma unroll
            for (int ai = 0; ai < 2; ++ai)
#pragma unroll
                for (int m = 0; m < 4; ++m) { const size_t off = (row0 + ai * HALF + m * 16) * 1024 + col;
                    unsigned wd[4];
#pragma unroll
                    for (int n = 0; n < 2; ++n)
#pragma unroll
                        for (int h = 0; h < 2; ++h) { unsigned d = 0u;
#pragma unroll
                            for (int e = 0; e < 2; ++e) { const int i = 2 * h + e; const unsigned ta = (unsigned)(sigm(acc[ai][0][m][n][i]) * 255.0f + 0.5f); unsigned tb = (unsigned)(sigm(acc[ai][1][m][n][i]) * 255.0f + 0.5f); tb = tb < 1u ? 1u : tb;
                                d |= (ta | (tb << 8)) << (16 * e); }
                            wd[2 * n + h] = d; }
                    *(u32x4*)(AB + off) = (u32x4){wd[0], wd[1], wd[2], wd[3]};
                    asm volatile("" ::: "memory"); }
        } else {
            size_t doff; int ld, tcol, act;
            if (pn < 6) { doff = OFF_V; ld = 512; tcol = (pn - 4) * 256; act = 0; }
            else { doff = OFF_SZA; ld = 512; tcol = (pn - 6) * 256; act = 1; }
            bf16_t* dst = (bf16_t*)(ws + doff);
            const int colb = tcol + 64 * wc + 8 * fq;
#pragma unroll
            for (int ai = 0; ai < 2; ++ai)
#pragma unroll
                for (int m = 0; m < 4; ++m) { bf16_t* rowp = dst + (row0 + ai * HALF + m * 16) * ld + colb;
#pragma unroll
                    for (int bj = 0; bj < 2; ++bj) { f32x4 v0 = acc[ai][bj][m][0], v1 = acc[ai][bj][m][1];
                        if (act == 1) { v0[0] = silu(v0[0]); v0[1] = silu(v0[1]); v0[2] = silu(v0[2]); v0[3] = silu(v0[3]); v1[0] = silu(v1[0]); v1[1] = silu(v1[1]); v1[2] = silu(v1[2]); v1[3] = silu(v1[3]); }
                        u32x4 w; w.x = cvt_pk_bf16(v0[0], v0[1]); w.y = cvt_pk_bf16(v0[2], v0[3]); w.z = cvt_pk_bf16(v1[0], v1[1]); w.w = cvt_pk_bf16(v1[2], v1[3]);
                        *(u32x4*)(rowp + 32 * bj) = w; } }
        }
    }
};
__host__ __device__ __forceinline__ int proj_src_col(int p) {
    const int pn = p >> 8, r = p & 255, bj = r >> 7, wc = (r >> 5) & 3, jj = r & 31;
    if (pn >= 8 && pn < 16) { const int fq = jj >> 3, n = (jj >> 2) & 1, i = jj & 3; const int sect = bj == 0 ? (n == 0 ? 2056 : 2568) : (n == 0 ? 3080 : 3592); return sect + 64 * (pn - 8) + 16 * wc + 4 * fq + i; }
    if (pn >= 16) return (bj == 0 ? 4104 : 5128) + 128 * (pn - 16) + 32 * wc + jj;
    const int nat = 64 * wc + 32 * bj + jj;
    if (pn < 6) return 256 * pn + nat;
    return 1544 + 256 * (pn - 6) + nat;
}

struct EpiMerge {
    static constexpr bool PERM = true, AFTER_DRAIN = false, MID = true;
    const unsigned short* AB; bf16_t* MG;
    static __device__ __forceinline__ float ub(unsigned w, int k) { return (float)((w >> (8 * k)) & 0xffu); }
    __device__ __forceinline__ void mid(f32x4 (&acc)[2][2][4][2], const Unit& u, int wr, int wc, int fr, int fq) const {
        unsigned off0 = (unsigned)((u.pm * BM + wr * 64 + fr) * 1024 + u.pn * BM + wc * 32 + 8 * fq);
        asm volatile("" : "+v"(off0));
#pragma unroll
        for (int ai = 0; ai < 2; ++ai)
#pragma unroll
            for (int m = 0; m < 4; ++m) { const unsigned off = off0 + (unsigned)((ai * HALF + m * 16) * 1024);
#pragma unroll
                for (int bj = 0; bj < 2; ++bj) { const u32x4 g = *(const u32x4*)(AB + (off + bj * HALF));
                    acc[ai][bj][m][0] *= (f32x4){ub(g.x, 0) * __builtin_amdgcn_rcpf(ub(g.x, 1)), ub(g.x, 2) * __builtin_amdgcn_rcpf(ub(g.x, 3)), ub(g.y, 0) * __builtin_amdgcn_rcpf(ub(g.y, 1)), ub(g.y, 2) * __builtin_amdgcn_rcpf(ub(g.y, 3))};
                    acc[ai][bj][m][1] *= (f32x4){ub(g.z, 0) * __builtin_amdgcn_rcpf(ub(g.z, 1)), ub(g.z, 2) * __builtin_amdgcn_rcpf(ub(g.z, 3)), ub(g.w, 0) * __builtin_amdgcn_rcpf(ub(g.w, 1)), ub(g.w, 2) * __builtin_amdgcn_rcpf(ub(g.w, 3))}; } }
    }
    __device__ __forceinline__ void operator()(const f32x4 (&acc)[2][2][4][2], const Unit& u, int wr, int wc, int fr, int fq) const {
        unsigned off0 = (unsigned)((u.pm * BM + wr * 64 + fr) * 1024 + u.pn * BM + wc * 32 + 8 * fq); const float s = 1.0f / 255.0f;
        asm volatile("" : "+v"(off0));
#pragma unroll
        for (int ai = 0; ai < 2; ++ai)
#pragma unroll
            for (int m = 0; m < 4; ++m) { const unsigned off = off0 + (unsigned)((ai * HALF + m * 16) * 1024);
#pragma unroll
                for (int bj = 0; bj < 2; ++bj) { const u32x4 g = *(const u32x4*)(AB + (off + bj * HALF)); const f32x4 v0 = acc[ai][bj][m][0] * s, v1 = acc[ai][bj][m][1] * s;
                    u32x4 w; w.x = cvt_pk_bf16(v0[0] * ub(g.x, 1), v0[1] * ub(g.x, 3)); w.y = cvt_pk_bf16(v0[2] * ub(g.y, 1), v0[3] * ub(g.y, 3));
                    w.z = cvt_pk_bf16(v1[0] * ub(g.z, 1), v1[1] * ub(g.z, 3)); w.w = cvt_pk_bf16(v1[2] * ub(g.w, 1), v1[3] * ub(g.w, 3));
                    *(u32x4*)((unsigned char*)MG + 2u * (off + bj * HALF)) = w; } }
    }
};
struct EpiOut {
    static constexpr bool PERM = false, AFTER_DRAIN = false, MID = false;
    const float* x; const float* gate; float* out;
    __device__ __forceinline__ void operator()(const f32x4 (&acc)[2][2][4][2], const Unit& u, int wr, int wc, int fr, int fq) const {
        const size_t row0 = (size_t)u.pm * BM + wr * 64 + fr; const int col0 = u.pn * BM + wc * 32 + 4 * fq; const float* gp = gate + (size_t)(u.pm >> 4) * 3072 + col0;
        f32x4 gv[2][2];
#pragma unroll
        for (int bj = 0; bj < 2; ++bj)
#pragma unroll
            for (int n = 0; n < 2; ++n) gv[bj][n] = *(const f32x4*)(gp + bj * HALF + n * 16);
#pragma unroll
        for (int ai = 0; ai < 2; ++ai) {
            f32x4 xv[4][2][2];
#pragma unroll
            for (int m = 0; m < 4; ++m) { const size_t off = (row0 + ai * HALF + m * 16) * 1024 + col0;
#pragma unroll
                for (int bj = 0; bj < 2; ++bj)
#pragma unroll
                    for (int n = 0; n < 2; ++n) xv[m][bj][n] = *(const f32x4*)(x + off + bj * HALF + n * 16); }
            asm volatile("" ::: "memory");
#pragma unroll
            for (int m = 0; m < 4; ++m) { const size_t off = (row0 + ai * HALF + m * 16) * 1024 + col0;
#pragma unroll
                for (int bj = 0; bj < 2; ++bj)
#pragma unroll
                    for (int n = 0; n < 2; ++n) *(f32x4*)(out + off + bj * HALF + n * 16) = xv[m][bj][n] + gv[bj][n] * acc[ai][bj][m][n]; }
            asm volatile("" ::: "memory"); }
    }
};

template <class Epi, class Sched, bool ALIGN_EPI = false, bool SP2 = false>
__device__ __forceinline__ void gemm_phase(PG8_LAS unsigned char* lds, const Gemm g, const Sched& S, const Epi& E) {
    int tid_ = threadIdx.x; asm volatile("" : "+v"(tid_));
    const int tid = tid_, wid = __builtin_amdgcn_readfirstlane(tid >> 6), lane = tid & 63, wr = wid >> 2, wc = wid & 3, fr = lane & 15, fq = lane >> 4;
    const int K = g.K, nt = K / BK;
    unsigned voffA[2], voffB[2];
#pragma unroll
    for (int i = 0; i < 2; ++i) { int R, C; stage_rc(tid * 16 + i * 8192, R, C); const int Rb = Epi::PERM ? ((R & ~31) + perm32(R & 31)) : R;
        voffA[i] = (unsigned)(R * K + C) * 2u; voffB[i] = (unsigned)(Rb * K + C) * 2u; }
    const size_t kstep = (size_t)(BK * 2);
    const size_t hstep = (size_t)HALF * K * 2;
    const size_t tstep = 2 * hstep;
    const unsigned ldsw = (unsigned)wid * 1024u;
    const int aoff = lds_byte(wr * 64 + fr, fq * 8), boff = lds_byte(wc * 32 + fr, fq * 8);
#define PG8_SA(b, h) (((b) * 2 + (h)) * HTB)
#define PG8_SB(b, h) ((4 + (b) * 2 + (h)) * HTB)
#define PG8_STAGE(bufoff, gbase, voff) do { _Pragma("unroll") for (int _i = 0; _i < 2; ++_i) \
        __builtin_amdgcn_global_load_lds((const unsigned*)((const char*)(gbase) + (voff)[_i]), (PG8_LAS unsigned*)(lds + (bufoff) + ldsw + _i * 8192), 16, 0, 0); } while (0)
#define PG8_LDA(dst, b, h) do { _Pragma("unroll") for (int m = 0; m < 4; ++m) _Pragma("unroll") for (int k = 0; k < 2; ++k) dst[m][k] = *(const PG8_LAS bf16x8*)(lds + PG8_SA(b, h) + aoff + m * 2048 + k * 1024); } while (0)
#define PG8_LDB(dst, b, h) do { _Pragma("unroll") for (int n = 0; n < 2; ++n) _Pragma("unroll") for (int k = 0; k < 2; ++k) dst[n][k] = *(const PG8_LAS bf16x8*)(lds + PG8_SB(b, h) + boff + n * 2048 + k * 1024); } while (0)
#define PG8_MMA(ai, bj, At, Bt) do { __builtin_amdgcn_s_setprio(1); _Pragma("unroll") for (int m = 0; m < 4; ++m) _Pragma("unroll") for (int n = 0; n < 2; ++n) _Pragma("unroll") for (int k = 0; k < 2; ++k) \
        acc[ai][bj][m][n] = __builtin_amdgcn_mfma_f32_16x16x32_bf16(Bt[n][k], At[m][k], acc[ai][bj][m][n], 0, 0, 0); __builtin_amdgcn_s_setprio(0); } while (0)
#define PG8_WAIT_V(n) asm volatile("s_waitcnt vmcnt(" #n ")" ::: "memory")
#define PG8_WAIT_L(n) asm volatile("s_waitcnt lgkmcnt(" #n ")" ::: "memory")
#define PG8_BAR __builtin_amdgcn_s_barrier()
#define PG8_SCHED __builtin_amdgcn_sched_barrier(0)
    Unit cur, nxt; int ui = 0;
    if (!S.next(0, cur)) return;
    f32x4 acc[2][2][4][2];
#pragma unroll
    for (int a = 0; a < 2; ++a)
#pragma unroll
        for (int b = 0; b < 2; ++b)
#pragma unroll
            for (int m = 0; m < 4; ++m)
#pragma unroll
                for (int n = 0; n < 2; ++n) acc[a][b][m][n] = (f32x4){0.f, 0.f, 0.f, 0.f};
    bf16x8 At[4][2], B0[2][2], B1[2][2];
    const char* cA = (const char*)g.A + (size_t)cur.pm * tstep; const char* cB = (const char*)g.Bt + (size_t)cur.pn * tstep;
    S.a_ready(cur);
    if constexpr (SP2) {
        PG8_STAGE(PG8_SB(0, 0), cB, voffB); PG8_STAGE(PG8_SB(0, 1), cB + hstep, voffB); PG8_STAGE(PG8_SA(0, 0), cA, voffA); PG8_STAGE(PG8_SA(0, 1), cA + hstep, voffA);
        if (wr == 1) PG8_BAR;
        PG8_WAIT_V(2); PG8_BAR;
        PG8_STAGE(PG8_SB(1, 0), cB + kstep, voffB); PG8_STAGE(PG8_SA(1, 0), cA + kstep, voffA); PG8_STAGE(PG8_SB(1, 1), cB + hstep + kstep, voffB);
        PG8_WAIT_V(6); PG8_BAR;
    } else {
        PG8_STAGE(PG8_SB(0, 0), cB, voffB); PG8_STAGE(PG8_SA(0, 0), cA, voffA); PG8_STAGE(PG8_SB(0, 1), cB + hstep, voffB); PG8_STAGE(PG8_SA(0, 1), cA + hstep, voffA);
        if (wr == 1) PG8_BAR;
        PG8_WAIT_V(4); PG8_BAR;
        PG8_STAGE(PG8_SB(1, 0), cB + kstep, voffB); PG8_STAGE(PG8_SA(1, 0), cA + kstep, voffA); PG8_STAGE(PG8_SB(1, 1), cB + hstep + kstep, voffB);
        PG8_WAIT_V(6); PG8_BAR;
    }
    for (;;) {
        const bool has_next = S.next(ui + 1, nxt);
        const char* nA = has_next ? (const char*)g.A + (size_t)nxt.pm * tstep : cA; const char* nB = has_next ? (const char*)g.Bt + (size_t)nxt.pn * tstep : cB;
        for (int t = 0; t < nt; t += 2) {
            if constexpr (Epi::MID) { if (t == nt / 2) E.mid(acc, cur, wr, wc, fr, fq); }
            const bool last = (t == nt - 2);
            const char* a1 = cA + (size_t)(t + 1) * kstep;
            const char* a2 = last ? nA : cA + (size_t)(t + 2) * kstep; const char* b2 = last ? nB : cB + (size_t)(t + 2) * kstep;
            const char* a3 = a2 + kstep; const char* b3 = b2 + kstep;
            if (last && has_next) S.a_ready(nxt);
            if constexpr (SP2) {
            PG8_LDB(B0, 0, 0); PG8_LDB(B1, 0, 1); PG8_SCHED; PG8_LDA(At, 0, 0); PG8_STAGE(PG8_SA(1, 1), a1 + hstep, voffA);
            PG8_WAIT_V(8); PG8_WAIT_L(0); PG8_BAR; PG8_MMA(0, 0, At, B0); PG8_MMA(0, 1, At, B1); PG8_BAR; PG8_SCHED;
            PG8_LDA(At, 0, 1); PG8_STAGE(PG8_SB(0, 0), b2, voffB); PG8_STAGE(PG8_SB(0, 1), b2 + hstep, voffB); PG8_STAGE(PG8_SA(0, 0), a2, voffA);
            PG8_WAIT_V(8); PG8_WAIT_L(0); PG8_BAR; PG8_MMA(1, 0, At, B0); PG8_MMA(1, 1, At, B1); PG8_BAR; PG8_SCHED;
            PG8_LDB(B0, 1, 0); PG8_LDB(B1, 1, 1); PG8_SCHED; PG8_LDA(At, 1, 0); PG8_STAGE(PG8_SA(0, 1), a2 + hstep, voffA);
            PG8_WAIT_V(8); PG8_WAIT_L(0); PG8_BAR; PG8_MMA(0, 0, At, B0); PG8_MMA(0, 1, At, B1); PG8_BAR; PG8_SCHED;
            PG8_LDA(At, 1, 1); PG8_STAGE(PG8_SB(1, 0), b3, voffB); PG8_STAGE(PG8_SB(1, 1), b3 + hstep, voffB); PG8_STAGE(PG8_SA(1, 0), a3, voffA);
            PG8_WAIT_V(8); PG8_WAIT_L(0); PG8_BAR; PG8_MMA(1, 0, At, B0); PG8_MMA(1, 1, At, B1); PG8_BAR; PG8_SCHED;
            } else {
            PG8_LDB(B0, 0, 0); PG8_SCHED; PG8_LDA(At, 0, 0); PG8_STAGE(PG8_SA(1, 1), a1 + hstep, voffA);
            PG8_WAIT_L(8); PG8_BAR; PG8_WAIT_L(0); PG8_MMA(0, 0, At, B0); PG8_BAR; PG8_SCHED;
            PG8_LDB(B1, 0, 1); PG8_STAGE(PG8_SB(0, 0), b2, voffB);
            PG8_BAR; PG8_WAIT_L(0); PG8_MMA(0, 1, At, B1); PG8_BAR;
            PG8_LDA(At, 0, 1); PG8_STAGE(PG8_SA(0, 0), a2, voffA);
            PG8_BAR; PG8_WAIT_L(0); PG8_MMA(1, 0, At, B0); PG8_BAR; PG8_SCHED;
            PG8_STAGE(PG8_SB(0, 1), b2 + hstep, voffB);
            PG8_WAIT_V(6); PG8_BAR; PG8_MMA(1, 1, At, B1); PG8_BAR;
            PG8_LDB(B0, 1, 0); PG8_SCHED; PG8_LDA(At, 1, 0); PG8_STAGE(PG8_SA(0, 1), a2 + hstep, voffA);
            PG8_WAIT_L(8); PG8_BAR; PG8_WAIT_L(0); PG8_MMA(0, 0, At, B0); PG8_BAR; PG8_SCHED;
            PG8_LDB(B1, 1, 1); PG8_STAGE(PG8_SB(1, 0), b3, voffB);
            PG8_BAR; PG8_WAIT_L(0); PG8_MMA(0, 1, At, B1); PG8_BAR;
            PG8_LDA(At, 1, 1); PG8_STAGE(PG8_SA(1, 0), a3, voffA);
            PG8_BAR; PG8_WAIT_L(0); PG8_MMA(1, 0, At, B0); PG8_BAR; PG8_SCHED;
            PG8_STAGE(PG8_SB(1, 1), b3 + hstep, voffB);
            PG8_WAIT_V(6); PG8_BAR; PG8_MMA(1, 1, At, B1); PG8_BAR;
            }
        }
        if constexpr (ALIGN_EPI) { if (wr == 0) PG8_BAR; }
        if constexpr (!Epi::AFTER_DRAIN) { E(acc, cur, wr, wc, fr, fq); S.done(cur); }
        if (!has_next) break;
#pragma unroll
        for (int a = 0; a < 2; ++a)
#pragma unroll
            for (int b = 0; b < 2; ++b)
#pragma unroll
                for (int m = 0; m < 4; ++m)
#pragma unroll
                    for (int n = 0; n < 2; ++n) acc[a][b][m][n] = (f32x4){0.f, 0.f, 0.f, 0.f};
        cur = nxt; cA = nA; cB = nB; ++ui;
        if constexpr (ALIGN_EPI) { if (wr == 1) PG8_BAR; }
    }
    PG8_WAIT_V(0);
    if constexpr (!ALIGN_EPI) { if (wr == 0) PG8_BAR; }
    PG8_BAR;
    if constexpr (Epi::AFTER_DRAIN) { E.fused(acc, cur, wr, wc, fr, fq, lds, wid, lane); S.done(cur); }
#undef PG8_SA
#undef PG8_SB
#undef PG8_STAGE
#undef PG8_LDA
#undef PG8_LDB
#undef PG8_MMA
#undef PG8_WAIT_V
#undef PG8_WAIT_L
#undef PG8_BAR
#undef PG8_SCHED
}
}

#ifndef PG8_SP2
#define PG8_SP2 true
#endif
#ifndef PG8_ALIGN
#define PG8_ALIGN true
#endif
#include <hip/hip_bf16.h>
#include <cmath>
namespace attn_body {
using bf16=__hip_bfloat16;
using bf16x8=__attribute__((ext_vector_type(8)))short;
using s16x4=__attribute__((ext_vector_type(4)))short;
using f32x16=__attribute__((ext_vector_type(16)))float;
using u32x4=__attribute__((ext_vector_type(4)))unsigned;
using f32x4v=__attribute__((ext_vector_type(4)))float;
constexpr int BATCH=8,NHEAD=8,SEQ=4096,D=64,DM=NHEAD*D;
constexpr int NW=8,QBLK=32,QB=QBLK*NW,KVBLK=64,NQB=SEQ/QB;
constexpr int ATTN_PITCH=DM, ATTN_UNIT_ROWS=QB, OPITCH=1024;
__device__ __forceinline__ int crow(int r,int hi){return (r&3)+8*(r>>2)+4*hi;}
#define SBAR() __builtin_amdgcn_sched_barrier(0)
__device__ __forceinline__ void cmask(f32x16&p0,f32x16&p1,int jb,int qrel,int hi){
  const float NEG=-INFINITY; int kb=64*jb+4*hi;
  #pragma unroll
  for(int r=0;r<16;++r){int kv=kb+(r&3)+8*(r>>2); if(kv>qrel)p0[r]=NEG; if(kv+32>qrel)p1[r]=NEG;}
}

constexpr int NSLOT=3, SLOTB=8192;
constexpr int LDS_K=0, LDS_V=NSLOT*SLOTB, LDS_WS=2*NSLOT*SLOTB, LDS_OST=LDS_WS+NW*64*4, LDS_BIAS=LDS_OST+NW*4096, LDS_BYTES=LDS_BIAS+SEQ*4;
constexpr float C2=0.125f*1.4426950408889634f;
__device__ __forceinline__ void glds16(const void*gsrc,unsigned lds_dst){unsigned keep;
  asm volatile("s_mov_b32 %0, m0\n\ts_mov_b32 m0, %2\n\ts_nop 0\n\tglobal_load_lds_dwordx4 %1, off\n\ts_mov_b32 m0, %0":"=&s"(keep):"v"(gsrc),"s"(lds_dst):"memory");}
__device__ __forceinline__ float max3f(float a,float b,float c){float r;asm("v_max3_f32 %0, %1, %2, %3":"=v"(r):"v"(a),"v"(b),"v"(c));return r;}
__device__ __forceinline__ float max2f(float a,float b){float r;asm("v_max_f32_e32 %0, %1, %2":"=v"(r):"v"(a),"v"(b));return r;}
__device__ __forceinline__ float fadd_s(float a,float b){float r;asm("v_add_f32_e32 %0, %1, %2":"=v"(r):"v"(a),"v"(b));return r;}
__device__ __forceinline__ float fsub_s(float a,float b){float r;asm("v_sub_f32_e32 %0, %1, %2":"=v"(r):"v"(a),"v"(b));return r;}
typedef float f32x2_t __attribute__((ext_vector_type(2))); typedef __bf16 bf16x2_t __attribute__((ext_vector_type(2)));
__device__ __forceinline__ unsigned cvtpk_s(float lo,float hi){f32x2_t v={lo,hi};bf16x2_t b=__builtin_convertvector(v,bf16x2_t);return __builtin_bit_cast(unsigned,b);}
#define WAIT_BAR(N) asm volatile("s_waitcnt vmcnt(" #N ") lgkmcnt(0)\n\ts_barrier":::"memory")

__device__ __forceinline__ void qkt(f32x16&p0,f32x16&p1,const char*Kslot,const bf16x8*qr,int r32,int hi){
  const char*kb=Kslot+hi*1024+r32*16;
  #pragma unroll
  for(int d0=0;d0<4;++d0){
    const bf16x8 b0=*reinterpret_cast<const bf16x8*>(kb+d0*2048);
    const bf16x8 b1=*reinterpret_cast<const bf16x8*>(kb+d0*2048+512);
    p0=__builtin_amdgcn_mfma_f32_32x32x16_bf16(b0,qr[d0],p0,0,0,0);p1=__builtin_amdgcn_mfma_f32_32x32x16_bf16(b1,qr[d0],p1,0,0,0);}
}
typedef __attribute__((address_space(3))) const char* lds_cptr;
typedef short v4i16_t __attribute__((ext_vector_type(4)));
__device__ __forceinline__ void kload8(bf16x8*kf,lds_cptr kp){
  kf[0]=*(const __attribute__((address_space(3))) bf16x8*)(kp);      kf[1]=*(const __attribute__((address_space(3))) bf16x8*)(kp+512);
  kf[2]=*(const __attribute__((address_space(3))) bf16x8*)(kp+2048); kf[3]=*(const __attribute__((address_space(3))) bf16x8*)(kp+2560);
  kf[4]=*(const __attribute__((address_space(3))) bf16x8*)(kp+4096); kf[5]=*(const __attribute__((address_space(3))) bf16x8*)(kp+4608);
  kf[6]=*(const __attribute__((address_space(3))) bf16x8*)(kp+6144); kf[7]=*(const __attribute__((address_space(3))) bf16x8*)(kp+6656);
}
__device__ __forceinline__ void kload2(bf16x8*kf,lds_cptr kp,int j){ kf[2*j]=*(const __attribute__((address_space(3))) bf16x8*)(kp+j*2048); kf[2*j+1]=*(const __attribute__((address_space(3))) bf16x8*)(kp+j*2048+512); }
__device__ __forceinline__ s16x4 vtr(lds_cptr p){ return __builtin_bit_cast(s16x4,__builtin_amdgcn_ds_read_tr16_b64_v4i16((__attribute__((address_space(3))) v4i16_t*)p)); }
__device__ __forceinline__ float rowmax(const f32x16&p0,const f32x16&p1){
  float a=max3f(p0[0],p0[1],p1[0]),b=max3f(p0[2],p0[3],p1[1]);a=max3f(a,p1[2],p1[3]);
  #pragma unroll
  for(int r=4;r<16;r+=4){a=max3f(a,p0[r],p0[r+1]);b=max3f(b,p0[r+2],p0[r+3]);a=max3f(a,p1[r],p1[r+1]);b=max3f(b,p1[r+2],p1[r+3]);}
  const float m=max2f(a,b);
  auto rr=__builtin_amdgcn_permlane32_swap(__float_as_uint(m),__float_as_uint(m),false,false);
  return max2f(__uint_as_float(rr[0]),__uint_as_float(rr[1]));
}
__device__ __forceinline__ void pv(f32x16*o,int vb,bf16x8 pa0,bf16x8 pa1,bf16x8 pa2,bf16x8 pa3){
  #pragma unroll
  for(int d0=0;d0<2;++d0){s16x4 lo[4],hi[4];
    #pragma unroll
    for(int ks=0;ks<4;++ks){
      asm volatile("ds_read_b64_tr_b16 %0,%1 offset:%c2":"=&v"(lo[ks]):"v"(vb),"i"(d0*4096+ks*1024):"memory");
      asm volatile("ds_read_b64_tr_b16 %0,%1 offset:%c2":"=&v"(hi[ks]):"v"(vb),"i"(d0*4096+ks*1024+512):"memory");}
    asm volatile("s_waitcnt lgkmcnt(0)":::"memory");SBAR();
    #define PK(k) (bf16x8){lo[k][0],lo[k][1],lo[k][2],lo[k][3],hi[k][0],hi[k][1],hi[k][2],hi[k][3]}
    o[d0]=__builtin_amdgcn_mfma_f32_32x32x16_bf16(pa0,PK(0),o[d0],0,0,0);
    o[d0]=__builtin_amdgcn_mfma_f32_32x32x16_bf16(pa1,PK(1),o[d0],0,0,0);
    o[d0]=__builtin_amdgcn_mfma_f32_32x32x16_bf16(pa2,PK(2),o[d0],0,0,0);
    o[d0]=__builtin_amdgcn_mfma_f32_32x32x16_bf16(pa3,PK(3),o[d0],0,0,0);
    #undef PK
  }
}

#ifndef ATTN_STORE16
#define ATTN_STORE16(p,v) (*(u32x4*)(p)=(v))
#endif
struct AttnTensors { unsigned char* ws; size_t oq,ok,ov,oz,olf,oo,obias,oj0; float gap,hdr; };
template<int THRL> __device__ __forceinline__ void attn_unit(int b,int h,int qb,int j0,f32x4v brow0,f32x4v brow1,unsigned*ctr,unsigned&nxt,const AttnTensors&T_,char*shm){
  const bf16*Q=(const bf16*)(T_.ws+T_.oq); const bf16*__restrict__ K=(const bf16*)(T_.ws+T_.ok); const bf16*__restrict__ V=(const bf16*)(T_.ws+T_.ov);
  const int tid=threadIdx.x,lane=tid&63,r32=lane&31,hi=lane>>5; const int wid=__builtin_amdgcn_readfirstlane(tid>>6);
  const long rowbase=(long)b*SEQ; const int q0=qb*QB;
  const bf16*Qw=Q+(rowbase+q0+wid*QBLK)*DM+h*D;
  const bf16*Kh=K+(rowbase+(long)j0*KVBLK)*DM+h*D,*Vh=V+(rowbase+(long)j0*KVBLK)*DM+h*D;
  const unsigned lds0=(unsigned)(uintptr_t)shm;
  float*wsf=(float*)(shm+LDS_WS)+wid*64;
  const bf16*ksrc=Kh+(long)lane*DM+wid*8;
  const bf16*vsrc=Vh+(long)(16*(wid&3)+(lane>>2))*DM+(wid>>2)*32+(lane&3)*8;
  const unsigned kdst=lds0+LDS_K+wid*1024, vdst=lds0+LDS_V+wid*1024;
  #define DMA_K(t,slot) glds16(ksrc+(long)(t)*KVBLK*DM,(unsigned)__builtin_amdgcn_readfirstlane(kdst+(slot)))
  #define DMA_V(t,slot) glds16(vsrc+(long)(t)*KVBLK*DM,(unsigned)__builtin_amdgcn_readfirstlane(vdst+(slot)))
  const int vb0=(int)(lds0+LDS_V)+((lane>>4)&1)*32+(lane&3)*8+(4*hi+((lane&15)>>2))*64;
  const char*Kbase=shm+LDS_K; bf16x8 kf[8];
  const lds_cptr shm3=(lds_cptr)shm; const lds_cptr kp0=shm3+LDS_K+hi*1024+r32*16; const lds_cptr vp0=shm3+LDS_V+((lane>>4)&1)*32+(lane&3)*8+(4*hi+((lane&15)>>2))*64;
  const int NT=(q0+QB)/KVBLK-j0;
  DMA_K(0,0);DMA_V(0,0);DMA_K(1,SLOTB);
  bf16x8 qr[4];
  #pragma unroll
  for(int d0=0;d0<4;++d0)qr[d0]=*reinterpret_cast<const bf16x8*>(&Qw[(long)r32*DM+d0*16+hi*8]);
  float mhat=0.f,l_reg=0.f;f32x16 o[2];o[0]=f32x16{};o[1]=f32x16{};
  const lds_cptr bp0=shm3+LDS_BIAS+hi*16+j0*256;
  #define BL(P,t,g,off) do{ const f32x4v a_=*(const __attribute__((address_space(3))) f32x4v*)(bp0+(t)*256+(off)+(g)*32); P[4*(g)]=a_[0];P[4*(g)+1]=a_[1];P[4*(g)+2]=a_[2];P[4*(g)+3]=a_[3]; }while(0)
  #define BS(P,g) do{ P[4*(g)]-=mhat;P[4*(g)+1]-=mhat;P[4*(g)+2]-=mhat;P[4*(g)+3]-=mhat; }while(0)
  #define BINIT(P0,P1,t) do{ _Pragma("unroll") for(int g_=0;g_<4;++g_){BL(P0,t,g_,0);BL(P1,t,g_,128);} _Pragma("unroll") for(int g_=0;g_<4;++g_){BS(P0,g_);BS(P1,g_);} }while(0)
  const int qrel=wid*QBLK+r32;
  #define CMASK(P0,P1,t) do{int jb_=(t)-(NT-4); if(jb_>=0)cmask(P0,P1,jb_,qrel,hi);}while(0)
  bool resc=false;
  #define START(P0,P1) do{ resc=false; \
    if(THRL>=0){ const float rm=rowmax(P0,P1); if(__builtin_expect(__any(rm>(float)THRL),0)){ const float dl=__builtin_fmaxf(rm,0.f); mhat=fadd_s(mhat,dl); \
      _Pragma("unroll") for(int r=0;r<16;++r){P0[r]=fsub_s(P0[r],dl);P1[r]=fsub_s(P1[r],dl);} } } \
    _Pragma("unroll") for(int r=0;r<16;++r)P0[r]=__builtin_amdgcn_exp2f(P0[r]); }while(0)
  #define RESC() do{ if(resc){ asm volatile("s_waitcnt lgkmcnt(0)":::"memory"); \
      _Pragma("unroll") for(int d_=0;d_<2;++d_) _Pragma("unroll") for(int r=0;r<16;++r)o[d_][r]*=wsf[crow(r,hi)]; } }while(0)
  f32x16 pA0,pA1,pB0,pB1;
  int sl_prev=0,sl_cur=0,sl_next=SLOTB;
  #define ROT() do{sl_prev=sl_cur;sl_cur=sl_next;sl_next=(sl_next==(NSLOT-1)*SLOTB)?0:sl_next+SLOTB;}while(0)
  DMA_K(2,2*SLOTB);
  { __attribute__((address_space(3))) f32x4v*bd=(__attribute__((address_space(3))) f32x4v*)((__attribute__((address_space(3))) char*)shm+LDS_BIAS)+tid*2; bd[0]=brow0; bd[1]=brow1; }
  if(tid==0)nxt=gridDim.x+__hip_atomic_fetch_add(ctr,1u,__ATOMIC_RELAXED,__HIP_MEMORY_SCOPE_AGENT);
  WAIT_BAR(3);
  mhat=((const __attribute__((address_space(3))) float*)(shm3+LDS_BIAS))[q0+qrel]+T_.hdr;
  BINIT(pA0,pA1,0);
  qkt(pA0,pA1,Kbase,qr,r32,hi);asm volatile("s_nop 15\n\ts_nop 7":"+v"(pA0),"+v"(pA1));CMASK(pA0,pA1,0);
  START(pA0,pA1);
  BINIT(pB0,pB1,1);
  _Pragma("unroll") for(int r=0;r<16;++r)pA1[r]=__builtin_amdgcn_exp2f(pA1[r]);
  WAIT_BAR(0);
  DMA_K(3,0);DMA_V(1,SLOTB);
  ROT();
  kload8(kf,kp0+sl_cur);
  WAIT_BAR(2);
  s16x4 vlo[8],vhi[8]; u32x4 pw0,pw1,pw2,pw3;
  #define PKW(P,B) cvtpk_s(P[B],P[B+1])
  #define PAF(k) __builtin_bit_cast(bf16x8,pw##k)
  #define VFR(i) (bf16x8){vlo[i][0],vlo[i][1],vlo[i][2],vlo[i][3],vhi[i][0],vhi[i][1],vhi[i][2],vhi[i][3]}
  #define PIN(x) asm volatile("":"+v"(x))
  #define MX3(a,b,c) __builtin_fmaxf(__builtin_fmaxf((a),(b)),(c))
  #define GAPA(MF,A0,A1,A2,A3,W0,W1,PW) do{ MF; sacc+=A0; sacc+=A1; sacc+=A2; sacc+=A3; PIN(sacc); W0; W1; PIN(PW); SBAR(); }while(0)
  #define EX(v) __builtin_amdgcn_exp2f(v)
  #define GAPB(MF,X,B,E0,E1) do{ MF; X[B]=EX(X[B]); X[B+1]=EX(X[B+1]); X[B+2]=EX(X[B+2]); X[B+3]=EX(X[B+3]); PIN(X); E0; E1; SBAR(); }while(0)
  #define BLG(G,P,t,g,off) do{ if(G){ BL(P,t,g,off); } }while(0)
  #define BSG(G,P,g) do{ if(G){ BS(P,g); } }while(0)
  #define VRD(i) do{ vlo[i]=vtr(vp_+(((i)>>2)*4096+((i)&3)*1024)); vhi[i]=vtr(vp_+(((i)>>2)*4096+((i)&3)*1024+512)); }while(0)
  #define KRD(G,j) do{ if(G){ kload2(kf,kp0+sl_next,j); SBAR(); } }while(0)
  #define STEP(C0,C1,P0,P1,t,GK,GV,GL) do{ SBAR(); \
    const lds_cptr vp_=vp0+sl_prev; \
    VRD(0); SBAR(); float sacc=(P0[0]+P0[1]); \
    GAPA(C0=__builtin_amdgcn_mfma_f32_32x32x16_bf16(kf[0],qr[0],C0,0,0,0), P0[2],P0[3],P0[4],P0[5],     pw0[0]=PKW(P0,0), pw0[1]=PKW(P0,2), pw0); \
    VRD(4); SBAR(); GAPA(C1=__builtin_amdgcn_mfma_f32_32x32x16_bf16(kf[1],qr[0],C1,0,0,0), P0[6],P0[7],P0[8],P0[9],     pw0[2]=PKW(P0,4), pw0[3]=PKW(P0,6), pw0); \
    VRD(1); SBAR(); GAPA(C0=__builtin_amdgcn_mfma_f32_32x32x16_bf16(kf[2],qr[1],C0,0,0,0),   P0[10],P0[11],P0[12],P0[13], pw1[0]=PKW(P0,8), pw1[1]=PKW(P0,10), pw1); \
    VRD(5); SBAR(); GAPA(C1=__builtin_amdgcn_mfma_f32_32x32x16_bf16(kf[3],qr[1],C1,0,0,0),   P0[14],P0[15],P1[0],P1[1],   pw1[2]=PKW(P0,12),pw1[3]=PKW(P0,14), pw1); \
    VRD(2); SBAR(); GAPA(C0=__builtin_amdgcn_mfma_f32_32x32x16_bf16(kf[4],qr[2],C0,0,0,0),   P1[2],P1[3],P1[4],P1[5],     pw2[0]=PKW(P1,0), pw2[1]=PKW(P1,2), pw2); \
    VRD(6); SBAR(); GAPA(C1=__builtin_amdgcn_mfma_f32_32x32x16_bf16(kf[5],qr[2],C1,0,0,0),   P1[6],P1[7],P1[8],P1[9],     pw2[2]=PKW(P1,4), pw2[3]=PKW(P1,6), pw2); \
    VRD(3); SBAR(); GAPA(C0=__builtin_amdgcn_mfma_f32_32x32x16_bf16(kf[6],qr[3],C0,0,0,0),   P1[10],P1[11],P1[12],P1[13], pw3[0]=PKW(P1,8), pw3[1]=PKW(P1,10), pw3); \
    VRD(7); SBAR(); GAPA(C1=__builtin_amdgcn_mfma_f32_32x32x16_bf16(kf[7],qr[3],C1,0,0,0),   P1[14],P1[15],0.f,0.f,       pw3[2]=PKW(P1,12),pw3[3]=PKW(P1,14), pw3); \
    l_reg+=sacc; \
    if(GK){DMA_K((t)+3,sl_cur);} if(GV){DMA_V((t)+1,sl_next);} \
    CMASK(C0,C1,t); \
    if(THRL>=0){ float a=MX3(C0[0],C0[1],C1[0]),b=MX3(C0[2],C0[3],C1[1]); a=MX3(a,C1[2],C1[3]); \
      _Pragma("unroll") for(int r=4;r<16;r+=4){a=MX3(a,C0[r],C0[r+1]);b=MX3(b,C0[r+2],C0[r+3]);a=MX3(a,C1[r],C1[r+1]);b=MX3(b,C1[r+2],C1[r+3]);} \
      float rm=__builtin_fmaxf(a,b); { auto rr=__builtin_amdgcn_permlane32_swap(__float_as_uint(rm),__float_as_uint(rm),false,false); rm=__builtin_fmaxf(__uint_as_float(rr[0]),__uint_as_float(rr[1])); } \
      resc=false; \
      if(__builtin_expect(__any(rm>(float)THRL),0)){ const float dl=__builtin_fmaxf(rm,0.f); mhat+=dl; \
        _Pragma("unroll") for(int r=0;r<16;++r){C0[r]-=dl;C1[r]-=dl;} \
        const float f=__builtin_amdgcn_exp2f(-dl); l_reg*=f; if(hi==0)wsf[r32]=f; resc=true; } } \
    SBAR(); \
    GAPB(o[0]=__builtin_amdgcn_mfma_f32_32x32x16_bf16(PAF(0),VFR(0),o[0],0,0,0), C0,0,  BLG(GL,P0,(t)+1,0,0),  BLG(GL,P0,(t)+1,1,0)); \
    GAPB(o[1]=__builtin_amdgcn_mfma_f32_32x32x16_bf16(PAF(0),VFR(4),o[1],0,0,0), C0,4,  BLG(GL,P0,(t)+1,2,0),  BLG(GL,P0,(t)+1,3,0)); \
    KRD(GL,0); GAPB(o[0]=__builtin_amdgcn_mfma_f32_32x32x16_bf16(PAF(1),VFR(1),o[0],0,0,0), C0,8,  BLG(GL,P1,(t)+1,0,128), BLG(GL,P1,(t)+1,1,128)); \
    KRD(GL,1); GAPB(o[1]=__builtin_amdgcn_mfma_f32_32x32x16_bf16(PAF(1),VFR(5),o[1],0,0,0), C0,12, BLG(GL,P1,(t)+1,2,128), BLG(GL,P1,(t)+1,3,128)); \
    KRD(GL,2); GAPB(o[0]=__builtin_amdgcn_mfma_f32_32x32x16_bf16(PAF(2),VFR(2),o[0],0,0,0), C1,0,  BSG(GL,P0,0), BSG(GL,P0,1)); \
    KRD(GL,3); GAPB(o[1]=__builtin_amdgcn_mfma_f32_32x32x16_bf16(PAF(2),VFR(6),o[1],0,0,0), C1,4,  BSG(GL,P0,2), BSG(GL,P0,3)); \
    GAPB(o[0]=__builtin_amdgcn_mfma_f32_32x32x16_bf16(PAF(3),VFR(3),o[0],0,0,0), C1,8,  BSG(GL,P1,0), BSG(GL,P1,1)); \
    GAPB(o[1]=__builtin_amdgcn_mfma_f32_32x32x16_bf16(PAF(3),VFR(7),o[1],0,0,0), C1,12, BSG(GL,P1,2), BSG(GL,P1,3)); \
    }while(0)
  int t=1;
  #undef CMASK
  #define CMASK(P0,P1,t) do{}while(0)
  for(;t+5<NT;t+=2){
    STEP(pB0,pB1,pA0,pA1,t,true,true,true);     WAIT_BAR(2); RESC(); ROT();
    STEP(pA0,pA1,pB0,pB1,t+1,true,true,true);   WAIT_BAR(2); RESC(); ROT();
  }
  #undef CMASK
  #define CMASK(P0,P1,t) do{int jb_=(t)-(NT-4); if(jb_>=0)cmask(P0,P1,jb_,qrel,hi);}while(0)
  #define ENDW(tt) do{ if((tt)+3<NT){WAIT_BAR(2);} else if((tt)+2<NT){WAIT_BAR(1);} else {WAIT_BAR(0);} }while(0)
  for(;t+1<NT;t+=2){
    STEP(pB0,pB1,pA0,pA1,t,(t+3<NT),(t+1<NT),(t+1<NT));       ENDW(t);   RESC(); ROT();
    STEP(pA0,pA1,pB0,pB1,t+1,(t+4<NT),(t+2<NT),(t+2<NT));     ENDW(t+1); RESC(); ROT();
  }
  STEP(pB0,pB1,pA0,pA1,NT-1,false,false,false); RESC();
  const bf16*Zw=(const bf16*)(T_.ws+T_.oz)+(rowbase+q0+wid*QBLK)*DM+h*D;
  u32x4 zv[4];
  #pragma unroll
  for(int i=0;i<4;++i)zv[i]=*(const u32x4*)(Zw+(long)(i*8+(lane>>3))*DM+(lane&7)*8);
  { float sacc=pB0[0]+pB0[1]; _Pragma("unroll") for(int r=2;r<16;++r)sacc+=pB0[r]; _Pragma("unroll") for(int r=0;r<16;++r)sacc+=pB1[r]; l_reg+=sacc;
    pw0=(u32x4){PKW(pB0,0),PKW(pB0,2),PKW(pB0,4),PKW(pB0,6)};pw1=(u32x4){PKW(pB0,8),PKW(pB0,10),PKW(pB0,12),PKW(pB0,14)};pw2=(u32x4){PKW(pB1,0),PKW(pB1,2),PKW(pB1,4),PKW(pB1,6)};pw3=(u32x4){PKW(pB1,8),PKW(pB1,10),PKW(pB1,12),PKW(pB1,14)};
    SBAR(); pv(o,vb0+sl_cur,PAF(0),PAF(1),PAF(2),PAF(3)); }
  #undef PKW
  #undef PAF
  #undef VFR
  #undef PIN
  #undef MX3
  #undef GAPA
  #undef GAPB
  #undef EX
  #undef VRD
  #undef KRD
  #undef STEP
  #undef ENDW
  {auto rr=__builtin_amdgcn_permlane32_swap(__float_as_uint(l_reg),__float_as_uint(l_reg),false,false);l_reg=__uint_as_float(rr[0])+__uint_as_float(rr[1]);}
  if(hi==0)wsf[32+r32]=l_reg;asm volatile("s_waitcnt lgkmcnt(0)":::"memory");
  float rli[16];
  #pragma unroll
  for(int r=0;r<16;++r)rli[r]=__builtin_amdgcn_rcpf(wsf[32+crow(r,hi)]);
  bf16*Ow=(bf16*)(T_.ws+T_.oo)+(rowbase+q0+wid*QBLK)*OPITCH+h*D;
  { bf16*stg=(bf16*)(shm+LDS_OST)+wid*2048;
    #pragma unroll
    for(int r=0;r<16;++r){const int orow=crow(r,hi);
      #pragma unroll
      for(int d0=0;d0<2;++d0)stg[orow*64+d0*32+r32]=__float2bfloat16(o[d0][r]*rli[r]);}
    asm volatile("s_waitcnt lgkmcnt(0)":::"memory");
    #pragma unroll
    for(int i=0;i<4;++i){const int row=i*8+(lane>>3),ch=lane&7; u32x4 v=*(const u32x4*)(stg+row*64+ch*8);
      #pragma unroll
      for(int e=0;e<4;++e){ const float a0=__uint_as_float(v[e]<<16)*__uint_as_float(zv[i][e]<<16), a1=__uint_as_float(v[e]&0xffff0000u)*__uint_as_float(zv[i][e]&0xffff0000u); v[e]=cvtpk_s(a0,a1); }
      ATTN_STORE16(Ow+(long)row*OPITCH+ch*8,v);} }
  asm volatile("s_waitcnt lgkmcnt(0)\n\ts_barrier":::"memory");
  #undef DMA_K
  #undef DMA_V
  #undef CMASK
  #undef START
  #undef RESC
  #undef ROT
  #undef BL
  #undef BS
  #undef BINIT
  #undef BLG
  #undef BSG
}
constexpr int ATTN_LDS_BYTES=LDS_BYTES;
struct AttnUnit { int bh; int qb; };
__device__ __forceinline__ void bias_scan(char*shm,const float*__restrict__ lf,float*gdst=nullptr){
  const int tid=threadIdx.x,lane=tid&63,wid=tid>>6;
  float*bias=(float*)(shm+LDS_BIAS); float*wtot=(float*)(shm+LDS_WS);
  const f32x4v a=*(const f32x4v*)(lf+tid*8),b=*(const f32x4v*)(lf+tid*8+4);
  const float s0=a[0],s1=s0+a[1],s2=s1+a[2],s3=s2+a[3],s4=s3+b[0],s5=s4+b[1],s6=s5+b[2],s7=s6+b[3];
  float inc=s7;
  #pragma unroll
  for(int o=1;o<64;o<<=1){const float t=__shfl_up(inc,o); if(lane>=o)inc+=t;}
  if(lane==63)wtot[wid]=inc;
  asm volatile("s_waitcnt lgkmcnt(0)\n\ts_barrier":::"memory");
  float base=0.f;
  #pragma unroll
  for(int w=0;w<NW;++w){const float x=wtot[w]; if(w<wid)base+=x;}
  const float off=base+inc-s7; const float NL=-1.4426950408889634f;
  *(f32x4v*)(bias+tid*8)=(f32x4v){(off+s0)*NL,(off+s1)*NL,(off+s2)*NL,(off+s3)*NL};
  *(f32x4v*)(bias+tid*8+4)=(f32x4v){(off+s4)*NL,(off+s5)*NL,(off+s6)*NL,(off+s7)*NL};
  if(gdst){ *(f32x4v*)(gdst+tid*8)=(f32x4v){(off+s0)*NL,(off+s1)*NL,(off+s2)*NL,(off+s3)*NL}; *(f32x4v*)(gdst+tid*8+4)=(f32x4v){(off+s4)*NL,(off+s5)*NL,(off+s6)*NL,(off+s7)*NL}; }
  asm volatile("s_waitcnt lgkmcnt(0)\n\ts_barrier":::"memory");
}
__device__ __forceinline__ void j0_table(const char*shm,float gap,int*dst,int wave,int lane){
  const __attribute__((address_space(3))) float*bl=(const __attribute__((address_space(3))) float*)((const __attribute__((address_space(3))) char*)shm+LDS_BIAS);
  const float v=bl[64*lane+63];
  #pragma unroll
  for(int q=0;q<2;++q){ const int qb=2*wave+q; const float thr=bl[QB*qb]-gap; const unsigned long long mk=__ballot(v>=thr);
    int j0=mk?(int)__builtin_ctzll(mk):0; j0&=~1; const int jmax=4*qb; j0=j0<jmax?j0:jmax; if(lane==0)dst[qb]=j0; }
}
constexpr int LDS_J0=LDS_BIAS+SEQ*4;
static_assert(LDS_J0+4096<=131072,"attention LDS");
template<int THRL,class Extra> __device__ __forceinline__ void attn_phase_dyn(char*lds,const AttnTensors&T,unsigned*ctr,const Extra&X,int nextra){
  const int tid=threadIdx.x;
  volatile __attribute__((address_space(3))) unsigned* uw=(volatile __attribute__((address_space(3))) unsigned*)((__attribute__((address_space(3))) char*)lds+LDS_WS);
  volatile __attribute__((address_space(3))) int* jt=(volatile __attribute__((address_space(3))) int*)((__attribute__((address_space(3))) char*)lds+LDS_J0);
  for(int i=tid;i<BATCH*NHEAD*NQB;i+=NW*64)jt[i]=((const int*)(T.ws+T.oj0))[i];
  const unsigned G_=gridDim.x; unsigned nxt=blockIdx.x;
  for(;;){
    if(tid==0){uw[0]=nxt;}
    asm volatile("s_waitcnt lgkmcnt(0)\n\ts_barrier":::"memory");
    const unsigned u=(unsigned)__builtin_amdgcn_readfirstlane((int)uw[0]);
    if(u>=(unsigned)(BATCH*NHEAD*NQB+nextra))break;
    if(u>=(unsigned)(BATCH*NHEAD*NQB)){ if(tid==0)nxt=G_+__hip_atomic_fetch_add(ctr,1u,__ATOMIC_RELAXED,__HIP_MEMORY_SCOPE_AGENT);
      X((int)u-BATCH*NHEAD*NQB); asm volatile("s_waitcnt lgkmcnt(0)\n\ts_barrier":::"memory"); continue; }
    const int qb=NQB-1-(int)(u/(BATCH*NHEAD)), bh=(int)(u%(BATCH*NHEAD));
    const int j0=__builtin_amdgcn_readfirstlane((int)jt[bh*NQB+qb]);
    const f32x4v*src=(const f32x4v*)((const float*)(T.ws+T.obias)+(long)bh*SEQ)+tid*2; const f32x4v ba=src[0],bb=src[1];
    attn_unit<THRL>(bh/NHEAD,bh%NHEAD,qb,j0,ba,bb,ctr,nxt,T,lds);
  }
}
#undef SBAR
#undef WAIT_BAR
}
constexpr int NWAVES = 8;
#ifndef MK_N_LAUNCHES
#define MK_N_LAUNCHES 1
#endif
constexpr int N_LAUNCHES = MK_N_LAUNCHES;
constexpr int PER_PHASE = 6;

constexpr int BATCH = 8, T = 4096, D = 1024, H = 8, HD = 64, AW = 512, CW = 512, INW = 6152, NPROJ = 6144;
constexpr int M = BATCH * T;
constexpr float EPS = 1e-6f;
constexpr int SRC_F = 1536;

constexpr size_t MiB = 1u << 20;
constexpr size_t WS_ADA = 0;
constexpr size_t WS_WF = 128 * 1024;
constexpr size_t WS_CTL = 256 * 1024;
constexpr int CW_ATTNQ = 3456 + 128;
constexpr size_t WS_LF = 1 * MiB;
constexpr size_t WS_W1 = 2 * MiB;
constexpr size_t WS_WAB = 14 * MiB, WS_WO = 16 * MiB;
constexpr size_t WS_HB = 32 * MiB;
constexpr size_t WS_OAB = WS_HB;
constexpr size_t WS_Q = pg8::OFF_Q;
constexpr size_t WS_K = pg8::OFF_K, WS_V = pg8::OFF_V;
constexpr size_t WS_MG = WS_K;
constexpr size_t WS_SZA = pg8::OFF_SZA, WS_CU = pg8::OFF_CU, WS_GZ = pg8::OFF_GZ;
constexpr size_t WS_R = pg8::OFF_SGA, WS_SGB = pg8::OFF_SGB;
constexpr size_t WS_BIAS = 448 * MiB;
constexpr size_t WS_J0 = 449 * MiB;
constexpr size_t WS_END = 450 * MiB;

constexpr int RING_OFF = 0, RING_BYTES = 131072;
constexpr int MISC_OFF = RING_BYTES + 320;
constexpr int LDS_BYTES = 147456;
static_assert(attn_body::ATTN_LDS_BYTES <= RING_BYTES, "attention LDS");

#define GAS __attribute__((address_space(1)))
#define LAS __attribute__((address_space(3)))
typedef unsigned short bf16;
typedef unsigned v4u __attribute__((ext_vector_type(4)));
typedef float f32x4 __attribute__((ext_vector_type(4)));
#define LDS_WAIT() asm volatile("s_waitcnt lgkmcnt(0)" ::: "memory")
__device__ __forceinline__ unsigned pk2(float lo, float hi) { return pg8::cvt_pk_bf16(lo, hi); }
__device__ __forceinline__ float wave_sum(float v) {
#pragma unroll
    for (int o = 1; o < 64; o <<= 1) v += __shfl_xor(v, o);
    return v;
}

template <bool MAP> __device__ __forceinline__ void p0_transpose_item(const float* W, int K, int NS, bf16* WT, LAS float* scr, int item, int nkb, int lane) {
    const int pb = item / nkb, kb = item % nkb, k0 = 64 * kb, p0 = 32 * pb;
    const int sc = MAP ? pg8::proj_src_col(p0 + (lane & 31)) : p0 + (lane & 31);
#pragma unroll 8
    for (int i = 0; i < 32; ++i) { const int kk = 2 * i + (lane >> 5); scr[kk * 33 + (lane & 31)] = W[(size_t)(k0 + kk) * NS + sc]; }
    LDS_WAIT(); asm volatile("" ::: "memory");
    const int c = lane & 7;
#pragma unroll
    for (int j = 0; j < 4; ++j) { const int n = (lane >> 3) + 8 * j; const LAS float* s = scr + (8 * c) * 33 + n;
        v4u o; o.x = pk2(s[0 * 33], s[1 * 33]); o.y = pk2(s[2 * 33], s[3 * 33]); o.z = pk2(s[4 * 33], s[5 * 33]); o.w = pk2(s[6 * 33], s[7 * 33]);
        *(GAS v4u*)(WT + (size_t)(p0 + n) * K + k0 + 8 * c) = o; }
    LDS_WAIT(); asm volatile("" ::: "memory");
}

#define XB_TMO      128
#define XB_XCNT(j)  (256  + 64 * (j))
#define XB_XSUB(j)  (1280 + 64 * (j))
#define XB_XGEN(j)  (2304 + 64 * (j))
#define XB_TOP      3328
#define XB_TOPGEN   3392
#define XCD_BAR_WORDS 3456
#define XB_SPIN_CAP (1u << 18)

__device__ __forceinline__ unsigned xb_ld(unsigned* p)              { return __hip_atomic_load(p, __ATOMIC_RELAXED, __HIP_MEMORY_SCOPE_AGENT); }
__device__ __forceinline__ unsigned xb_add(unsigned* p, unsigned v) { return __hip_atomic_fetch_add(p, v, __ATOMIC_RELAXED, __HIP_MEMORY_SCOPE_AGENT); }
__device__ __forceinline__ unsigned xb_xcc_id() { return (unsigned)__builtin_amdgcn_s_getreg((3 << 11) | 20) & 0xFu; }
#define XB_SPIN(cond, bar) do { unsigned _sp = 0; while (cond) { __builtin_amdgcn_s_sleep(1); \
    if ((++_sp & 255u) == 0u) { if (xb_ld(&(bar)[XB_TMO])) break; if (_sp > XB_SPIN_CAP) { atomicAdd(&(bar)[XB_TMO], 1u); break; } } } } while (0)

struct XcdBarrier {
    unsigned* bar; unsigned x;
    volatile LAS unsigned* st;
};

__device__ __forceinline__ XcdBarrier xcd_barrier_post(unsigned* bar, volatile LAS unsigned* st) {
    XcdBarrier b; b.bar = bar; b.x = xb_xcc_id(); b.st = st;
    if (threadIdx.x == 0) (void)xb_add(&bar[XB_XCNT(b.x)], 1u);
    return b;
}
__device__ __forceinline__ void xcd_barrier_complete(unsigned* bar, unsigned x, unsigned& nloc, unsigned& nx) {
    const unsigned G = gridDim.x * gridDim.y * gridDim.z;
    unsigned sum, cnt, mine, sp = 0u;
    for (;;) {
        sum = 0u; cnt = 0u; mine = 0u;
#pragma unroll
        for (unsigned j = 0; j < 16; ++j) { const unsigned c = xb_ld(&bar[XB_XCNT(j)]); sum += c; cnt += (c > 0u) ? 1u : 0u; mine = (j == x) ? c : mine; }
        if (sum == G) break;
        __builtin_amdgcn_s_sleep(1);
        if ((++sp & 255u) == 0u) { if (xb_ld(&bar[XB_TMO])) break; if (sp > XB_SPIN_CAP) { atomicAdd(&bar[XB_TMO], 1u); break; } }
    }
    nloc = mine > 0u ? mine : 1u; nx = cnt > 0u ? cnt : 1u;
}

__device__ __forceinline__ void xcd_barrier(const XcdBarrier& b) {
    asm volatile("s_waitcnt vmcnt(0)" ::: "memory");
    __syncthreads();
    if (threadIdx.x == 0) {
        unsigned* bar = b.bar;
        __builtin_amdgcn_s_waitcnt(0);
        unsigned nloc = b.st[0], nx = b.st[1];
        if (nloc == 0u) { xcd_barrier_complete(bar, b.x, nloc, nx); b.st[0] = nloc; b.st[1] = nx; }
        const unsigned old = xb_add(&bar[XB_XSUB(b.x)], 1u);
        const unsigned gen = old / nloc;
        if (old + 1u == (gen + 1u) * nloc) {
            __builtin_amdgcn_fence(__ATOMIC_RELEASE, "agent");
            asm volatile("s_waitcnt vmcnt(0)" ::: "memory");
            const unsigned og = xb_add(&bar[XB_TOP], 1u);
            const unsigned tg = og / nx;
            if (og + 1u == (tg + 1u) * nx) xb_add(&bar[XB_TOPGEN], 1u);
            else XB_SPIN(xb_ld(&bar[XB_TOPGEN]) == tg, bar);
            __builtin_amdgcn_fence(__ATOMIC_ACQUIRE, "agent");
            xb_add(&bar[XB_XGEN(b.x)], 1u);
            asm volatile("s_waitcnt vmcnt(0)" ::: "memory");
        } else {
            XB_SPIN(xb_ld(&bar[XB_XGEN(b.x)]) == gen, bar);
            __builtin_amdgcn_fence(__ATOMIC_ACQUIRE, "agent");
            asm volatile("s_waitcnt vmcnt(0)" ::: "memory");
        }
    }
    __syncthreads();
}


__device__ __forceinline__ float qk_bound(const float* q_g, const float* k_g, int lane) {
    float gq = fabsf(q_g[lane]), gk = fabsf(k_g[lane]);
#pragma unroll
    for (int o = 1; o < 64; o <<= 1) { gq = fmaxf(gq, __shfl_xor(gq, o)); gk = fmaxf(gk, __shfl_xor(gk, o)); }
    return attn_body::C2 * 64.0f * 1.02f * gq * gk;
}
#ifndef GEMM1_WGM
#define GEMM1_WGM 12
#endif
constexpr float GAP_EXTRA = 38.0f;
struct Args { const float* in[13]; float* out; unsigned char* ws; };
struct ConvItems {
    LAS unsigned char* L;
    __device__ __forceinline__ void operator()(int item) const {
        const __attribute__((address_space(4))) Args* ap_ = (const __attribute__((address_space(4))) Args*)__builtin_amdgcn_kernarg_segment_ptr(); asm volatile("" : "+s"(ap_));
        unsigned char* ws = ap_->ws; const float* conv_w = ap_->in[9]; const float* w_a = ap_->in[10]; const float* w_b = ap_->in[11]; const float* w_o = ap_->in[12];
        const bf16* CUB = (const bf16*)(ws + WS_CU); const bf16* GZB = (const bf16*)(ws + WS_GZ); bf16* OAB = (bf16*)(ws + WS_OAB); bf16* WABT = (bf16*)(ws + WS_WAB); bf16* WOT = (bf16*)(ws + WS_WO);
        const int lane = threadIdx.x & 63, wave = __builtin_amdgcn_readfirstlane((int)threadIdx.x >> 6);
        if (item >= M / 128) {
            LAS float* scr = (LAS float*)(L + wave * 8704); int r = (item - M / 128) * 8 + wave;
            constexpr int I_A = (D / 32) * (AW / 64), I_B = (D / 32) * (CW / 64);
            if (r < I_A) p0_transpose_item<false>(w_a, D, D, WABT, scr, r, AW / 64, lane);
            else if (r < I_A + I_B) p0_transpose_item<false>(w_b, D, D, WABT + 512, scr, r - I_A, CW / 64, lane);
            else p0_transpose_item<false>(w_o, D, D, WOT, scr, r - I_A - I_B, D / 64, lane);
            return; }
        const int m0 = item * 128 + wave * 16; const int ch = 8 * lane;
        float w0[8], w1[8], w2[8];
#pragma unroll
        for (int e = 0; e < 8; ++e) { w0[e] = conv_w[ch + e]; w1[e] = conv_w[CW + ch + e]; w2[e] = conv_w[2 * CW + ch + e]; }
        float p1[8], p2[8];
        const bool first = (m0 % T) == 0;
        { v4u a = {0u, 0u, 0u, 0u}, bq = {0u, 0u, 0u, 0u};
          if (!first) { a = *(const v4u*)(CUB + (size_t)(m0 - 2) * CW + ch); bq = *(const v4u*)(CUB + (size_t)(m0 - 1) * CW + ch); }
#pragma unroll
          for (int e = 0; e < 4; ++e) { p2[2 * e] = pg8::bflo(a[e]); p2[2 * e + 1] = pg8::bfhi(a[e]); p1[2 * e] = pg8::bflo(bq[e]); p1[2 * e + 1] = pg8::bfhi(bq[e]); } }
#pragma unroll 4
        for (int r = 0; r < 16; ++r) { const int m = m0 + r;
            const v4u cv = *(const v4u*)(CUB + (size_t)m * CW + ch), gv = *(const v4u*)(GZB + (size_t)m * CW + ch);
            float cur[8], o[8];
#pragma unroll
            for (int e = 0; e < 4; ++e) { cur[2 * e] = pg8::bflo(cv[e]); cur[2 * e + 1] = pg8::bfhi(cv[e]); }
#pragma unroll
            for (int e = 0; e < 4; ++e) { o[2 * e] = pg8::bflo(gv[e]) * (w0[2 * e] * p2[2 * e] + w1[2 * e] * p1[2 * e] + w2[2 * e] * cur[2 * e]);
                o[2 * e + 1] = pg8::bfhi(gv[e]) * (w0[2 * e + 1] * p2[2 * e + 1] + w1[2 * e + 1] * p1[2 * e + 1] + w2[2 * e + 1] * cur[2 * e + 1]); }
            v4u ov; ov.x = pk2(o[0], o[1]); ov.y = pk2(o[2], o[3]); ov.z = pk2(o[4], o[5]); ov.w = pk2(o[6], o[7]);
            *(v4u*)(OAB + (size_t)m * 1024 + 512 + ch) = ov;
#pragma unroll
            for (int e = 0; e < 8; ++e) { p2[e] = p1[e]; p1[e] = cur[e]; }
        }
    }
};
constexpr int N_CONV_ITEMS = M / 128 + ((D / 32) * (AW / 64) + (D / 32) * (CW / 64) + (D / 32) * (D / 64)) / 8;

template <int LO, int HI> __global__ void __launch_bounds__(NWAVES * 64, 2) fox_fwd(Args args) {
    extern __shared__ __attribute__((aligned(16))) unsigned char lds[];
    LAS unsigned char* L = (LAS unsigned char*)lds;
    if (threadIdx.x < 2) ((volatile LAS unsigned*)(L + MISC_OFF))[threadIdx.x] = 0u;
    if (HI - LO > 1 && threadIdx.x == 0) (void)xb_add(&((unsigned*)(args.ws + WS_CTL))[XB_XCNT(xb_xcc_id())], 1u);
    __syncthreads();
#define PHASE_IDS() int tid = threadIdx.x; asm volatile("" : "+v"(tid)); int bx = blockIdx.x; asm volatile("" : "+s"(bx)); int G = gridDim.x; asm volatile("" : "+s"(G)); \
    const int lane = tid & 63, wave = __builtin_amdgcn_readfirstlane(tid >> 6); const int vcu = (G % 8 == 0) ? (bx % 8) * (G / 8) + bx / 8 : bx; const int gw = vcu * NWAVES + wave, NGW = G * NWAVES; (void)lane; (void)gw; (void)NGW
#define PHASE_PTRS() const __attribute__((address_space(4))) Args* ap_ = (const __attribute__((address_space(4))) Args*)__builtin_amdgcn_kernarg_segment_ptr(); asm volatile("" : "+s"(ap_)); unsigned char* ws = ap_->ws; const float* x = ap_->in[0]; const float* c = ap_->in[1]; const float* w_ada = ap_->in[2]; const float* b_ada = ap_->in[3]; const float* norm_g = ap_->in[4]; const float* w_in = ap_->in[5]; const float* b_f = ap_->in[6]; const float* q_g = ap_->in[7]; const float* k_g = ap_->in[8]; const float* conv_w = ap_->in[9]; const float* w_a = ap_->in[10]; const float* w_b = ap_->in[11]; const float* w_o = ap_->in[12]; float* ADA = (float*)(ws + WS_ADA); float* WF = (float*)(ws + WS_WF); float* LF = (float*)(ws + WS_LF); bf16* W1T = (bf16*)(ws + WS_W1); bf16* WABT = (bf16*)(ws + WS_WAB); bf16* WOT = (bf16*)(ws + WS_WO); bf16* HB = (bf16*)(ws + WS_HB); bf16* OAB = (bf16*)(ws + WS_OAB); bf16* QB = (bf16*)(ws + WS_Q); bf16* KB = (bf16*)(ws + WS_K); bf16* VB = (bf16*)(ws + WS_V); bf16* MG = (bf16*)(ws + WS_MG); bf16* SZA = (bf16*)(ws + WS_SZA); bf16* CUB = (bf16*)(ws + WS_CU); bf16* GZB = (bf16*)(ws + WS_GZ); bf16* RB = (bf16*)(ws + WS_R); bf16* SGB = (bf16*)(ws + WS_SGB);
#ifndef REPEAT_PHASE
#define REPEAT_PHASE -1
#endif
#define REPS(k) (REPEAT_PHASE == (k) ? 2 : 1)
#ifndef PHMASK
#define PHMASK 63
#endif
#define IN(k) ((((PHMASK) >> (k)) & 1) && LO <= (k) && (k) < HI)
#define BOTH(k) (IN(k) && IN((k) + 1))
#ifndef BAR_REPS
#define BAR_REPS 1
#endif
#define XBAR() for (int br_ = 0; br_ < BAR_REPS; ++br_) do { const __attribute__((address_space(4))) Args* bp_ = (const __attribute__((address_space(4))) Args*)__builtin_amdgcn_kernarg_segment_ptr(); asm volatile("" : "+s"(bp_)); XcdBarrier b_; b_.bar = (unsigned*)(bp_->ws + WS_CTL); b_.x = xb_xcc_id(); b_.st = (volatile LAS unsigned*)(L + MISC_OFF); xcd_barrier(b_); } while (0)

    for (int rep_ = 0; rep_ < REPS(0); ++rep_) if (IN(0)) {
        PHASE_PTRS(); PHASE_IDS();
        if (bx < 192) {
            LAS float* ct = (LAS float*)L;
            LAS float* red = (LAS float*)(L + 32768);
            for (int i = tid; i < 8192; i += NWAVES * 64) { const int b = i >> 10, k = i & 1023; ct[k * 8 + b] = c[i]; }
            __syncthreads();
            const int col = bx * 16 + (lane & 15), kpar = lane >> 4;
            float acc[8];
#pragma unroll
            for (int b = 0; b < 8; ++b) acc[b] = 0.f;
#pragma unroll 8
            for (int kk = 0; kk < 32; ++kk) { const int k = wave * 128 + 4 * kk + kpar; const float wv = w_ada[(size_t)k * 3072 + col];
                const f32x4 c0 = *(const LAS f32x4*)(ct + k * 8), c1 = *(const LAS f32x4*)(ct + k * 8 + 4);
                acc[0] += c0[0] * wv; acc[1] += c0[1] * wv; acc[2] += c0[2] * wv; acc[3] += c0[3] * wv; acc[4] += c1[0] * wv; acc[5] += c1[1] * wv; acc[6] += c1[2] * wv; acc[7] += c1[3] * wv; }
#pragma unroll
            for (int b = 0; b < 8; ++b) { acc[b] += __shfl_xor(acc[b], 16); acc[b] += __shfl_xor(acc[b], 32); if (lane < 16) red[(wave * 8 + b) * 16 + lane] = acc[b]; }
            __syncthreads();
            if (tid < 128) { const int b = tid >> 4, cl = tid & 15; float s = b_ada[bx * 16 + cl];
#pragma unroll
                for (int w = 0; w < 8; ++w) s += red[(w * 8 + b) * 16 + cl];
                ADA[b * 3072 + bx * 16 + cl] = s; }
            __syncthreads();
        }
        {
            const int i = bx * NWAVES * 64 + tid; if (i < 8192) { const int j = i >> 10, k = i & 1023; WF[i] = w_in[(size_t)k * INW + SRC_F + j]; }
        }
        if (bx >= 192) {
            LAS float* scr = (LAS float*)(L + wave * 8704); const int w2 = (bx - 192) * NWAVES + wave;
            p0_transpose_item<true>(w_in, D, INW, W1T, scr, 2048 + w2, D / 64, lane);
            p0_transpose_item<true>(w_in, D, INW, W1T, scr, 2048 + 512 + w2, D / 64, lane);
        }
        if (BOTH(0)) XBAR();
    }

    for (int rep_ = 0; rep_ < REPS(1); ++rep_) if (IN(1)) {
        PHASE_PTRS(); PHASE_IDS();
#define P1COL(j) (8 * lane + 512 * ((j) >> 1) + 4 * ((j) & 1))
        LAS float* wf = (LAS float*)L;
        for (int i = tid; i < 2048; i += NWAVES * 64) ((LAS f32x4*)wf)[i] = ((const f32x4*)WF)[i];
        __syncthreads();
        const int m0 = gw * 16, b = m0 / T;
        f32x4 gm[4], sh[4];
#pragma unroll
        for (int j = 0; j < 4; ++j) { const int col = P1COL(j); const f32x4 g = *(const f32x4*)(norm_g + col), scl = *(const f32x4*)(ADA + b * 3072 + 1024 + col);
            gm[j] = g * (scl + 1.0f); sh[j] = *(const f32x4*)(ADA + b * 3072 + col); }
        for (int r = 0; r < 16; ++r) { const int m = m0 + r; if (m >= M) break;
            const GAS float* xr = (const GAS float*)(x + (size_t)m * D);
            f32x4 v[4]; float s2 = 0.f;
#pragma unroll
            for (int j = 0; j < 4; ++j) { v[j] = *(const GAS f32x4*)(xr + P1COL(j)); s2 += (v[j][0] * v[j][0] + v[j][1] * v[j][1]) + (v[j][2] * v[j][2] + v[j][3] * v[j][3]); }
            const float rstd = 1.0f / sqrtf(wave_sum(s2) * (1.0f / D) + EPS);
#pragma unroll
            for (int j = 0; j < 4; ++j) v[j] = v[j] * rstd * gm[j] + sh[j];
#pragma unroll
            for (int j = 0; j < 2; ++j) { v4u o; o.x = pk2(v[2 * j][0], v[2 * j][1]); o.y = pk2(v[2 * j][2], v[2 * j][3]); o.z = pk2(v[2 * j + 1][0], v[2 * j + 1][1]); o.w = pk2(v[2 * j + 1][2], v[2 * j + 1][3]);
                *(GAS v4u*)(HB + (size_t)m * D + 8 * lane + 512 * j) = o; }
            float fl[8];
#pragma unroll
            for (int q = 0; q < 8; ++q) { float a = 0.f;
#pragma unroll
                for (int j = 0; j < 4; ++j) { const f32x4 w = *(const LAS f32x4*)(wf + q * 1024 + P1COL(j)); a += (v[j][0] * w[0] + v[j][1] * w[1]) + (v[j][2] * w[2] + v[j][3] * w[3]); }
                fl[q] = wave_sum(a); }
            float mine = fl[0];
#pragma unroll
            for (int q = 1; q < 8; ++q) mine = (lane == q) ? fl[q] : mine;
            if (lane < 8) { const float z = mine + b_f[lane]; const float ls = fminf(z, 0.f) - log1pf(__expf(-fabsf(z)));
                LF[(size_t)(b * 8 + lane) * T + (m - b * T)] = ls; }
        }
        {
            LAS float* scr = (LAS float*)(L + 32768 + wave * 8704);
            constexpr int I_1 = (NPROJ / 32) * (D / 64), I_A = (D / 32) * (AW / 64), I_B = (D / 32) * (CW / 64), I_O = (D / 32) * (D / 64);
            (void)I_A; (void)I_B; (void)I_O;
            static_assert(I_1 == 3072, "P0 converts items [2048, 3072) on its 64 GEMV-free workgroups");
            for (int it = gw; it < 2048; it += NGW) p0_transpose_item<true>(w_in, D, INW, W1T, scr, it, D / 64, lane);
        }
        __syncthreads();
        if (BOTH(1)) XBAR();
    }

    for (int rep_ = 0; rep_ < REPS(2); ++rep_) if (IN(2)) {
        PHASE_PTRS(); PHASE_IDS();
        if (bx < BATCH * H) {
            attn_body::bias_scan((char*)lds, LF + (size_t)bx * T, (float*)(ws + WS_BIAS) + (size_t)bx * T);
            attn_body::j0_table((const char*)lds, 2.0f * qk_bound(q_g, k_g, lane) + GAP_EXTRA, (int*)(ws + WS_J0) + bx * 16, wave, lane);
            __syncthreads(); }
        pg8::Gemm g{HB, W1T, M, NPROJ, D}; pg8::StaticOrder S; S.init(M, NPROJ, G, bx, GEMM1_WGM);
        pg8::EpiProj E{ws, q_g, k_g, attn_body::C2, EPS};
        pg8::gemm_phase<pg8::EpiProj, pg8::StaticOrder, PG8_ALIGN, PG8_SP2>(L + RING_OFF, g, S, E);
        if (BOTH(2)) XBAR();
    }

    for (int rep_ = 0; rep_ < REPS(3); ++rep_) if (IN(3)) {
        PHASE_PTRS(); PHASE_IDS();
        const float qkb = qk_bound(q_g, k_g, lane);
        const attn_body::AttnTensors AT{ws, WS_Q, WS_K, WS_V, WS_SZA, WS_LF, WS_OAB, WS_BIAS, WS_J0, 2.0f * qkb + GAP_EXTRA, qkb};
        const ConvItems CI{L};
        attn_body::attn_phase_dyn<-1, ConvItems>((char*)lds + RING_OFF, AT, (unsigned*)(ws + WS_CTL) + CW_ATTNQ, CI, N_CONV_ITEMS);
        if (BOTH(3)) XBAR();
    }

    for (int rep_ = 0; rep_ < REPS(4); ++rep_) if (IN(4)) {
        PHASE_PTRS(); PHASE_IDS();
        pg8::Gemm g{OAB, WABT, M, D, D}; pg8::StaticOrder S; S.init(M, D, G, bx);
        pg8::EpiMerge E{(const unsigned short*)RB, MG};
        pg8::gemm_phase<pg8::EpiMerge, pg8::StaticOrder, PG8_ALIGN, PG8_SP2>(L + RING_OFF, g, S, E);
        if (BOTH(4)) XBAR();
    }

    for (int rep_ = 0; rep_ < REPS(5); ++rep_) if (IN(5)) {
        PHASE_PTRS(); PHASE_IDS();
        pg8::Gemm g{MG, WOT, M, D, D}; pg8::StaticOrder S; S.init(M, D, G, bx);
        pg8::EpiOut E{x, ADA + 2048, ap_->out};
        pg8::gemm_phase<pg8::EpiOut, pg8::StaticOrder, PG8_ALIGN, PG8_SP2>(L + RING_OFF, g, S, E);
    }
#undef IN
#undef BOTH
}

extern "C" void kernel_launch(void* const* d_in, const int* in_sizes, int n_in, void* d_out, int out_size, void* d_ws, size_t ws_size, hipStream_t stream) {
    static int grid = 0;
    if (grid == 0) {
        if (n_in != 13 || in_sizes[0] != M * D || out_size != M * D || ws_size < WS_END) { fprintf(stderr, "kernel_launch: shape/workspace mismatch (n_in %d, in0 %d, out %d, ws %zu); nothing launched\n", n_in, n_in > 0 ? in_sizes[0] : -1, out_size, ws_size); grid = -1; return; }
        int dev = 0, cus = 0, per_cu = 0;
        if (hipGetDevice(&dev) != hipSuccess || hipDeviceGetAttribute(&cus, hipDeviceAttributeMultiprocessorCount, dev) != hipSuccess) { fprintf(stderr, "kernel_launch: device query failed\n"); grid = -1; return; }
        bool ok = true;
#if MK_N_LAUNCHES == 1
        const void* kfull = (const void*)fox_fwd<0, PER_PHASE>;
        ok = hipFuncSetAttribute(kfull, hipFuncAttributeMaxDynamicSharedMemorySize, LDS_BYTES) == hipSuccess;
#else
        const void* kph[PER_PHASE] = {(const void*)fox_fwd<0, 1>, (const void*)fox_fwd<1, 2>, (const void*)fox_fwd<2, 3>, (const void*)fox_fwd<3, 4>, (const void*)fox_fwd<4, 5>, (const void*)fox_fwd<5, 6>};
        const void* kfull = kph[3];
        for (int i = 0; i < PER_PHASE; ++i) ok = ok && hipFuncSetAttribute(kph[i], hipFuncAttributeMaxDynamicSharedMemorySize, LDS_BYTES) == hipSuccess;
#endif
        if (!ok) { fprintf(stderr, "kernel_launch: hipFuncSetAttribute failed\n"); grid = -1; return; }
        if (hipOccupancyMaxActiveBlocksPerMultiprocessor(&per_cu, kfull, NWAVES * 64, LDS_BYTES) != hipSuccess || per_cu < 1) { fprintf(stderr, "kernel_launch: occupancy query reports %d workgroups per CU\n", per_cu); (void)hipGetLastError(); grid = -1; return; }
        grid = cus;
        if (grid != 256) { fprintf(stderr, "kernel_launch: built for a 256-CU device (got %d CUs); nothing launched\n", cus); grid = -1; return; }
    }
    if (grid < 0) return;
    if (hipMemsetAsync((char*)d_ws + WS_CTL, 0, (XCD_BAR_WORDS + 256) * 4, stream) != hipSuccess) { fprintf(stderr, "kernel_launch: hipMemsetAsync failed\n"); return; }
    Args a{};
    for (int i = 0; i < 13; ++i) a.in[i] = (const float*)d_in[i];
    a.out = (float*)d_out; a.ws = (unsigned char*)d_ws;
#if MK_N_LAUNCHES == 1
    {
        void* kargs[] = {&a};
        const hipError_t e = hipLaunchCooperativeKernel((const void*)fox_fwd<0, PER_PHASE>, dim3(grid), dim3(NWAVES * 64), kargs, LDS_BYTES, stream);
        if (e != hipSuccess) fprintf(stderr, "kernel_launch: cooperative launch failed: %s (grid %d)\n", hipGetErrorString(e), grid);
    }
#else
    {
        hipLaunchKernelGGL((fox_fwd<0, 1>), dim3(grid), dim3(NWAVES * 64), LDS_BYTES, stream, a);
        hipLaunchKernelGGL((fox_fwd<1, 2>), dim3(grid), dim3(NWAVES * 64), LDS_BYTES, stream, a);
        hipLaunchKernelGGL((fox_fwd<2, 3>), dim3(grid), dim3(NWAVES * 64), LDS_BYTES, stream, a);
        hipLaunchKernelGGL((fox_fwd<3, 4>), dim3(grid), dim3(NWAVES * 64), LDS_BYTES, stream, a);
        hipLaunchKernelGGL((fox_fwd<4, 5>), dim3(grid), dim3(NWAVES * 64), LDS_BYTES, stream, a);
        hipLaunchKernelGGL((fox_fwd<5, 6>), dim3(grid), dim3(NWAVES * 64), LDS_BYTES, stream, a);
        const hipError_t le = hipPeekAtLastError();
        if (le != hipSuccess) fprintf(stderr, "kernel_launch: a phase launch failed: %s\n", hipGetErrorName(le));
    }
#endif
}
```

```cpp
#include <hip/hip_runtime.h>
#include <cstdio>
#include <cstdint>
namespace pg8 {
#define PG8_LAS __attribute__((address_space(3)))
typedef unsigned short bf16_t;
typedef short bf16x8 __attribute__((ext_vector_type(8)));
typedef float f32x4 __attribute__((ext_vector_type(4)));
typedef unsigned u32x4 __attribute__((ext_vector_type(4)));
constexpr int BM = 256, BK = 64, HALF = 128, HTB = HALF * BK * 2  , STAGE_BYTES = 8 * HTB, NXCD = 8, WGM = 8;

__host__ __device__ __forceinline__ int lds_byte(int r, int c) { const int st = (r >> 4) * 2 + (c >> 5), rr = r & 15, cc = c & 31, ob = rr * 64 + cc * 2; return st * 1024 + (ob ^ (((ob >> 9) & 1) << 5)); }
__host__ __device__ __forceinline__ void stage_rc(int b, int& R, int& C) { const int st = b / 1024, sb = b % 1024, swz = sb ^ (((sb >> 9) & 1) << 5); R = (st >> 1) * 16 + swz / 64; C = (st & 1) * 32 + (swz % 64) / 2; }
__host__ __device__ __forceinline__ int perm32(int rho) { const int n = rho >> 4, i = rho & 15; return 8 * (i >> 2) + 4 * n + (i & 3); }

struct Unit { int pm, pn; };
struct Gemm { const bf16_t* A; const bf16_t* Bt; int M, N, K; };

struct StaticOrder {
    int nM, nN, nwg, G, c, wgm;
    __host__ __device__ void init(int M, int N, int G_, int c_, int wgm_ = WGM) { nM = M / BM; nN = N / BM; nwg = nM * nN; G = G_; c = c_; wgm = wgm_; }
    __host__ __device__ bool next(int i, Unit& u) const {
        const long L = (long)i * G + c; if (L >= nwg) return false;
        int wgid = (int)L; { const int q = nwg / NXCD, r = nwg % NXCD, xcd = wgid % NXCD, off = wgid / NXCD; wgid = (xcd < r ? xcd * (q + 1) : r * (q + 1) + (xcd - r) * q) + off; }
        const int nig = wgm * nN, gid = wgid / nig, fm = gid * wgm, gsz = (nM - fm) < wgm ? (nM - fm) : wgm;
        u.pm = fm + ((wgid % nig) % gsz); u.pn = (wgid % nig) / gsz; return true;
    }
    __device__ __forceinline__ void a_ready(const Unit&) const {}
    __device__ __forceinline__ void done(const Unit&) const {}
};

__device__ __forceinline__ unsigned cvt_pk_bf16(float lo, float hi) { unsigned r; asm volatile("v_cvt_pk_bf16_f32 %0, %1, %2" : "=v"(r) : "v"(lo), "v"(hi)); return r; }
typedef float f32x2 __attribute__((ext_vector_type(2)));
__device__ __forceinline__ float sigm(float x) { return __builtin_amdgcn_rcpf(1.0f + __builtin_amdgcn_exp2f(x * -1.4426950408889634f)); }
__device__ __forceinline__ float silu(float x) { return x * sigm(x); }
__device__ __forceinline__ float bflo(unsigned w) { return __builtin_bit_cast(float, w << 16); }
__device__ __forceinline__ float bfhi(unsigned w) { return __builtin_bit_cast(float, w & 0xffff0000u); }
typedef unsigned u32x2 __attribute__((ext_vector_type(2)));

constexpr size_t OFF_Q = 96u << 20, OFF_K = 128u << 20, OFF_V = 160u << 20, OFF_SZA = 192u << 20, OFF_CU = 224u << 20, OFF_GZ = 256u << 20, OFF_SGA = 320u << 20, OFF_SGB = 384u << 20;
struct EpiProj {
    static constexpr bool PERM = true, AFTER_DRAIN = false, MID = false;
    unsigned char* ws; const float *qg, *kg; float qscale, eps;
    __device__ __forceinline__ void operator()(const f32x4 (&acc)[2][2][4][2], const Unit& u, int wr, int wc, int fr, int fq) const {
        const int pn = u.pn; const size_t row0 = (size_t)u.pm * BM + wr * 64 + fr;
        if (pn < 4) {
            const bool isq = pn < 2; const float* g = isq ? qg : kg; bf16_t* dst = (bf16_t*)(ws + (isq ? OFF_Q : OFF_K)); const float sc = isq ? qscale : 1.0f;
            const int colb = (pn & 1) * 256 + 64 * wc + 8 * fq;
            f32x4 gv[2][2];
#pragma unroll
            for (int bj = 0; bj < 2; ++bj)
#pragma unroll
                for (int n = 0; n < 2; ++n) gv[bj][n] = *(const f32x4*)(g + 32 * bj + 8 * fq + 4 * n) * sc;
#pragma unroll
            for (int ai = 0; ai < 2; ++ai)
#pragma unroll
                for (int m = 0; m < 4; ++m) {
                    float ss = 0.f;
#pragma unroll
                    for (int bj = 0; bj < 2; ++bj)
#pragma unroll
                        for (int n = 0; n < 2; ++n) { const f32x4 x = acc[ai][bj][m][n]; ss += (x[0] * x[0] + x[1] * x[1]) + (x[2] * x[2] + x[3] * x[3]); }
                    ss += __shfl_xor(ss, 16); ss += __shfl_xor(ss, 32);
                    const float rstd = __builtin_amdgcn_rsqf(ss * (1.0f / 64.0f) + eps);
                    bf16_t* rowp = dst + (row0 + ai * HALF + m * 16) * 512 + colb;
#pragma unroll
                    for (int bj = 0; bj < 2; ++bj) { const f32x4 v0 = acc[ai][bj][m][0] * rstd * gv[bj][0], v1 = acc[ai][bj][m][1] * rstd * gv[bj][1];
                        u32x4 w; w.x = cvt_pk_bf16(v0[0], v0[1]); w.y = cvt_pk_bf16(v0[2], v0[3]); w.z = cvt_pk_bf16(v1[0], v1[1]); w.w = cvt_pk_bf16(v1[2], v1[3]);
                        *(u32x4*)(rowp + 32 * bj) = w; }
                }
        } else if (pn >= 8 && pn < 16) {
            const int col = 64 * (pn - 8) + 16 * wc + 8 * (fq >> 1); bf16_t* dstb = (bf16_t*)(ws + ((fq & 1) ? OFF_GZ : OFF_CU));
#pragma unroll
            for (int ai = 0; ai < 2; ++ai)
#pragma unroll
                for (int m = 0; m < 4; ++m) { const size_t off = (row0 + ai * HALF + m * 16) * 512 + col;
                    const f32x4 gb = acc[ai][0][m][0], gc = acc[ai][0][m][1], uu = acc[ai][1][m][0], zb = acc[ai][1][m][1];
                    const f32x4 cu = gc * uu; f32x4 gz; gz[0] = gb[0] * silu(zb[0]); gz[1] = gb[1] * silu(zb[1]); gz[2] = gb[2] * silu(zb[2]); gz[3] = gb[3] * silu(zb[3]);
                    u32x2 a, b; a.x = cvt_pk_bf16(cu[0], cu[1]); a.y = cvt_pk_bf16(cu[2], cu[3]); b.x = cvt_pk_bf16(gz[0], gz[1]); b.y = cvt_pk_bf16(gz[2], gz[3]);
                    const auto rx = __builtin_amdgcn_permlane16_swap(a.x, b.x, false, false), ry = __builtin_amdgcn_permlane16_swap(a.y, b.y, false, false);
                    u32x4 w; w.x = rx[0]; w.y = ry[0]; w.z = rx[1]; w.w = ry[1];
                    *(u32x4*)(dstb + off) = w; }
        } else if (pn >= 16) {
            const int col = 128 * (pn - 16) + 32 * wc + 8 * fq; unsigned short* AB = (unsigned short*)(ws + OFF_SGA);
#pragma unroll
            for (int ai = 0; ai < 2; ++ai)
#pragma unroll
                for (int m = 0; m < 4; ++m) { const size_t off = (row0 + ai * HALF + m * 16) * 1024 + col;
                    unsigned wd[4];
#pragma unroll
                    for (int n = 0; n < 2; ++n)
#pragma unroll
                        for (int h = 0; h < 2; ++h) { unsigned d = 0u;
#pragma unroll
                            for (int e = 0; e < 2; ++e) { const int i = 2 * h + e; const unsigned ta = (unsigned)(sigm(acc[ai][0][m][n][i]) * 255.0f + 0.5f); unsigned tb = (unsigned)(sigm(acc[ai][1][m][n][i]) * 255.0f + 0.5f); tb = tb < 1u ? 1u : tb;
                                d |= (ta | (tb << 8)) << (16 * e); }
                            wd[2 * n + h] = d; }
                    *(u32x4*)(AB + off) = (u32x4){wd[0], wd[1], wd[2], wd[3]};
                    asm volatile("" ::: "memory"); }
        } else {
            size_t doff; int ld, tcol, act;
            if (pn < 6) { doff = OFF_V; ld = 512; tcol = (pn - 4) * 256; act = 0; }
            else { doff = OFF_SZA; ld = 512; tcol = (pn - 6) * 256; act = 1; }
            bf16_t* dst = (bf16_t*)(ws + doff);
            const int colb = tcol + 64 * wc + 8 * fq;
#pragma unroll
            for (int ai = 0; ai < 2; ++ai)
#pragma unroll
                for (int m = 0; m < 4; ++m) { bf16_t* rowp = dst + (row0 + ai * HALF + m * 16) * ld + colb;
#pragma unroll
                    for (int bj = 0; bj < 2; ++bj) { f32x4 v0 = acc[ai][bj][m][0], v1 = acc[ai][bj][m][1];
                        if (act == 1) { v0[0] = silu(v0[0]); v0[1] = silu(v0[1]); v0[2] = silu(v0[2]); v0[3] = silu(v0[3]); v1[0] = silu(v1[0]); v1[1] = silu(v1[1]); v1[2] = silu(v1[2]); v1[3] = silu(v1[3]); }
                        u32x4 w; w.x = cvt_pk_bf16(v0[0], v0[1]); w.y = cvt_pk_bf16(v0[2], v0[3]); w.z = cvt_pk_bf16(v1[0], v1[1]); w.w = cvt_pk_bf16(v1[2], v1[3]);
                        *(u32x4*)(rowp + 32 * bj) = w; } }
        }
    }
};
__host__ __device__ __forceinline__ int proj_src_col(int p) {
    const int pn = p >> 8, r = p & 255, bj = r >> 7, wc = (r >> 5) & 3, jj = r & 31;
    if (pn >= 8 && pn < 16) { const int fq = jj >> 3, n = (jj >> 2) & 1, i = jj & 3; const int sect = bj == 0 ? (n == 0 ? 2056 : 2568) : (n == 0 ? 3080 : 3592); return sect + 64 * (pn - 8) + 16 * wc + 4 * fq + i; }
    if (pn >= 16) return (bj == 0 ? 4104 : 5128) + 128 * (pn - 16) + 32 * wc + jj;
    const int nat = 64 * wc + 32 * bj + jj;
    if (pn < 6) return 256 * pn + nat;
    return 1544 + 256 * (pn - 6) + nat;
}

struct EpiMerge {
    static constexpr bool PERM = true, AFTER_DRAIN = false, MID = true;
    const unsigned short* AB; bf16_t* MG;
    static __device__ __forceinline__ float ub(unsigned w, int k) { return (float)((w >> (8 * k)) & 0xffu); }
    __device__ __forceinline__ void mid(f32x4 (&acc)[2][2][4][2], const Unit& u, int wr, int wc, int fr, int fq) const {
        unsigned off0 = (unsigned)((u.pm * BM + wr * 64 + fr) * 1024 + u.pn * BM + wc * 32 + 8 * fq);
        asm volatile("" : "+v"(off0));
#pragma unroll
        for (int ai = 0; ai < 2; ++ai)
#pragma unroll
            for (int m = 0; m < 4; ++m) { const unsigned off = off0 + (unsigned)((ai * HALF + m * 16) * 1024);
#pragma unroll
                for (int bj = 0; bj < 2; ++bj) { const u32x4 g = *(const u32x4*)(AB + (off + bj * HALF));
                    acc[ai][bj][m][0] *= (f32x4){ub(g.x, 0) * __builtin_amdgcn_rcpf(ub(g.x, 1)), ub(g.x, 2) * __builtin_amdgcn_rcpf(ub(g.x, 3)), ub(g.y, 0) * __builtin_amdgcn_rcpf(ub(g.y, 1)), ub(g.y, 2) * __builtin_amdgcn_rcpf(ub(g.y, 3))};
                    acc[ai][bj][m][1] *= (f32x4){ub(g.z, 0) * __builtin_amdgcn_rcpf(ub(g.z, 1)), ub(g.z, 2) * __builtin_amdgcn_rcpf(ub(g.z, 3)), ub(g.w, 0) * __builtin_amdgcn_rcpf(ub(g.w, 1)), ub(g.w, 2) * __builtin_amdgcn_rcpf(ub(g.w, 3))}; } }
    }
    __device__ __forceinline__ void operator()(const f32x4 (&acc)[2][2][4][2], const Unit& u, int wr, int wc, int fr, int fq) const {
        unsigned off0 = (unsigned)((u.pm * BM + wr * 64 + fr) * 1024 + u.pn * BM + wc * 32 + 8 * fq); const float s = 1.0f / 255.0f;
        asm volatile("" : "+v"(off0));
#pragma unroll
        for (int ai = 0; ai < 2; ++ai)
#pragma unroll
            for (int m = 0; m < 4; ++m) { const unsigned off = off0 + (unsigned)((ai * HALF + m * 16) * 1024);
#pragma unroll
                for (int bj = 0; bj < 2; ++bj) { const u32x4 g = *(const u32x4*)(AB + (off + bj * HALF)); const f32x4 v0 = acc[ai][bj][m][0] * s, v1 = acc[ai][bj][m][1] * s;
                    u32x4 w; w.x = cvt_pk_bf16(v0[0] * ub(g.x, 1), v0[1] * ub(g.x, 3)); w.y = cvt_pk_bf16(v0[2] * ub(g.y, 1), v0[3] * ub(g.y, 3));
                    w.z = cvt_pk_bf16(v1[0] * ub(g.z, 1), v1[1] * ub(g.z, 3)); w.w = cvt_pk_bf16(v1[2] * ub(g.w, 1), v1[3] * ub(g.w, 3));
                    *(u32x4*)((unsigned char*)MG + 2u * (off + bj * HALF)) = w; } }
    }
};
struct EpiOut {
    static constexpr bool PERM = false, AFTER_DRAIN = false, MID = false;
    const float* x; const float* gate; float* out;
    __device__ __forceinline__ void operator()(const f32x4 (&acc)[2][2][4][2], const Unit& u, int wr, int wc, int fr, int fq) const {
        const size_t row0 = (size_t)u.pm * BM + wr * 64 + fr; const int col0 = u.pn * BM + wc * 32 + 4 * fq; const float* gp = gate + (size_t)(u.pm >> 4) * 3072 + col0;
        f32x4 gv[2][2];
#pragma unroll
        for (int bj = 0; bj < 2; ++bj)
#pragma unroll
            for (int n = 0; n < 2; ++n) gv[bj][n] = *(const f32x4*)(gp + bj * HALF + n * 16);
#pragma unroll
        for (int ai = 0; ai < 2; ++ai) {
            f32x4 xv[4][2][2];
#pragma unroll
            for (int m = 0; m < 4; ++m) { const size_t off = (row0 + ai * HALF + m * 16) * 1024 + col0;
#pragma unroll
                for (int bj = 0; bj < 2; ++bj)
#pragma unroll
                    for (int n = 0; n < 2; ++n) xv[m][bj][n] = *(const f32x4*)(x + off + bj * HALF + n * 16); }
            asm volatile("" ::: "memory");
#pragma unroll
            for (int m = 0; m < 4; ++m) { const size_t off = (row0 + ai * HALF + m * 16) * 1024 + col0;
#pragma unroll
                for (int bj = 0; bj < 2; ++bj)
#pragma unroll
                    for (int n = 0; n < 2; ++n) *(f32x4*)(out + off + bj * HALF + n * 16) = xv[m][bj][n] + gv[bj][n] * acc[ai][bj][m][n]; }
            asm volatile("" ::: "memory"); }
    }
};

template <class Epi, class Sched, bool ALIGN_EPI = false, bool SP2 = false>
__device__ __forceinline__ void gemm_phase(PG8_LAS unsigned char* lds, const Gemm g, const Sched& S, const Epi& E) {
    int tid_ = threadIdx.x; asm volatile("" : "+v"(tid_));
    const int tid = tid_, wid = __builtin_amdgcn_readfirstlane(tid >> 6), lane = tid & 63, wr = wid >> 2, wc = wid & 3, fr = lane & 15, fq = lane >> 4;
    const int K = g.K, nt = K / BK;
    unsigned voffA[2], voffB[2];
#pragma unroll
    for (int i = 0; i < 2; ++i) { int R, C; stage_rc(tid * 16 + i * 8192, R, C); const int Rb = Epi::PERM ? ((R & ~31) + perm32(R & 31)) : R;
        voffA[i] = (unsigned)(R * K + C) * 2u; voffB[i] = (unsigned)(Rb * K + C) * 2u; }
    const size_t kstep = (size_t)(BK * 2);
    const size_t hstep = (size_t)HALF * K * 2;
    const size_t tstep = 2 * hstep;
    const unsigned ldsw = (unsigned)wid * 1024u;
    const int aoff = lds_byte(wr * 64 + fr, fq * 8), boff = lds_byte(wc * 32 + fr, fq * 8);
#define PG8_SA(b, h) (((b) * 2 + (h)) * HTB)
#define PG8_SB(b, h) ((4 + (b) * 2 + (h)) * HTB)
#define PG8_STAGE(bufoff, gbase, voff) do { _Pragma("unroll") for (int _i = 0; _i < 2; ++_i) \
        __builtin_amdgcn_global_load_lds((const unsigned*)((const char*)(gbase) + (voff)[_i]), (PG8_LAS unsigned*)(lds + (bufoff) + ldsw + _i * 8192), 16, 0, 0); } while (0)
#define PG8_LDA(dst, b, h) do { _Pragma("unroll") for (int m = 0; m < 4; ++m) _Pragma("unroll") for (int k = 0; k < 2; ++k) dst[m][k] = *(const PG8_LAS bf16x8*)(lds + PG8_SA(b, h) + aoff + m * 2048 + k * 1024); } while (0)
#define PG8_LDB(dst, b, h) do { _Pragma("unroll") for (int n = 0; n < 2; ++n) _Pragma("unroll") for (int k = 0; k < 2; ++k) dst[n][k] = *(const PG8_LAS bf16x8*)(lds + PG8_SB(b, h) + boff + n * 2048 + k * 1024); } while (0)
#define PG8_MMA(ai, bj, At, Bt) do { __builtin_amdgcn_s_setprio(1); _Pragma("unroll") for (int m = 0; m < 4; ++m) _Pragma("unroll") for (int n = 0; n < 2; ++n) _Pragma("unroll") for (int k = 0; k < 2; ++k) \
        acc[ai][bj][m][n] = __builtin_amdgcn_mfma_f32_16x16x32_bf16(Bt[n][k], At[m][k], acc[ai][bj][m][n], 0, 0, 0); __builtin_amdgcn_s_setprio(0); } while (0)
#define PG8_WAIT_V(n) asm volatile("s_waitcnt vmcnt(" #n ")" ::: "memory")
#define PG8_WAIT_L(n) asm volatile("s_waitcnt lgkmcnt(" #n ")" ::: "memory")
#define PG8_BAR __builtin_amdgcn_s_barrier()
#define PG8_SCHED __builtin_amdgcn_sched_barrier(0)
    Unit cur, nxt; int ui = 0;
    if (!S.next(0, cur)) return;
    f32x4 acc[2][2][4][2];
#pragma unroll
    for (int a = 0; a < 2; ++a)
#pragma unroll
        for (int b = 0; b < 2; ++b)
#pragma unroll
            for (int m = 0; m < 4; ++m)
#pragma unroll
                for (int n = 0; n < 2; ++n) acc[a][b][m][n] = (f32x4){0.f, 0.f, 0.f, 0.f};
    bf16x8 At[4][2], B0[2][2], B1[2][2];
    const char* cA = (const char*)g.A + (size_t)cur.pm * tstep; const char* cB = (const char*)g.Bt + (size_t)cur.pn * tstep;
    S.a_ready(cur);
    if constexpr (SP2) {
        PG8_STAGE(PG8_SB(0, 0), cB, voffB); PG8_STAGE(PG8_SB(0, 1), cB + hstep, voffB); PG8_STAGE(PG8_SA(0, 0), cA, voffA); PG8_STAGE(PG8_SA(0, 1), cA + hstep, voffA);
        if (wr == 1) PG8_BAR;
        PG8_WAIT_V(2); PG8_BAR;
        PG8_STAGE(PG8_SB(1, 0), cB + kstep, voffB); PG8_STAGE(PG8_SA(1, 0), cA + kstep, voffA); PG8_STAGE(PG8_SB(1, 1), cB + hstep + kstep, voffB);
        PG8_WAIT_V(6); PG8_BAR;
    } else {
        PG8_STAGE(PG8_SB(0, 0), cB, voffB); PG8_STAGE(PG8_SA(0, 0), cA, voffA); PG8_STAGE(PG8_SB(0, 1), cB + hstep, voffB); PG8_STAGE(PG8_SA(0, 1), cA + hstep, voffA);
        if (wr == 1) PG8_BAR;
        PG8_WAIT_V(4); PG8_BAR;
        PG8_STAGE(PG8_SB(1, 0), cB + kstep, voffB); PG8_STAGE(PG8_SA(1, 0), cA + kstep, voffA); PG8_STAGE(PG8_SB(1, 1), cB + hstep + kstep, voffB);
        PG8_WAIT_V(6); PG8_BAR;
    }
    for (;;) {
        const bool has_next = S.next(ui + 1, nxt);
        const char* nA = has_next ? (const char*)g.A + (size_t)nxt.pm * tstep : cA; const char* nB = has_next ? (const char*)g.Bt + (size_t)nxt.pn * tstep : cB;
        for (int t = 0; t < nt; t += 2) {
            if constexpr (Epi::MID) { if (t == nt / 2) E.mid(acc, cur, wr, wc, fr, fq); }
            const bool last = (t == nt - 2);
            const char* a1 = cA + (size_t)(t + 1) * kstep;
            const char* a2 = last ? nA : cA + (size_t)(t + 2) * kstep; const char* b2 = last ? nB : cB + (size_t)(t + 2) * kstep;
            const char* a3 = a2 + kstep; const char* b3 = b2 + kstep;
            if (last && has_next) S.a_ready(nxt);
            if constexpr (SP2) {
            PG8_LDB(B0, 0, 0); PG8_LDB(B1, 0, 1); PG8_SCHED; PG8_LDA(At, 0, 0); PG8_STAGE(PG8_SA(1, 1), a1 + hstep, voffA);
            PG8_WAIT_V(8); PG8_WAIT_L(0); PG8_BAR; PG8_MMA(0, 0, At, B0); PG8_MMA(0, 1, At, B1); PG8_BAR; PG8_SCHED;
            PG8_LDA(At, 0, 1); PG8_STAGE(PG8_SB(0, 0), b2, voffB); PG8_STAGE(PG8_SB(0, 1), b2 + hstep, voffB); PG8_STAGE(PG8_SA(0, 0), a2, voffA);
            PG8_WAIT_V(8); PG8_WAIT_L(0); PG8_BAR; PG8_MMA(1, 0, At, B0); PG8_MMA(1, 1, At, B1); PG8_BAR; PG8_SCHED;
            PG8_LDB(B0, 1, 0); PG8_LDB(B1, 1, 1); PG8_SCHED; PG8_LDA(At, 1, 0); PG8_STAGE(PG8_SA(0, 1), a2 + hstep, voffA);
            PG8_WAIT_V(8); PG8_WAIT_L(0); PG8_BAR; PG8_MMA(0, 0, At, B0); PG8_MMA(0, 1, At, B1); PG8_BAR; PG8_SCHED;
            PG8_LDA(At, 1, 1); PG8_STAGE(PG8_SB(1, 0), b3, voffB); PG8_STAGE(PG8_SB(1, 1), b3 + hstep, voffB); PG8_STAGE(PG8_SA(1, 0), a3, voffA);
            PG8_WAIT_V(8); PG8_WAIT_L(0); PG8_BAR; PG8_MMA(1, 0, At, B0); PG8_MMA(1, 1, At, B1); PG8_BAR; PG8_SCHED;
            } else {
            PG8_LDB(B0, 0, 0); PG8_SCHED; PG8_LDA(At, 0, 0); PG8_STAGE(PG8_SA(1, 1), a1 + hstep, voffA);
            PG8_WAIT_L(8); PG8_BAR; PG8_WAIT_L(0); PG8_MMA(0, 0, At, B0); PG8_BAR; PG8_SCHED;
            PG8_LDB(B1, 0, 1); PG8_STAGE(PG8_SB(0, 0), b2, voffB);
            PG8_BAR; PG8_WAIT_L(0); PG8_MMA(0, 1, At, B1); PG8_BAR;
            PG8_LDA(At, 0, 1); PG8_STAGE(PG8_SA(0, 0), a2, voffA);
            PG8_BAR; PG8_WAIT_L(0); PG8_MMA(1, 0, At, B0); PG8_BAR; PG8_SCHED;
            PG8_STAGE(PG8_SB(0, 1), b2 + hstep, voffB);
            PG8_WAIT_V(6); PG8_BAR; PG8_MMA(1, 1, At, B1); PG8_BAR;
            PG8_LDB(B0, 1, 0); PG8_SCHED; PG8_LDA(At, 1, 0); PG8_STAGE(PG8_SA(0, 1), a2 + hstep, voffA);
            PG8_WAIT_L(8); PG8_BAR; PG8_WAIT_L(0); PG8_MMA(0, 0, At, B0); PG8_BAR; PG8_SCHED;
            PG8_LDB(B1, 1, 1); PG8_STAGE(PG8_SB(1, 0), b3, voffB);
            PG8_BAR; PG8_WAIT_L(0); PG8_MMA(0, 1, At, B1); PG8_BAR;
            PG8_LDA(At, 1, 1); PG8_STAGE(PG8_SA(1, 0), a3, voffA);
            PG8_BAR; PG8_WAIT_L(0); PG8_MMA(1, 0, At, B0); PG8_BAR; PG8_SCHED;
            PG8_STAGE(PG8_SB(1, 1), b3 + hstep, voffB);
            PG8_WAIT_V(6); PG8_BAR; PG8_MMA(1, 1, At, B1); PG8_BAR;
            }
        }
        if constexpr (ALIGN_EPI) { if (wr == 0) PG8_BAR; }
        if constexpr (!Epi::AFTER_DRAIN) { E(acc, cur, wr, wc, fr, fq); S.done(cur); }
        if (!has_next) break;
#pragma unroll
        for (int a = 0; a < 2; ++a)
#pragma unroll
            for (int b = 0; b < 2; ++b)
#pragma unroll
                for (int m = 0; m < 4; ++m)
#pragma unroll
                    for (int n = 0; n < 2; ++n) acc[a][b][m][n] = (f32x4){0.f, 0.f, 0.f, 0.f};
        cur = nxt; cA = nA; cB = nB; ++ui;
        if constexpr (ALIGN_EPI) { if (wr == 1) PG8_BAR; }
    }
    PG8_WAIT_V(0);
    if constexpr (!ALIGN_EPI) { if (wr == 0) PG8_BAR; }
    PG8_BAR;
    if constexpr (Epi::AFTER_DRAIN) { E.fused(acc, cur, wr, wc, fr, fq, lds, wid, lane); S.done(cur); }
#undef PG8_SA
#undef PG8_SB
#undef PG8_STAGE
#undef PG8_LDA
#undef PG8_LDB
#undef PG8_MMA
#undef PG8_WAIT_V
#undef PG8_WAIT_L
#undef PG8_BAR
#undef PG8_SCHED
}
}

#ifndef PG8_SP2
#define PG8_SP2 true
#endif
#ifndef PG8_ALIGN
#define PG8_ALIGN true
#endif
#include <hip/hip_bf16.h>
#include <cmath>
namespace attn_body {
using bf16=__hip_bfloat16;
using bf16x8=__attribute__((ext_vector_type(8)))short;
using s16x4=__attribute__((ext_vector_type(4)))short;
using f32x16=__attribute__((ext_vector_type(16)))float;
using u32x4=__attribute__((ext_vector_type(4)))unsigned;
using f32x4v=__attribute__((ext_vector_type(4)))float;
constexpr int BATCH=8,NHEAD=8,SEQ=4096,D=64,DM=NHEAD*D;
constexpr int NW=8,QBLK=32,QB=QBLK*NW,KVBLK=64,NQB=SEQ/QB;
constexpr int ATTN_PITCH=DM, ATTN_UNIT_ROWS=QB, OPITCH=1024;
__device__ __forceinline__ int crow(int r,int hi){return (r&3)+8*(r>>2)+4*hi;}
#define SBAR() __builtin_amdgcn_sched_barrier(0)
__device__ __forceinline__ void cmask(f32x16&p0,f32x16&p1,int jb,int qrel,int hi){
  const float NEG=-INFINITY; int kb=64*jb+4*hi;
  #pragma unroll
  for(int r=0;r<16;++r){int kv=kb+(r&3)+8*(r>>2); if(kv>qrel)p0[r]=NEG; if(kv+32>qrel)p1[r]=NEG;}
}

constexpr int NSLOT=3, SLOTB=8192;
constexpr int LDS_K=0, LDS_V=NSLOT*SLOTB, LDS_WS=2*NSLOT*SLOTB, LDS_OST=LDS_WS+NW*64*4, LDS_BIAS=LDS_OST+NW*4096, LDS_BYTES=LDS_BIAS+SEQ*4;
constexpr float C2=0.125f*1.4426950408889634f;
__device__ __forceinline__ void glds16(const void*gsrc,unsigned lds_dst){unsigned keep;
  asm volatile("s_mov_b32 %0, m0\n\ts_mov_b32 m0, %2\n\ts_nop 0\n\tglobal_load_lds_dwordx4 %1, off\n\ts_mov_b32 m0, %0":"=&s"(keep):"v"(gsrc),"s"(lds_dst):"memory");}
__device__ __forceinline__ float max3f(float a,float b,float c){float r;asm("v_max3_f32 %0, %1, %2, %3":"=v"(r):"v"(a),"v"(b),"v"(c));return r;}
__device__ __forceinline__ float max2f(float a,float b){float r;asm("v_max_f32_e32 %0, %1, %2":"=v"(r):"v"(a),"v"(b));return r;}
__device__ __forceinline__ float fadd_s(float a,float b){float r;asm("v_add_f32_e32 %0, %1, %2":"=v"(r):"v"(a),"v"(b));return r;}
__device__ __forceinline__ float fsub_s(float a,float b){float r;asm("v_sub_f32_e32 %0, %1, %2":"=v"(r):"v"(a),"v"(b));return r;}
typedef float f32x2_t __attribute__((ext_vector_type(2))); typedef __bf16 bf16x2_t __attribute__((ext_vector_type(2)));
__device__ __forceinline__ unsigned cvtpk_s(float lo,float hi){f32x2_t v={lo,hi};bf16x2_t b=__builtin_convertvector(v,bf16x2_t);return __builtin_bit_cast(unsigned,b);}
#define WAIT_BAR(N) asm volatile("s_waitcnt vmcnt(" #N ") lgkmcnt(0)\n\ts_barrier":::"memory")

__device__ __forceinline__ void qkt(f32x16&p0,f32x16&p1,const char*Kslot,const bf16x8*qr,int r32,int hi){
  const char*kb=Kslot+hi*1024+r32*16;
  #pragma unroll
  for(int d0=0;d0<4;++d0){
    const bf16x8 b0=*reinterpret_cast<const bf16x8*>(kb+d0*2048);
    const bf16x8 b1=*reinterpret_cast<const bf16x8*>(kb+d0*2048+512);
    p0=__builtin_amdgcn_mfma_f32_32x32x16_bf16(b0,qr[d0],p0,0,0,0);p1=__builtin_amdgcn_mfma_f32_32x32x16_bf16(b1,qr[d0],p1,0,0,0);}
}
typedef __attribute__((address_space(3))) const char* lds_cptr;
typedef short v4i16_t __attribute__((ext_vector_type(4)));
__device__ __forceinline__ void kload8(bf16x8*kf,lds_cptr kp){
  kf[0]=*(const __attribute__((address_space(3))) bf16x8*)(kp);      kf[1]=*(const __attribute__((address_space(3))) bf16x8*)(kp+512);
  kf[2]=*(const __attribute__((address_space(3))) bf16x8*)(kp+2048); kf[3]=*(const __attribute__((address_space(3))) bf16x8*)(kp+2560);
  kf[4]=*(const __attribute__((address_space(3))) bf16x8*)(kp+4096); kf[5]=*(const __attribute__((address_space(3))) bf16x8*)(kp+4608);
  kf[6]=*(const __attribute__((address_space(3))) bf16x8*)(kp+6144); kf[7]=*(const __attribute__((address_space(3))) bf16x8*)(kp+6656);
}
__device__ __forceinline__ void kload2(bf16x8*kf,lds_cptr kp,int j){ kf[2*j]=*(const __attribute__((address_space(3))) bf16x8*)(kp+j*2048); kf[2*j+1]=*(const __attribute__((address_space(3))) bf16x8*)(kp+j*2048+512); }
__device__ __forceinline__ s16x4 vtr(lds_cptr p){ return __builtin_bit_cast(s16x4,__builtin_amdgcn_ds_read_tr16_b64_v4i16((__attribute__((address_space(3))) v4i16_t*)p)); }
__device__ __forceinline__ float rowmax(const f32x16&p0,const f32x16&p1){
  float a=max3f(p0[0],p0[1],p1[0]),b=max3f(p0[2],p0[3],p1[1]);a=max3f(a,p1[2],p1[3]);
  #pragma unroll
  for(int r=4;r<16;r+=4){a=max3f(a,p0[r],p0[r+1]);b=max3f(b,p0[r+2],p0[r+3]);a=max3f(a,p1[r],p1[r+1]);b=max3f(b,p1[r+2],p1[r+3]);}
  const float m=max2f(a,b);
  auto rr=__builtin_amdgcn_permlane32_swap(__float_as_uint(m),__float_as_uint(m),false,false);
  return max2f(__uint_as_float(rr[0]),__uint_as_float(rr[1]));
}
__device__ __forceinline__ void pv(f32x16*o,int vb,bf16x8 pa0,bf16x8 pa1,bf16x8 pa2,bf16x8 pa3){
  #pragma unroll
  for(int d0=0;d0<2;++d0){s16x4 lo[4],hi[4];
    #pragma unroll
    for(int ks=0;ks<4;++ks){
      asm volatile("ds_read_b64_tr_b16 %0,%1 offset:%c2":"=&v"(lo[ks]):"v"(vb),"i"(d0*4096+ks*1024):"memory");
      asm volatile("ds_read_b64_tr_b16 %0,%1 offset:%c2":"=&v"(hi[ks]):"v"(vb),"i"(d0*4096+ks*1024+512):"memory");}
    asm volatile("s_waitcnt lgkmcnt(0)":::"memory");SBAR();
    #define PK(k) (bf16x8){lo[k][0],lo[k][1],lo[k][2],lo[k][3],hi[k][0],hi[k][1],hi[k][2],hi[k][3]}
    o[d0]=__builtin_amdgcn_mfma_f32_32x32x16_bf16(pa0,PK(0),o[d0],0,0,0);
    o[d0]=__builtin_amdgcn_mfma_f32_32x32x16_bf16(pa1,PK(1),o[d0],0,0,0);
    o[d0]=__builtin_amdgcn_mfma_f32_32x32x16_bf16(pa2,PK(2),o[d0],0,0,0);
    o[d0]=__builtin_amdgcn_mfma_f32_32x32x16_bf16(pa3,PK(3),o[d0],0,0,0);
    #undef PK
  }
}

#ifndef ATTN_STORE16
#define ATTN_STORE16(p,v) (*(u32x4*)(p)=(v))
#endif
struct AttnTensors { unsigned char* ws; size_t oq,ok,ov,oz,olf,oo,obias,oj0; float gap,hdr; };
template<int THRL> __device__ __forceinline__ void attn_unit(int b,int h,int qb,int j0,f32x4v brow0,f32x4v brow1,unsigned*ctr,unsigned&nxt,const AttnTensors&T_,char*shm){
  const bf16*Q=(const bf16*)(T_.ws+T_.oq); const bf16*__restrict__ K=(const bf16*)(T_.ws+T_.ok); const bf16*__restrict__ V=(const bf16*)(T_.ws+T_.ov);
  const int tid=threadIdx.x,lane=tid&63,r32=lane&31,hi=lane>>5; const int wid=__builtin_amdgcn_readfirstlane(tid>>6);
  const long rowbase=(long)b*SEQ; const int q0=qb*QB;
  const bf16*Qw=Q+(rowbase+q0+wid*QBLK)*DM+h*D;
  const bf16*Kh=K+(rowbase+(long)j0*KVBLK)*DM+h*D,*Vh=V+(rowbase+(long)j0*KVBLK)*DM+h*D;
  const unsigned lds0=(unsigned)(uintptr_t)shm;
  float*wsf=(float*)(shm+LDS_WS)+wid*64;
  const bf16*ksrc=Kh+(long)lane*DM+wid*8;
  const bf16*vsrc=Vh+(long)(16*(wid&3)+(lane>>2))*DM+(wid>>2)*32+(lane&3)*8;
  const unsigned kdst=lds0+LDS_K+wid*1024, vdst=lds0+LDS_V+wid*1024;
  #define DMA_K(t,slot) glds16(ksrc+(long)(t)*KVBLK*DM,(unsigned)__builtin_amdgcn_readfirstlane(kdst+(slot)))
  #define DMA_V(t,slot) glds16(vsrc+(long)(t)*KVBLK*DM,(unsigned)__builtin_amdgcn_readfirstlane(vdst+(slot)))
  const int vb0=(int)(lds0+LDS_V)+((lane>>4)&1)*32+(lane&3)*8+(4*hi+((lane&15)>>2))*64;
  const char*Kbase=shm+LDS_K; bf16x8 kf[8];
  const lds_cptr shm3=(lds_cptr)shm; const lds_cptr kp0=shm3+LDS_K+hi*1024+r32*16; const lds_cptr vp0=shm3+LDS_V+((lane>>4)&1)*32+(lane&3)*8+(4*hi+((lane&15)>>2))*64;
  const int NT=(q0+QB)/KVBLK-j0;
  DMA_K(0,0);DMA_V(0,0);DMA_K(1,SLOTB);
  bf16x8 qr[4];
  #pragma unroll
  for(int d0=0;d0<4;++d0)qr[d0]=*reinterpret_cast<const bf16x8*>(&Qw[(long)r32*DM+d0*16+hi*8]);
  float mhat=0.f,l_reg=0.f;f32x16 o[2];o[0]=f32x16{};o[1]=f32x16{};
  const lds_cptr bp0=shm3+LDS_BIAS+hi*16+j0*256;
  #define BL(P,t,g,off) do{ const f32x4v a_=*(const __attribute__((address_space(3))) f32x4v*)(bp0+(t)*256+(off)+(g)*32); P[4*(g)]=a_[0];P[4*(g)+1]=a_[1];P[4*(g)+2]=a_[2];P[4*(g)+3]=a_[3]; }while(0)
  #define BS(P,g) do{ P[4*(g)]-=mhat;P[4*(g)+1]-=mhat;P[4*(g)+2]-=mhat;P[4*(g)+3]-=mhat; }while(0)
  #define BINIT(P0,P1,t) do{ _Pragma("unroll") for(int g_=0;g_<4;++g_){BL(P0,t,g_,0);BL(P1,t,g_,128);} _Pragma("unroll") for(int g_=0;g_<4;++g_){BS(P0,g_);BS(P1,g_);} }while(0)
  const int qrel=wid*QBLK+r32;
  #define CMASK(P0,P1,t) do{int jb_=(t)-(NT-4); if(jb_>=0)cmask(P0,P1,jb_,qrel,hi);}while(0)
  bool resc=false;
  #define START(P0,P1) do{ resc=false; \
    if(THRL>=0){ const float rm=rowmax(P0,P1); if(__builtin_expect(__any(rm>(float)THRL),0)){ const float dl=__builtin_fmaxf(rm,0.f); mhat=fadd_s(mhat,dl); \
      _Pragma("unroll") for(int r=0;r<16;++r){P0[r]=fsub_s(P0[r],dl);P1[r]=fsub_s(P1[r],dl);} } } \
    _Pragma("unroll") for(int r=0;r<16;++r)P0[r]=__builtin_amdgcn_exp2f(P0[r]); }while(0)
  #define RESC() do{ if(resc){ asm volatile("s_waitcnt lgkmcnt(0)":::"memory"); \
      _Pragma("unroll") for(int d_=0;d_<2;++d_) _Pragma("unroll") for(int r=0;r<16;++r)o[d_][r]*=wsf[crow(r,hi)]; } }while(0)
  f32x16 pA0,pA1,pB0,pB1;
  int sl_prev=0,sl_cur=0,sl_next=SLOTB;
  #define ROT() do{sl_prev=sl_cur;sl_cur=sl_next;sl_next=(sl_next==(NSLOT-1)*SLOTB)?0:sl_next+SLOTB;}while(0)
  DMA_K(2,2*SLOTB);
  { __attribute__((address_space(3))) f32x4v*bd=(__attribute__((address_space(3))) f32x4v*)((__attribute__((address_space(3))) char*)shm+LDS_BIAS)+tid*2; bd[0]=brow0; bd[1]=brow1; }
  if(tid==0)nxt=gridDim.x+__hip_atomic_fetch_add(ctr,1u,__ATOMIC_RELAXED,__HIP_MEMORY_SCOPE_AGENT);
  WAIT_BAR(3);
  mhat=((const __attribute__((address_space(3))) float*)(shm3+LDS_BIAS))[q0+qrel]+T_.hdr;
  BINIT(pA0,pA1,0);
  qkt(pA0,pA1,Kbase,qr,r32,hi);asm volatile("s_nop 15\n\ts_nop 7":"+v"(pA0),"+v"(pA1));CMASK(pA0,pA1,0);
  START(pA0,pA1);
  BINIT(pB0,pB1,1);
  _Pragma("unroll") for(int r=0;r<16;++r)pA1[r]=__builtin_amdgcn_exp2f(pA1[r]);
  WAIT_BAR(0);
  DMA_K(3,0);DMA_V(1,SLOTB);
  ROT();
  kload8(kf,kp0+sl_cur);
  WAIT_BAR(2);
  s16x4 vlo[8],vhi[8]; u32x4 pw0,pw1,pw2,pw3;
  #define PKW(P,B) cvtpk_s(P[B],P[B+1])
  #define PAF(k) __builtin_bit_cast(bf16x8,pw##k)
  #define VFR(i) (bf16x8){vlo[i][0],vlo[i][1],vlo[i][2],vlo[i][3],vhi[i][0],vhi[i][1],vhi[i][2],vhi[i][3]}
  #define PIN(x) asm volatile("":"+v"(x))
  #define MX3(a,b,c) __builtin_fmaxf(__builtin_fmaxf((a),(b)),(c))
  #define GAPA(MF,A0,A1,A2,A3,W0,W1,PW) do{ MF; sacc+=A0; sacc+=A1; sacc+=A2; sacc+=A3; PIN(sacc); W0; W1; PIN(PW); SBAR(); }while(0)
  #define EX(v) __builtin_amdgcn_exp2f(v)
  #define GAPB(MF,X,B,E0,E1) do{ MF; X[B]=EX(X[B]); X[B+1]=EX(X[B+1]); X[B+2]=EX(X[B+2]); X[B+3]=EX(X[B+3]); PIN(X); E0; E1; SBAR(); }while(0)
  #define BLG(G,P,t,g,off) do{ if(G){ BL(P,t,g,off); } }while(0)
  #define BSG(G,P,g) do{ if(G){ BS(P,g); } }while(0)
  #define VRD(i) do{ vlo[i]=vtr(vp_+(((i)>>2)*4096+((i)&3)*1024)); vhi[i]=vtr(vp_+(((i)>>2)*4096+((i)&3)*1024+512)); }while(0)
  #define KRD(G,j) do{ if(G){ kload2(kf,kp0+sl_next,j); SBAR(); } }while(0)
  #define STEP(C0,C1,P0,P1,t,GK,GV,GL) do{ SBAR(); \
    const lds_cptr vp_=vp0+sl_prev; \
    VRD(0); SBAR(); float sacc=(P0[0]+P0[1]); \
    GAPA(C0=__builtin_amdgcn_mfma_f32_32x32x16_bf16(kf[0],qr[0],C0,0,0,0), P0[2],P0[3],P0[4],P0[5],     pw0[0]=PKW(P0,0), pw0[1]=PKW(P0,2), pw0); \
    VRD(4); SBAR(); GAPA(C1=__builtin_amdgcn_mfma_f32_32x32x16_bf16(kf[1],qr[0],C1,0,0,0), P0[6],P0[7],P0[8],P0[9],     pw0[2]=PKW(P0,4), pw0[3]=PKW(P0,6), pw0); \
    VRD(1); SBAR(); GAPA(C0=__builtin_amdgcn_mfma_f32_32x32x16_bf16(kf[2],qr[1],C0,0,0,0),   P0[10],P0[11],P0[12],P0[13], pw1[0]=PKW(P0,8), pw1[1]=PKW(P0,10), pw1); \
    VRD(5); SBAR(); GAPA(C1=__builtin_amdgcn_mfma_f32_32x32x16_bf16(kf[3],qr[1],C1,0,0,0),   P0[14],P0[15],P1[0],P1[1],   pw1[2]=PKW(P0,12),pw1[3]=PKW(P0,14), pw1); \
    VRD(2); SBAR(); GAPA(C0=__builtin_amdgcn_mfma_f32_32x32x16_bf16(kf[4],qr[2],C0,0,0,0),   P1[2],P1[3],P1[4],P1[5],     pw2[0]=PKW(P1,0), pw2[1]=PKW(P1,2), pw2); \
    VRD(6); SBAR(); GAPA(C1=__builtin_amdgcn_mfma_f32_32x32x16_bf16(kf[5],qr[2],C1,0,0,0),   P1[6],P1[7],P1[8],P1[9],     pw2[2]=PKW(P1,4), pw2[3]=PKW(P1,6), pw2); \
    VRD(3); SBAR(); GAPA(C0=__builtin_amdgcn_mfma_f32_32x32x16_bf16(kf[6],qr[3],C0,0,0,0),   P1[10],P1[11],P1[12],P1[13], pw3[0]=PKW(P1,8), pw3[1]=PKW(P1,10), pw3); \
    VRD(7); SBAR(); GAPA(C1=__builtin_amdgcn_mfma_f32_32x32x16_bf16(kf[7],qr[3],C1,0,0,0),   P1[14],P1[15],0.f,0.f,       pw3[2]=PKW(P1,12),pw3[3]=PKW(P1,14), pw3); \
    l_reg+=sacc; \
    if(GK){DMA_K((t)+3,sl_cur);} if(GV){DMA_V((t)+1,sl_next);} \
    CMASK(C0,C1,t); \
    if(THRL>=0){ float a=MX3(C0[0],C0[1],C1[0]),b=MX3(C0[2],C0[3],C1[1]); a=MX3(a,C1[2],C1[3]); \
      _Pragma("unroll") for(int r=4;r<16;r+=4){a=MX3(a,C0[r],C0[r+1]);b=MX3(b,C0[r+2],C0[r+3]);a=MX3(a,C1[r],C1[r+1]);b=MX3(b,C1[r+2],C1[r+3]);} \
      float rm=__builtin_fmaxf(a,b); { auto rr=__builtin_amdgcn_permlane32_swap(__float_as_uint(rm),__float_as_uint(rm),false,false); rm=__builtin_fmaxf(__uint_as_float(rr[0]),__uint_as_float(rr[1])); } \
      resc=false; \
      if(__builtin_expect(__any(rm>(float)THRL),0)){ const float dl=__builtin_fmaxf(rm,0.f); mhat+=dl; \
        _Pragma("unroll") for(int r=0;r<16;++r){C0[r]-=dl;C1[r]-=dl;} \
        const float f=__builtin_amdgcn_exp2f(-dl); l_reg*=f; if(hi==0)wsf[r32]=f; resc=true; } } \
    SBAR(); \
    GAPB(o[0]=__builtin_amdgcn_mfma_f32_32x32x16_bf16(PAF(0),VFR(0),o[0],0,0,0), C0,0,  BLG(GL,P0,(t)+1,0,0),  BLG(GL,P0,(t)+1,1,0)); \
    GAPB(o[1]=__builtin_amdgcn_mfma_f32_32x32x16_bf16(PAF(0),VFR(4),o[1],0,0,0), C0,4,  BLG(GL,P0,(t)+1,2,0),  BLG(GL,P0,(t)+1,3,0)); \
    KRD(GL,0); GAPB(o[0]=__builtin_amdgcn_mfma_f32_32x32x16_bf16(PAF(1),VFR(1),o[0],0,0,0), C0,8,  BLG(GL,P1,(t)+1,0,128), BLG(GL,P1,(t)+1,1,128)); \
    KRD(GL,1); GAPB(o[1]=__builtin_amdgcn_mfma_f32_32x32x16_bf16(PAF(1),VFR(5),o[1],0,0,0), C0,12, BLG(GL,P1,(t)+1,2,128), BLG(GL,P1,(t)+1,3,128)); \
    KRD(GL,2); GAPB(o[0]=__builtin_amdgcn_mfma_f32_32x32x16_bf16(PAF(2),VFR(2),o[0],0,0,0), C1,0,  BSG(GL,P0,0), BSG(GL,P0,1)); \
    KRD(GL,3); GAPB(o[1]=__builtin_amdgcn_mfma_f32_32x32x16_bf16(PAF(2),VFR(6),o[1],0,0,0), C1,4,  BSG(GL,P0,2), BSG(GL,P0,3)); \
    GAPB(o[0]=__builtin_amdgcn_mfma_f32_32x32x16_bf16(PAF(3),VFR(3),o[0],0,0,0), C1,8,  BSG(GL,P1,0), BSG(GL,P1,1)); \
    GAPB(o[1]=__builtin_amdgcn_mfma_f32_32x32x16_bf16(PAF(3),VFR(7),o[1],0,0,0), C1,12, BSG(GL,P1,2), BSG(GL,P1,3)); \
    }while(0)
  int t=1;
  #undef CMASK
  #define CMASK(P0,P1,t) do{}while(0)
  for(;t+5<NT;t+=2){
    STEP(pB0,pB1,pA0,pA1,t,true,true,true);     WAIT_BAR(2); RESC(); ROT();
    STEP(pA0,pA1,pB0,pB1,t+1,true,true,true);   WAIT_BAR(2); RESC(); ROT();
  }
  #undef CMASK
  #define CMASK(P0,P1,t) do{int jb_=(t)-(NT-4); if(jb_>=0)cmask(P0,P1,jb_,qrel,hi);}while(0)
  #define ENDW(tt) do{ if((tt)+3<NT){WAIT_BAR(2);} else if((tt)+2<NT){WAIT_BAR(1);} else {WAIT_BAR(0);} }while(0)
  for(;t+1<NT;t+=2){
    STEP(pB0,pB1,pA0,pA1,t,(t+3<NT),(t+1<NT),(t+1<NT));       ENDW(t);   RESC(); ROT();
    STEP(pA0,pA1,pB0,pB1,t+1,(t+4<NT),(t+2<NT),(t+2<NT));     ENDW(t+1); RESC(); ROT();
  }
  STEP(pB0,pB1,pA0,pA1,NT-1,false,false,false); RESC();
  const bf16*Zw=(const bf16*)(T_.ws+T_.oz)+(rowbase+q0+wid*QBLK)*DM+h*D;
  u32x4 zv[4];
  #pragma unroll
  for(int i=0;i<4;++i)zv[i]=*(const u32x4*)(Zw+(long)(i*8+(lane>>3))*DM+(lane&7)*8);
  { float sacc=pB0[0]+pB0[1]; _Pragma("unroll") for(int r=2;r<16;++r)sacc+=pB0[r]; _Pragma("unroll") for(int r=0;r<16;++r)sacc+=pB1[r]; l_reg+=sacc;
    pw0=(u32x4){PKW(pB0,0),PKW(pB0,2),PKW(pB0,4),PKW(pB0,6)};pw1=(u32x4){PKW(pB0,8),PKW(pB0,10),PKW(pB0,12),PKW(pB0,14)};pw2=(u32x4){PKW(pB1,0),PKW(pB1,2),PKW(pB1,4),PKW(pB1,6)};pw3=(u32x4){PKW(pB1,8),PKW(pB1,10),PKW(pB1,12),PKW(pB1,14)};
    SBAR(); pv(o,vb0+sl_cur,PAF(0),PAF(1),PAF(2),PAF(3)); }
  #undef PKW
  #undef PAF
  #undef VFR
  #undef PIN
  #undef MX3
  #undef GAPA
  #undef GAPB
  #undef EX
  #undef VRD
  #undef KRD
  #undef STEP
  #undef ENDW
  {auto rr=__builtin_amdgcn_permlane32_swap(__float_as_uint(l_reg),__float_as_uint(l_reg),false,false);l_reg=__uint_as_float(rr[0])+__uint_as_float(rr[1]);}
  if(hi==0)wsf[32+r32]=l_reg;asm volatile("s_waitcnt lgkmcnt(0)":::"memory");
  float rli[16];
  #pragma unroll
  for(int r=0;r<16;++r)rli[r]=__builtin_amdgcn_rcpf(wsf[32+crow(r,hi)]);
  bf16*Ow=(bf16*)(T_.ws+T_.oo)+(rowbase+q0+wid*QBLK)*OPITCH+h*D;
  { bf16*stg=(bf16*)(shm+LDS_OST)+wid*2048;
    #pragma unroll
    for(int r=0;r<16;++r){const int orow=crow(r,hi);
      #pragma unroll
      for(int d0=0;d0<2;++d0)stg[orow*64+d0*32+r32]=__float2bfloat16(o[d0][r]*rli[r]);}
    asm volatile("s_waitcnt lgkmcnt(0)":::"memory");
    #pragma unroll
    for(int i=0;i<4;++i){const int row=i*8+(lane>>3),ch=lane&7; u32x4 v=*(const u32x4*)(stg+row*64+ch*8);
      #pragma unroll
      for(int e=0;e<4;++e){ const float a0=__uint_as_float(v[e]<<16)*__uint_as_float(zv[i][e]<<16), a1=__uint_as_float(v[e]&0xffff0000u)*__uint_as_float(zv[i][e]&0xffff0000u); v[e]=cvtpk_s(a0,a1); }
      ATTN_STORE16(Ow+(long)row*OPITCH+ch*8,v);} }
  asm volatile("s_waitcnt lgkmcnt(0)\n\ts_barrier":::"memory");
  #undef DMA_K
  #undef DMA_V
  #undef CMASK
  #undef START
  #undef RESC
  #undef ROT
  #undef BL
  #undef BS
  #undef BINIT
  #undef BLG
  #undef BSG
}
constexpr int ATTN_LDS_BYTES=LDS_BYTES;
struct AttnUnit { int bh; int qb; };
__device__ __forceinline__ void bias_scan(char*shm,const float*__restrict__ lf,float*gdst=nullptr){
  const int tid=threadIdx.x,lane=tid&63,wid=tid>>6;
  float*bias=(float*)(shm+LDS_BIAS); float*wtot=(float*)(shm+LDS_WS);
  const f32x4v a=*(const f32x4v*)(lf+tid*8),b=*(const f32x4v*)(lf+tid*8+4);
  const float s0=a[0],s1=s0+a[1],s2=s1+a[2],s3=s2+a[3],s4=s3+b[0],s5=s4+b[1],s6=s5+b[2],s7=s6+b[3];
  float inc=s7;
  #pragma unroll
  for(int o=1;o<64;o<<=1){const float t=__shfl_up(inc,o); if(lane>=o)inc+=t;}
  if(lane==63)wtot[wid]=inc;
  asm volatile("s_waitcnt lgkmcnt(0)\n\ts_barrier":::"memory");
  float base=0.f;
  #pragma unroll
  for(int w=0;w<NW;++w){const float x=wtot[w]; if(w<wid)base+=x;}
  const float off=base+inc-s7; const float NL=-1.4426950408889634f;
  *(f32x4v*)(bias+tid*8)=(f32x4v){(off+s0)*NL,(off+s1)*NL,(off+s2)*NL,(off+s3)*NL};
  *(f32x4v*)(bias+tid*8+4)=(f32x4v){(off+s4)*NL,(off+s5)*NL,(off+s6)*NL,(off+s7)*NL};
  if(gdst){ *(f32x4v*)(gdst+tid*8)=(f32x4v){(off+s0)*NL,(off+s1)*NL,(off+s2)*NL,(off+s3)*NL}; *(f32x4v*)(gdst+tid*8+4)=(f32x4v){(off+s4)*NL,(off+s5)*NL,(off+s6)*NL,(off+s7)*NL}; }
  asm volatile("s_waitcnt lgkmcnt(0)\n\ts_barrier":::"memory");
}
__device__ __forceinline__ void j0_table(const char*shm,float gap,int*dst,int wave,int lane){
  const __attribute__((address_space(3))) float*bl=(const __attribute__((address_space(3))) float*)((const __attribute__((address_space(3))) char*)shm+LDS_BIAS);
  const float v=bl[64*lane+63];
  #pragma unroll
  for(int q=0;q<2;++q){ const int qb=2*wave+q; const float thr=bl[QB*qb]-gap; const unsigned long long mk=__ballot(v>=thr);
    int j0=mk?(int)__builtin_ctzll(mk):0; j0&=~1; const int jmax=4*qb; j0=j0<jmax?j0:jmax; if(lane==0)dst[qb]=j0; }
}
constexpr int LDS_J0=LDS_BIAS+SEQ*4;
static_assert(LDS_J0+4096<=131072,"attention LDS");
template<int THRL,class Extra> __device__ __forceinline__ void attn_phase_dyn(char*lds,const AttnTensors&T,unsigned*ctr,const Extra&X,int nextra){
  const int tid=threadIdx.x;
  volatile __attribute__((address_space(3))) unsigned* uw=(volatile __attribute__((address_space(3))) unsigned*)((__attribute__((address_space(3))) char*)lds+LDS_WS);
  volatile __attribute__((address_space(3))) int* jt=(volatile __attribute__((address_space(3))) int*)((__attribute__((address_space(3))) char*)lds+LDS_J0);
  for(int i=tid;i<BATCH*NHEAD*NQB;i+=NW*64)jt[i]=((const int*)(T.ws+T.oj0))[i];
  const unsigned G_=gridDim.x; unsigned nxt=blockIdx.x;
  for(;;){
    if(tid==0){uw[0]=nxt;}
    asm volatile("s_waitcnt lgkmcnt(0)\n\ts_barrier":::"memory");
    const unsigned u=(unsigned)__builtin_amdgcn_readfirstlane((int)uw[0]);
    if(u>=(unsigned)(BATCH*NHEAD*NQB+nextra))break;
    if(u>=(unsigned)(BATCH*NHEAD*NQB)){ if(tid==0)nxt=G_+__hip_atomic_fetch_add(ctr,1u,__ATOMIC_RELAXED,__HIP_MEMORY_SCOPE_AGENT);
      X((int)u-BATCH*NHEAD*NQB); asm volatile("s_waitcnt lgkmcnt(0)\n\ts_barrier":::"memory"); continue; }
    const int qb=NQB-1-(int)(u/(BATCH*NHEAD)), bh=(int)(u%(BATCH*NHEAD));
    const int j0=__builtin_amdgcn_readfirstlane((int)jt[bh*NQB+qb]);
    const f32x4v*src=(const f32x4v*)((const float*)(T.ws+T.obias)+(long)bh*SEQ)+tid*2; const f32x4v ba=src[0],bb=src[1];
    attn_unit<THRL>(bh/NHEAD,bh%NHEAD,qb,j0,ba,bb,ctr,nxt,T,lds);
  }
}
#undef SBAR
#undef WAIT_BAR
}
constexpr int NWAVES = 8;
#ifndef MK_N_LAUNCHES
#define MK_N_LAUNCHES 1
#endif
constexpr int N_LAUNCHES = MK_N_LAUNCHES;
constexpr int PER_PHASE = 6;

constexpr int BATCH = 8, T = 4096, D = 1024, H = 8, HD = 64, AW = 512, CW = 512, INW = 6152, NPROJ = 6144;
constexpr int M = BATCH * T;
constexpr float EPS = 1e-6f;
constexpr int SRC_F = 1536;

constexpr size_t MiB = 1u << 20;
constexpr size_t WS_ADA = 0;
constexpr size_t WS_WF = 128 * 1024;
constexpr size_t WS_CTL = 256 * 1024;
constexpr int CW_ATTNQ = 3456 + 128;
constexpr size_t WS_LF = 1 * MiB;
constexpr size_t WS_W1 = 2 * MiB;
constexpr size_t WS_WAB = 14 * MiB, WS_WO = 16 * MiB;
constexpr size_t WS_HB = 32 * MiB;
constexpr size_t WS_OAB = WS_HB;
constexpr size_t WS_Q = pg8::OFF_Q;
constexpr size_t WS_K = pg8::OFF_K, WS_V = pg8::OFF_V;
constexpr size_t WS_MG = WS_K;
constexpr size_t WS_SZA = pg8::OFF_SZA, WS_CU = pg8::OFF_CU, WS_GZ = pg8::OFF_GZ;
constexpr size_t WS_R = pg8::OFF_SGA, WS_SGB = pg8::OFF_SGB;
constexpr size_t WS_BIAS = 448 * MiB;
constexpr size_t WS_J0 = 449 * MiB;
constexpr size_t WS_END = 450 * MiB;

constexpr int RING_OFF = 0, RING_BYTES = 131072;
constexpr int MISC_OFF = RING_BYTES + 320;
constexpr int LDS_BYTES = 147456;
static_assert(attn_body::ATTN_LDS_BYTES <= RING_BYTES, "attention LDS");

#define GAS __attribute__((address_space(1)))
#define LAS __attribute__((address_space(3)))
typedef unsigned short bf16;
typedef unsigned v4u __attribute__((ext_vector_type(4)));
typedef float f32x4 __attribute__((ext_vector_type(4)));
#define LDS_WAIT() asm volatile("s_waitcnt lgkmcnt(0)" ::: "memory")
__device__ __forceinline__ unsigned pk2(float lo, float hi) { return pg8::cvt_pk_bf16(lo, hi); }
__device__ __forceinline__ float wave_sum(float v) {
#pragma unroll
    for (int o = 1; o < 64; o <<= 1) v += __shfl_xor(v, o);
    return v;
}

template <bool MAP> __device__ __forceinline__ void p0_transpose_item(const float* W, int K, int NS, bf16* WT, LAS float* scr, int item, int nkb, int lane) {
    const int pb = item / nkb, kb = item % nkb, k0 = 64 * kb, p0 = 32 * pb;
    const int sc = MAP ? pg8::proj_src_col(p0 + (lane & 31)) : p0 + (lane & 31);
#pragma unroll 8
    for (int i = 0; i < 32; ++i) { const int kk = 2 * i + (lane >> 5); scr[kk * 33 + (lane & 31)] = W[(size_t)(k0 + kk) * NS + sc]; }
    LDS_WAIT(); asm volatile("" ::: "memory");
    const int c = lane & 7;
#pragma unroll
    for (int j = 0; j < 4; ++j) { const int n = (lane >> 3) + 8 * j; const LAS float* s = scr + (8 * c) * 33 + n;
        v4u o; o.x = pk2(s[0 * 33], s[1 * 33]); o.y = pk2(s[2 * 33], s[3 * 33]); o.z = pk2(s[4 * 33], s[5 * 33]); o.w = pk2(s[6 * 33], s[7 * 33]);
        *(GAS v4u*)(WT + (size_t)(p0 + n) * K + k0 + 8 * c) = o; }
    LDS_WAIT(); asm volatile("" ::: "memory");
}

#define XB_TMO      128
#define XB_XCNT(j)  (256  + 64 * (j))
#define XB_XSUB(j)  (1280 + 64 * (j))
#define XB_XGEN(j)  (2304 + 64 * (j))
#define XB_TOP      3328
#define XB_TOPGEN   3392
#define XCD_BAR_WORDS 3456
#define XB_SPIN_CAP (1u << 18)

__device__ __forceinline__ unsigned xb_ld(unsigned* p)              { return __hip_atomic_load(p, __ATOMIC_RELAXED, __HIP_MEMORY_SCOPE_AGENT); }
__device__ __forceinline__ unsigned xb_add(unsigned* p, unsigned v) { return __hip_atomic_fetch_add(p, v, __ATOMIC_RELAXED, __HIP_MEMORY_SCOPE_AGENT); }
__device__ __forceinline__ unsigned xb_xcc_id() { return (unsigned)__builtin_amdgcn_s_getreg((3 << 11) | 20) & 0xFu; }
#define XB_SPIN(cond, bar) do { unsigned _sp = 0; while (cond) { __builtin_amdgcn_s_sleep(1); \
    if ((++_sp & 255u) == 0u) { if (xb_ld(&(bar)[XB_TMO])) break; if (_sp > XB_SPIN_CAP) { atomicAdd(&(bar)[XB_TMO], 1u); break; } } } } while (0)

struct XcdBarrier {
    unsigned* bar; unsigned x;
    volatile LAS unsigned* st;
};

__device__ __forceinline__ XcdBarrier xcd_barrier_post(unsigned* bar, volatile LAS unsigned* st) {
    XcdBarrier b; b.bar = bar; b.x = xb_xcc_id(); b.st = st;
    if (threadIdx.x == 0) (void)xb_add(&bar[XB_XCNT(b.x)], 1u);
    return b;
}
__device__ __forceinline__ void xcd_barrier_complete(unsigned* bar, unsigned x, unsigned& nloc, unsigned& nx) {
    const unsigned G = gridDim.x * gridDim.y * gridDim.z;
    unsigned sum, cnt, mine, sp = 0u;
    for (;;) {
        sum = 0u; cnt = 0u; mine = 0u;
#pragma unroll
        for (unsigned j = 0; j < 16; ++j) { const unsigned c = xb_ld(&bar[XB_XCNT(j)]); sum += c; cnt += (c > 0u) ? 1u : 0u; mine = (j == x) ? c : mine; }
        if (sum == G) break;
        __builtin_amdgcn_s_sleep(1);
        if ((++sp & 255u) == 0u) { if (xb_ld(&bar[XB_TMO])) break; if (sp > XB_SPIN_CAP) { atomicAdd(&bar[XB_TMO], 1u); break; } }
    }
    nloc = mine > 0u ? mine : 1u; nx = cnt > 0u ? cnt : 1u;
}

__device__ __forceinline__ void xcd_barrier(const XcdBarrier& b) {
    asm volatile("s_waitcnt vmcnt(0)" ::: "memory");
    __syncthreads();
    if (threadIdx.x == 0) {
        unsigned* bar = b.bar;
        __builtin_amdgcn_s_waitcnt(0);
        unsigned nloc = b.st[0], nx = b.st[1];
        if (nloc == 0u) { xcd_barrier_complete(bar, b.x, nloc, nx); b.st[0] = nloc; b.st[1] = nx; }
        const unsigned old = xb_add(&bar[XB_XSUB(b.x)], 1u);
        const unsigned gen = old / nloc;
        if (old + 1u == (gen + 1u) * nloc) {
            __builtin_amdgcn_fence(__ATOMIC_RELEASE, "agent");
            asm volatile("s_waitcnt vmcnt(0)" ::: "memory");
            const unsigned og = xb_add(&bar[XB_TOP], 1u);
            const unsigned tg = og / nx;
            if (og + 1u == (tg + 1u) * nx) xb_add(&bar[XB_TOPGEN], 1u);
            else XB_SPIN(xb_ld(&bar[XB_TOPGEN]) == tg, bar);
            __builtin_amdgcn_fence(__ATOMIC_ACQUIRE, "agent");
            xb_add(&bar[XB_XGEN(b.x)], 1u);
            asm volatile("s_waitcnt vmcnt(0)" ::: "memory");
        } else {
            XB_SPIN(xb_ld(&bar[XB_XGEN(b.x)]) == gen, bar);
            __builtin_amdgcn_fence(__ATOMIC_ACQUIRE, "agent");
            asm volatile("s_waitcnt vmcnt(0)" ::: "memory");
        }
    }
    __syncthreads();
}


__device__ __forceinline__ float qk_bound(const float* q_g, const float* k_g, int lane) {
    float gq = fabsf(q_g[lane]), gk = fabsf(k_g[lane]);
#pragma unroll
    for (int o = 1; o < 64; o <<= 1) { gq = fmaxf(gq, __shfl_xor(gq, o)); gk = fmaxf(gk, __shfl_xor(gk, o)); }
    return attn_body::C2 * 64.0f * 1.02f * gq * gk;
}
#ifndef GEMM1_WGM
#define GEMM1_WGM 12
#endif
constexpr float GAP_EXTRA = 38.0f;
struct Args { const float* in[13]; float* out; unsigned char* ws; };
struct ConvItems {
    LAS unsigned char* L;
    __device__ __forceinline__ void operator()(int item) const {
        const __attribute__((address_space(4))) Args* ap_ = (const __attribute__((address_space(4))) Args*)__builtin_amdgcn_kernarg_segment_ptr(); asm volatile("" : "+s"(ap_));
        unsigned char* ws = ap_->ws; const float* conv_w = ap_->in[9]; const float* w_a = ap_->in[10]; const float* w_b = ap_->in[11]; const float* w_o = ap_->in[12];
        const bf16* CUB = (const bf16*)(ws + WS_CU); const bf16* GZB = (const bf16*)(ws + WS_GZ); bf16* OAB = (bf16*)(ws + WS_OAB); bf16* WABT = (bf16*)(ws + WS_WAB); bf16* WOT = (bf16*)(ws + WS_WO);
        const int lane = threadIdx.x & 63, wave = __builtin_amdgcn_readfirstlane((int)threadIdx.x >> 6);
        if (item >= M / 128) {
            LAS float* scr = (LAS float*)(L + wave * 8704); int r = (item - M / 128) * 8 + wave;
            constexpr int I_A = (D / 32) * (AW / 64), I_B = (D / 32) * (CW / 64);
            if (r < I_A) p0_transpose_item<false>(w_a, D, D, WABT, scr, r, AW / 64, lane);
            else if (r < I_A + I_B) p0_transpose_item<false>(w_b, D, D, WABT + 512, scr, r - I_A, CW / 64, lane);
            else p0_transpose_item<false>(w_o, D, D, WOT, scr, r - I_A - I_B, D / 64, lane);
            return; }
        const int m0 = item * 128 + wave * 16; const int ch = 8 * lane;
        float w0[8], w1[8], w2[8];
#pragma unroll
        for (int e = 0; e < 8; ++e) { w0[e] = conv_w[ch + e]; w1[e] = conv_w[CW + ch + e]; w2[e] = conv_w[2 * CW + ch + e]; }
        float p1[8], p2[8];
        const bool first = (m0 % T) == 0;
        { v4u a = {0u, 0u, 0u, 0u}, bq = {0u, 0u, 0u, 0u};
          if (!first) { a = *(const v4u*)(CUB + (size_t)(m0 - 2) * CW + ch); bq = *(const v4u*)(CUB + (size_t)(m0 - 1) * CW + ch); }
#pragma unroll
          for (int e = 0; e < 4; ++e) { p2[2 * e] = pg8::bflo(a[e]); p2[2 * e + 1] = pg8::bfhi(a[e]); p1[2 * e] = pg8::bflo(bq[e]); p1[2 * e + 1] = pg8::bfhi(bq[e]); } }
#pragma unroll 4
        for (int r = 0; r < 16; ++r) { const int m = m0 + r;
            const v4u cv = *(const v4u*)(CUB + (size_t)m * CW + ch), gv = *(const v4u*)(GZB + (size_t)m * CW + ch);
            float cur[8], o[8];
#pragma unroll
            for (int e = 0; e < 4; ++e) { cur[2 * e] = pg8::bflo(cv[e]); cur[2 * e + 1] = pg8::bfhi(cv[e]); }
#pragma unroll
            for (int e = 0; e < 4; ++e) { o[2 * e] = pg8::bflo(gv[e]) * (w0[2 * e] * p2[2 * e] + w1[2 * e] * p1[2 * e] + w2[2 * e] * cur[2 * e]);
                o[2 * e + 1] = pg8::bfhi(gv[e]) * (w0[2 * e + 1] * p2[2 * e + 1] + w1[2 * e + 1] * p1[2 * e + 1] + w2[2 * e + 1] * cur[2 * e + 1]); }
            v4u ov; ov.x = pk2(o[0], o[1]); ov.y = pk2(o[2], o[3]); ov.z = pk2(o[4], o[5]); ov.w = pk2(o[6], o[7]);
            *(v4u*)(OAB + (size_t)m * 1024 + 512 + ch) = ov;
#pragma unroll
            for (int e = 0; e < 8; ++e) { p2[e] = p1[e]; p1[e] = cur[e]; }
        }
    }
};
constexpr int N_CONV_ITEMS = M / 128 + ((D / 32) * (AW / 64) + (D / 32) * (CW / 64) + (D / 32) * (D / 64)) / 8;

template <int LO, int HI> __global__ void __launch_bounds__(NWAVES * 64, 2) fox_fwd(Args args) {
    extern __shared__ __attribute__((aligned(16))) unsigned char lds[];
    LAS unsigned char* L = (LAS unsigned char*)lds;
    if (threadIdx.x < 2) ((volatile LAS unsigned*)(L + MISC_OFF))[threadIdx.x] = 0u;
    if (HI - LO > 1 && threadIdx.x == 0) (void)xb_add(&((unsigned*)(args.ws + WS_CTL))[XB_XCNT(xb_xcc_id())], 1u);
    __syncthreads();
#define PHASE_IDS() int tid = threadIdx.x; asm volatile("" : "+v"(tid)); int bx = blockIdx.x; asm volatile("" : "+s"(bx)); int G = gridDim.x; asm volatile("" : "+s"(G)); \
    const int lane = tid & 63, wave = __builtin_amdgcn_readfirstlane(tid >> 6); const int vcu = (G % 8 == 0) ? (bx % 8) * (G / 8) + bx / 8 : bx; const int gw = vcu * NWAVES + wave, NGW = G * NWAVES; (void)lane; (void)gw; (void)NGW
#define PHASE_PTRS() const __attribute__((address_space(4))) Args* ap_ = (const __attribute__((address_space(4))) Args*)__builtin_amdgcn_kernarg_segment_ptr(); asm volatile("" : "+s"(ap_)); unsigned char* ws = ap_->ws; const float* x = ap_->in[0]; const float* c = ap_->in[1]; const float* w_ada = ap_->in[2]; const float* b_ada = ap_->in[3]; const float* norm_g = ap_->in[4]; const float* w_in = ap_->in[5]; const float* b_f = ap_->in[6]; const float* q_g = ap_->in[7]; const float* k_g = ap_->in[8]; const float* conv_w = ap_->in[9]; const float* w_a = ap_->in[10]; const float* w_b = ap_->in[11]; const float* w_o = ap_->in[12]; float* ADA = (float*)(ws + WS_ADA); float* WF = (float*)(ws + WS_WF); float* LF = (float*)(ws + WS_LF); bf16* W1T = (bf16*)(ws + WS_W1); bf16* WABT = (bf16*)(ws + WS_WAB); bf16* WOT = (bf16*)(ws + WS_WO); bf16* HB = (bf16*)(ws + WS_HB); bf16* OAB = (bf16*)(ws + WS_OAB); bf16* QB = (bf16*)(ws + WS_Q); bf16* KB = (bf16*)(ws + WS_K); bf16* VB = (bf16*)(ws + WS_V); bf16* MG = (bf16*)(ws + WS_MG); bf16* SZA = (bf16*)(ws + WS_SZA); bf16* CUB = (bf16*)(ws + WS_CU); bf16* GZB = (bf16*)(ws + WS_GZ); bf16* RB = (bf16*)(ws + WS_R); bf16* SGB = (bf16*)(ws + WS_SGB);
#ifndef REPEAT_PHASE
#define REPEAT_PHASE -1
#endif
#define REPS(k) (REPEAT_PHASE == (k) ? 2 : 1)
#ifndef PHMASK
#define PHMASK 63
#endif
#define IN(k) ((((PHMASK) >> (k)) & 1) && LO <= (k) && (k) < HI)
#define BOTH(k) (IN(k) && IN((k) + 1))
#ifndef BAR_REPS
#define BAR_REPS 1
#endif
#define XBAR() for (int br_ = 0; br_ < BAR_REPS; ++br_) do { const __attribute__((address_space(4))) Args* bp_ = (const __attribute__((address_space(4))) Args*)__builtin_amdgcn_kernarg_segment_ptr(); asm volatile("" : "+s"(bp_)); XcdBarrier b_; b_.bar = (unsigned*)(bp_->ws + WS_CTL); b_.x = xb_xcc_id(); b_.st = (volatile LAS unsigned*)(L + MISC_OFF); xcd_barrier(b_); } while (0)

    for (int rep_ = 0; rep_ < REPS(0); ++rep_) if (IN(0)) {
        PHASE_PTRS(); PHASE_IDS();
        if (bx < 192) {
            LAS float* ct = (LAS float*)L;
            LAS float* red = (LAS float*)(L + 32768);
            for (int i = tid; i < 8192; i += NWAVES * 64) { const int b = i >> 10, k = i & 1023; ct[k * 8 + b] = c[i]; }
            __syncthreads();
            const int col = bx * 16 + (lane & 15), kpar = lane >> 4;
            float acc[8];
#pragma unroll
            for (int b = 0; b < 8; ++b) acc[b] = 0.f;
#pragma unroll 8
            for (int kk = 0; kk < 32; ++kk) { const int k = wave * 128 + 4 * kk + kpar; const float wv = w_ada[(size_t)k * 3072 + col];
                const f32x4 c0 = *(const LAS f32x4*)(ct + k * 8), c1 = *(const LAS f32x4*)(ct + k * 8 + 4);
                acc[0] += c0[0] * wv; acc[1] += c0[1] * wv; acc[2] += c0[2] * wv; acc[3] += c0[3] * wv; acc[4] += c1[0] * wv; acc[5] += c1[1] * wv; acc[6] += c1[2] * wv; acc[7] += c1[3] * wv; }
#pragma unroll
            for (int b = 0; b < 8; ++b) { acc[b] += __shfl_xor(acc[b], 16); acc[b] += __shfl_xor(acc[b], 32); if (lane < 16) red[(wave * 8 + b) * 16 + lane] = acc[b]; }
            __syncthreads();
            if (tid < 128) { const int b = tid >> 4, cl = tid & 15; float s = b_ada[bx * 16 + cl];
#pragma unroll
                for (int w = 0; w < 8; ++w) s += red[(w * 8 + b) * 16 + cl];
                ADA[b * 3072 + bx * 16 + cl] = s; }
            __syncthreads();
        }
        {
            const int i = bx * NWAVES * 64 + tid; if (i < 8192) { const int j = i >> 10, k = i & 1023; WF[i] = w_in[(size_t)k * INW + SRC_F + j]; }
        }
        if (bx >= 192) {
            LAS float* scr = (LAS float*)(L + wave * 8704); const int w2 = (bx - 192) * NWAVES + wave;
            p0_transpose_item<true>(w_in, D, INW, W1T, scr, 2048 + w2, D / 64, lane);
            p0_transpose_item<true>(w_in, D, INW, W1T, scr, 2048 + 512 + w2, D / 64, lane);
        }
        if (BOTH(0)) XBAR();
    }

    for (int rep_ = 0; rep_ < REPS(1); ++rep_) if (IN(1)) {
        PHASE_PTRS(); PHASE_IDS();
#define P1COL(j) (8 * lane + 512 * ((j) >> 1) + 4 * ((j) & 1))
        LAS float* wf = (LAS float*)L;
        for (int i = tid; i < 2048; i += NWAVES * 64) ((LAS f32x4*)wf)[i] = ((const f32x4*)WF)[i];
        __syncthreads();
        const int m0 = gw * 16, b = m0 / T;
        f32x4 gm[4], sh[4];
#pragma unroll
        for (int j = 0; j < 4; ++j) { const int col = P1COL(j); const f32x4 g = *(const f32x4*)(norm_g + col), scl = *(const f32x4*)(ADA + b * 3072 + 1024 + col);
            gm[j] = g * (scl + 1.0f); sh[j] = *(const f32x4*)(ADA + b * 3072 + col); }
        const float bfv = b_f[lane & 7]; f32x4 lsq[4];
#pragma unroll
        for (int k = 0; k < 4; ++k) lsq[k] = (f32x4){0.f, 0.f, 0.f, 0.f};
        for (int r = 0; r < 16; ++r) { const int m = m0 + r;
            const GAS float* xr = (const GAS float*)(x + (size_t)m * D);
            f32x4 v[4]; float s2 = 0.f;
#pragma unroll
            for (int j = 0; j < 4; ++j) { v[j] = *(const GAS f32x4*)(xr + P1COL(j)); s2 += (v[j][0] * v[j][0] + v[j][1] * v[j][1]) + (v[j][2] * v[j][2] + v[j][3] * v[j][3]); }
            const float rstd = 1.0f / sqrtf(wave_sum(s2) * (1.0f / D) + EPS);
#pragma unroll
            for (int j = 0; j < 4; ++j) v[j] = v[j] * rstd * gm[j] + sh[j];
#pragma unroll
            for (int j = 0; j < 2; ++j) { v4u o; o.x = pk2(v[2 * j][0], v[2 * j][1]); o.y = pk2(v[2 * j][2], v[2 * j][3]); o.z = pk2(v[2 * j + 1][0], v[2 * j + 1][1]); o.w = pk2(v[2 * j + 1][2], v[2 * j + 1][3]);
                *(GAS v4u*)(HB + (size_t)m * D + 8 * lane + 512 * j) = o; }
            float fl[8];
#pragma unroll
            for (int q = 0; q < 8; ++q) { float a = 0.f;
#pragma unroll
                for (int j = 0; j < 4; ++j) { const f32x4 w = *(const LAS f32x4*)(wf + q * 1024 + P1COL(j)); a += (v[j][0] * w[0] + v[j][1] * w[1]) + (v[j][2] * w[2] + v[j][3] * w[3]); }
                fl[q] = wave_sum(a); }
            float mine = fl[0];
#pragma unroll
            for (int q = 1; q < 8; ++q) mine = (lane == q) ? fl[q] : mine;
            { const float z = mine + bfv; const float ls = fminf(z, 0.f) - log1pf(__expf(-fabsf(z)));
#pragma unroll
              for (int k = 0; k < 4; ++k)
#pragma unroll
                  for (int e = 0; e < 4; ++e) lsq[k][e] = (r == 4 * k + e) ? ls : lsq[k][e]; }
        }
        if (lane < 8) { f32x4* dst = (f32x4*)(LF + (size_t)(b * 8 + lane) * T + (m0 - b * T));
#pragma unroll
            for (int k = 0; k < 4; ++k) dst[k] = lsq[k]; }
        {
            LAS float* scr = (LAS float*)(L + 32768 + wave * 8704);
            constexpr int I_1 = (NPROJ / 32) * (D / 64), I_A = (D / 32) * (AW / 64), I_B = (D / 32) * (CW / 64), I_O = (D / 32) * (D / 64);
            (void)I_A; (void)I_B; (void)I_O;
            static_assert(I_1 == 3072, "P0 converts items [2048, 3072) on its 64 GEMV-free workgroups");
            for (int it = gw; it < 2048; it += NGW) p0_transpose_item<true>(w_in, D, INW, W1T, scr, it, D / 64, lane);
        }
        __syncthreads();
        if (BOTH(1)) XBAR();
    }

    for (int rep_ = 0; rep_ < REPS(2); ++rep_) if (IN(2)) {
        PHASE_PTRS(); PHASE_IDS();
        if (bx < BATCH * H) {
            attn_body::bias_scan((char*)lds, LF + (size_t)bx * T, (float*)(ws + WS_BIAS) + (size_t)bx * T);
            attn_body::j0_table((const char*)lds, 2.0f * qk_bound(q_g, k_g, lane) + GAP_EXTRA, (int*)(ws + WS_J0) + bx * 16, wave, lane);
            __syncthreads(); }
        pg8::Gemm g{HB, W1T, M, NPROJ, D}; pg8::StaticOrder S; S.init(M, NPROJ, G, bx, GEMM1_WGM);
        pg8::EpiProj E{ws, q_g, k_g, attn_body::C2, EPS};
        pg8::gemm_phase<pg8::EpiProj, pg8::StaticOrder, PG8_ALIGN, PG8_SP2>(L + RING_OFF, g, S, E);
        if (BOTH(2)) XBAR();
    }

    for (int rep_ = 0; rep_ < REPS(3); ++rep_) if (IN(3)) {
        PHASE_PTRS(); PHASE_IDS();
        const float qkb = qk_bound(q_g, k_g, lane);
        const attn_body::AttnTensors AT{ws, WS_Q, WS_K, WS_V, WS_SZA, WS_LF, WS_OAB, WS_BIAS, WS_J0, 2.0f * qkb + GAP_EXTRA, qkb};
        const ConvItems CI{L};
        attn_body::attn_phase_dyn<-1, ConvItems>((char*)lds + RING_OFF, AT, (unsigned*)(ws + WS_CTL) + CW_ATTNQ, CI, N_CONV_ITEMS);
        if (BOTH(3)) XBAR();
    }

    for (int rep_ = 0; rep_ < REPS(4); ++rep_) if (IN(4)) {
        PHASE_PTRS(); PHASE_IDS();
        pg8::Gemm g{OAB, WABT, M, D, D}; pg8::StaticOrder S; S.init(M, D, G, bx);
        pg8::EpiMerge E{(const unsigned short*)RB, MG};
        pg8::gemm_phase<pg8::EpiMerge, pg8::StaticOrder, PG8_ALIGN, PG8_SP2>(L + RING_OFF, g, S, E);
        if (BOTH(4)) XBAR();
    }

    for (int rep_ = 0; rep_ < REPS(5); ++rep_) if (IN(5)) {
        PHASE_PTRS(); PHASE_IDS();
        pg8::Gemm g{MG, WOT, M, D, D}; pg8::StaticOrder S; S.init(M, D, G, bx);
        pg8::EpiOut E{x, ADA + 2048, ap_->out};
        pg8::gemm_phase<pg8::EpiOut, pg8::StaticOrder, PG8_ALIGN, PG8_SP2>(L + RING_OFF, g, S, E);
    }
#undef IN
#undef BOTH
}

extern "C" void kernel_launch(void* const* d_in, const int* in_sizes, int n_in, void* d_out, int out_size, void* d_ws, size_t ws_size, hipStream_t stream) {
    static int grid = 0;
    if (grid == 0) {
        if (n_in != 13 || in_sizes[0] != M * D || out_size != M * D || ws_size < WS_END) { fprintf(stderr, "kernel_launch: shape/workspace mismatch (n_in %d, in0 %d, out %d, ws %zu); nothing launched\n", n_in, n_in > 0 ? in_sizes[0] : -1, out_size, ws_size); grid = -1; return; }
        int dev = 0, cus = 0, per_cu = 0;
        if (hipGetDevice(&dev) != hipSuccess || hipDeviceGetAttribute(&cus, hipDeviceAttributeMultiprocessorCount, dev) != hipSuccess) { fprintf(stderr, "kernel_launch: device query failed\n"); grid = -1; return; }
        bool ok = true;
#if MK_N_LAUNCHES == 1
        const void* kfull = (const void*)fox_fwd<0, PER_PHASE>;
        ok = hipFuncSetAttribute(kfull, hipFuncAttributeMaxDynamicSharedMemorySize, LDS_BYTES) == hipSuccess;
#else
        const void* kph[PER_PHASE] = {(const void*)fox_fwd<0, 1>, (const void*)fox_fwd<1, 2>, (const void*)fox_fwd<2, 3>, (const void*)fox_fwd<3, 4>, (const void*)fox_fwd<4, 5>, (const void*)fox_fwd<5, 6>};
        const void* kfull = kph[3];
        for (int i = 0; i < PER_PHASE; ++i) ok = ok && hipFuncSetAttribute(kph[i], hipFuncAttributeMaxDynamicSharedMemorySize, LDS_BYTES) == hipSuccess;
#endif
        if (!ok) { fprintf(stderr, "kernel_launch: hipFuncSetAttribute failed\n"); grid = -1; return; }
        if (hipOccupancyMaxActiveBlocksPerMultiprocessor(&per_cu, kfull, NWAVES * 64, LDS_BYTES) != hipSuccess || per_cu < 1) { fprintf(stderr, "kernel_launch: occupancy query reports %d workgroups per CU\n", per_cu); (void)hipGetLastError(); grid = -1; return; }
        grid = cus;
        if (grid != 256) { fprintf(stderr, "kernel_launch: built for a 256-CU device (got %d CUs); nothing launched\n", cus); grid = -1; return; }
    }
    if (grid < 0) return;
    if (hipMemsetAsync((char*)d_ws + WS_CTL, 0, (XCD_BAR_WORDS + 256) * 4, stream) != hipSuccess) { fprintf(stderr, "kernel_launch: hipMemsetAsync failed\n"); return; }
    Args a{};
    for (int i = 0; i < 13; ++i) a.in[i] = (const float*)d_in[i];
    a.out = (float*)d_out; a.ws = (unsigned char*)d_ws;
#if MK_N_LAUNCHES == 1
    {
        void* kargs[] = {&a};
        const hipError_t e = hipLaunchCooperativeKernel((const void*)fox_fwd<0, PER_PHASE>, dim3(grid), dim3(NWAVES * 64), kargs, LDS_BYTES, stream);
        if (e != hipSuccess) fprintf(stderr, "kernel_launch: cooperative launch failed: %s (grid %d)\n", hipGetErrorString(e), grid);
    }
#else
    {
        hipLaunchKernelGGL((fox_fwd<0, 1>), dim3(grid), dim3(NWAVES * 64), LDS_BYTES, stream, a);
        hipLaunchKernelGGL((fox_fwd<1, 2>), dim3(grid), dim3(NWAVES * 64), LDS_BYTES, stream, a);
        hipLaunchKernelGGL((fox_fwd<2, 3>), dim3(grid), dim3(NWAVES * 64), LDS_BYTES, stream, a);
        hipLaunchKernelGGL((fox_fwd<3, 4>), dim3(grid), dim3(NWAVES * 64), LDS_BYTES, stream, a);
        hipLaunchKernelGGL((fox_fwd<4, 5>), dim3(grid), dim3(NWAVES * 64), LDS_BYTES, stream, a);
        hipLaunchKernelGGL((fox_fwd<5, 6>), dim3(grid), dim3(NWAVES * 64), LDS_BYTES, stream, a);
        const hipError_t le = hipPeekAtLastError();
        if (le != hipSuccess) fprintf(stderr, "kernel_launch: a phase launch failed: %s\n", hipGetErrorName(le));
    }
#endif
}
```
